# Optimizing an MI355X kernel written in HIP

```python
import jax, jax.numpy as jnp
from jax import lax
import numpy as np

D_MODEL = 2048
BATCH = 8
SEQ = 4096
DEPTH = 4

N_MEM = 256
N_A_LAYERS = DEPTH // 2
N_B_LAYERS = DEPTH - N_A_LAYERS
GLA_HEADS = 4
GLA_DK = D_MODEL // 8
GLA_DV = 3 * D_MODEL // 16
GLA_QK_WIDTH = GLA_HEADS * GLA_DK
GLA_V_WIDTH = GLA_HEADS * GLA_DV
GLA_GATE_RANK = 16
GLA_GATE_TAU = 16.0
GLA_CHUNK = 64
FOX_HEADS = 12
FOX_HEAD_DIM = D_MODEL // 16
FOX_WIDTH = FOX_HEADS * FOX_HEAD_DIM
FOX_BLOCK = 128
MEM_HEADS = 4
MEM_HEAD_DIM = D_MODEL // 16
MEM_WIDTH = MEM_HEADS * MEM_HEAD_DIM
A_MIX_WIDTH = GLA_V_WIDTH + MEM_WIDTH
B_MIX_WIDTH = FOX_WIDTH + MEM_WIDTH
A_IN_WIDTH = 2 * GLA_QK_WIDTH + GLA_V_WIDTH + GLA_GATE_RANK + GLA_V_WIDTH + MEM_WIDTH
B_IN_WIDTH = FOX_WIDTH + MEM_WIDTH
FFN_HIDDEN = 11 * D_MODEL // 4
CONV_WIDTH = 3
EPS = 1e-6

kernel_name = 'hybrid_gla_fox_yoco_block'


def rmsnorm(x, g):
    xf = x.astype(jnp.float32)
    y = xf * lax.rsqrt(jnp.mean(xf * xf, axis=-1, keepdims=True) + EPS)
    return (y * g.astype(jnp.float32)).astype(x.dtype)


def split_cols(z, widths):
    out, start = [], 0
    for w in widths:
        out.append(z[..., start:start + w])
        start += w
    return out


def split_heads(t, n_heads):
    b, s, _ = t.shape
    return t.reshape(b, s, n_heads, -1).transpose(0, 2, 1, 3)


def merge_heads(t):
    b, h, s, d = t.shape
    return t.transpose(0, 2, 1, 3).reshape(b, s, h * d)


def memory_kv(mem_n, w_kv):
    mk, mv = split_cols(mem_n @ w_kv, [MEM_WIDTH, MEM_WIDTH])
    return split_heads(mk, MEM_HEADS), split_heads(mv, MEM_HEADS)


def memory_attention(q, mem_k, mem_v):
    qh = split_heads(q, MEM_HEADS)
    s = jnp.einsum('bhqd,bhkd->bhqk', qh, mem_k).astype(jnp.float32) * (MEM_HEAD_DIM ** -0.5)
    p = jax.nn.softmax(s, axis=-1).astype(mem_v.dtype)
    return merge_heads(jnp.einsum('bhqk,bhkd->bhqd', p, mem_v))


def gla_chunked(q, k, v, g):
    q, k, v, g = (t.astype(jnp.float32) for t in (q, k, v, g))
    b_, h_, s_, dk = q.shape
    dv = v.shape[-1]
    nc = s_ // GLA_CHUNK

    def to_chunks(t):
        return jnp.moveaxis(t.reshape(b_, h_, nc, GLA_CHUNK, t.shape[-1]), 2, 0)

    tri = jnp.tril(jnp.ones((GLA_CHUNK, GLA_CHUNK), dtype=bool))[:, :, None]

    def step(state, inp):
        qc, kc, vc, gc = inp
        bcum = jnp.cumsum(gc, axis=2)
        o_inter = jnp.einsum('bhtk,bhkv->bhtv', qc * jnp.exp(bcum), state)
        rel = bcum[:, :, :, None, :] - bcum[:, :, None, :, :]
        decay = jnp.exp(jnp.where(tri, rel, -jnp.inf))
        att = jnp.einsum('bhtk,bhsk,bhtsk->bhts', qc, kc, decay)
        o_intra = jnp.einsum('bhts,bhsv->bhtv', att, vc)
        b_last = bcum[:, :, -1:, :]
        new_state = jnp.exp(b_last)[:, :, 0, :, None] * state + jnp.einsum(
            'bhsk,bhsv->bhkv', kc * jnp.exp(b_last - bcum), vc)
        return new_state, o_inter + o_intra

    state0 = jnp.zeros((b_, h_, dk, dv), jnp.float32)
    _, out = lax.scan(step, state0, (to_chunks(q), to_chunks(k), to_chunks(v), to_chunks(g)))
    return jnp.moveaxis(out, 0, 2).reshape(b_, h_, s_, dv)


def gla_mixer(h, mem_k, mem_v, w_in, w_gate_up, b_gate, gn_gain, w_out):
    z = h @ w_in
    q, k, v, glr, og, mq = split_cols(
        z, [GLA_QK_WIDTH, GLA_QK_WIDTH, GLA_V_WIDTH, GLA_GATE_RANK, GLA_V_WIDTH, MEM_WIDTH])
    g = jax.nn.log_sigmoid((glr @ w_gate_up + b_gate).astype(jnp.float32)) / GLA_GATE_TAU
    o = gla_chunked(split_heads(q, GLA_HEADS) * (GLA_DK ** -0.5), split_heads(k, GLA_HEADS),
                    split_heads(v, GLA_HEADS), split_heads(g, GLA_HEADS))
    o = o * lax.rsqrt(jnp.mean(o * o, axis=-1, keepdims=True) + EPS)
    o = o * gn_gain.astype(jnp.float32).reshape(GLA_HEADS, 1, GLA_DV)
    o = merge_heads(o).astype(h.dtype) * jax.nn.silu(og)
    m = memory_attention(mq, mem_k, mem_v)
    return jnp.concatenate([o, m], axis=-1) @ w_out


def fox_shared_kv(x, g_kv, w_kv, b_f):
    hs = rmsnorm(x, g_kv)
    k, v, fl = split_cols(hs @ w_kv, [FOX_WIDTH, FOX_WIDTH, FOX_HEADS])
    log_f = jax.nn.log_sigmoid((fl + b_f).astype(jnp.float32))
    c = jnp.cumsum(log_f, axis=1).transpose(0, 2, 1)
    return split_heads(k, FOX_HEADS), split_heads(v, FOX_HEADS), c


def fox_attention(q, k, v, c):
    b_, h_, s_, dh = q.shape
    nb = s_ // FOX_BLOCK
    qb = jnp.moveaxis(q.reshape(b_, h_, nb, FOX_BLOCK, dh), 2, 0)
    cb = jnp.moveaxis(c.reshape(b_, h_, nb, FOX_BLOCK), 2, 0)
    kpos = jnp.arange(s_)
    scale = FOX_HEAD_DIM ** -0.5

    def block(args):
        qi, ci, i = args
        s = jnp.einsum('bhqd,bhkd->bhqk', qi, k).astype(jnp.float32) * scale
        s = s + ci[..., None] - c[:, :, None, :]
        qpos = i * FOX_BLOCK + jnp.arange(FOX_BLOCK)
        s = jnp.where(kpos[None, :] <= qpos[:, None], s, -jnp.inf)
        p = jax.nn.softmax(s, axis=-1).astype(v.dtype)
        return jnp.einsum('bhqk,bhkd->bhqd', p, v)

    out = lax.map(block, (qb, cb, jnp.arange(nb)))
    return jnp.moveaxis(out, 0, 2).reshape(b_, h_, s_, dh)


def fox_mixer(h, fk, fv, fc, mem_k, mem_v, w_in, w_out):
    q, mq = split_cols(h @ w_in, [FOX_WIDTH, MEM_WIDTH])
    o = merge_heads(fox_attention(split_heads(q, FOX_HEADS), fk, fv, fc))
    m = memory_attention(mq, mem_k, mem_v)
    return jnp.concatenate([o, m], axis=-1) @ w_out


def causal_dwconv(u, w, b):
    s_ = u.shape[1]
    up = jnp.pad(u, ((0, 0), (CONV_WIDTH - 1, 0), (0, 0)))
    return w[0] * up[:, 0:s_] + w[1] * up[:, 1:s_ + 1] + w[2] * up[:, 2:s_ + 2] + b


def conv_ffn(h, w_up, conv_w, conv_b, w_down):
    u = causal_dwconv(h @ w_up, conv_w, conv_b)
    a, val = split_cols(u, [FFN_HIDDEN, FFN_HIDDEN])
    return (jax.nn.silu(a) * val) @ w_down


def setup_inputs(seed: int = 0) -> dict:
    key = jax.random.key(seed)
    ks = jax.random.split(key, 24)

    def nrm(k, shape, scale):
        return jax.random.normal(k, shape, jnp.float32) * scale

    out_scale = (2.0 * DEPTH) ** -0.5
    return {
        'x': nrm(ks[0], (BATCH, SEQ, D_MODEL), 1.0),
        'mem': nrm(ks[1], (BATCH, N_MEM, D_MODEL), 1.0),
        'norm_mix': 1.0 + nrm(ks[2], (DEPTH, D_MODEL), 0.02),
        'norm_ffn': 1.0 + nrm(ks[3], (DEPTH, D_MODEL), 0.02),
        'norm_mem': 1.0 + nrm(ks[4], (D_MODEL,), 0.02),
        'norm_final': 1.0 + nrm(ks[5], (D_MODEL,), 0.02),
        'mem_w_kv': nrm(ks[6], (DEPTH, D_MODEL, 2 * MEM_WIDTH), D_MODEL ** -0.5),
        'gla_w_in': nrm(ks[7], (N_A_LAYERS, D_MODEL, A_IN_WIDTH), D_MODEL ** -0.5),
        'gla_w_gate_up': nrm(ks[8], (N_A_LAYERS, GLA_GATE_RANK, GLA_QK_WIDTH), GLA_GATE_RANK ** -0.5),
        'gla_b_gate': 1.0 + nrm(ks[9], (N_A_LAYERS, GLA_QK_WIDTH), 0.5),
        'gla_norm': 1.0 + nrm(ks[10], (N_A_LAYERS, GLA_V_WIDTH), 0.02),
        'gla_w_out': nrm(ks[11], (N_A_LAYERS, A_MIX_WIDTH, D_MODEL), A_MIX_WIDTH ** -0.5 * out_scale),
        'fox_kv_norm': 1.0 + nrm(ks[12], (D_MODEL,), 0.02),
        'fox_w_kv': nrm(ks[13], (D_MODEL, 2 * FOX_WIDTH + FOX_HEADS), D_MODEL ** -0.5),
        'fox_b_f': 3.0 + nrm(ks[14], (FOX_HEADS,), 1.0),
        'fox_w_in': nrm(ks[15], (N_B_LAYERS, D_MODEL, B_IN_WIDTH), D_MODEL ** -0.5),
        'fox_w_out': nrm(ks[16], (N_B_LAYERS, B_MIX_WIDTH, D_MODEL), B_MIX_WIDTH ** -0.5 * out_scale),
        'ffn_w_up': nrm(ks[17], (DEPTH, D_MODEL, 2 * FFN_HIDDEN), D_MODEL ** -0.5),
        'ffn_conv_w': nrm(ks[18], (DEPTH, CONV_WIDTH, 2 * FFN_HIDDEN), CONV_WIDTH ** -0.5),
        'ffn_conv_b': nrm(ks[19], (DEPTH, 2 * FFN_HIDDEN), 0.01),
        'ffn_w_down': nrm(ks[20], (DEPTH, FFN_HIDDEN, D_MODEL), FFN_HIDDEN ** -0.5 * out_scale),
    }


def reference(x, mem, norm_mix, norm_ffn, norm_mem, norm_final, mem_w_kv, gla_w_in, gla_w_gate_up,
              gla_b_gate, gla_norm, gla_w_out, fox_kv_norm, fox_w_kv, fox_b_f, fox_w_in, fox_w_out,
              ffn_w_up, ffn_conv_w, ffn_conv_b, ffn_w_down):
    mem_n = rmsnorm(mem, norm_mem)
    fk = fv = fc = None
    for i in range(DEPTH):
        if i == N_A_LAYERS:
            fk, fv, fc = fox_shared_kv(x, fox_kv_norm, fox_w_kv, fox_b_f)
        mk, mv = memory_kv(mem_n, mem_w_kv[i])
        h = rmsnorm(x, norm_mix[i])
        if i < N_A_LAYERS:
            x = x + gla_mixer(h, mk, mv, gla_w_in[i], gla_w_gate_up[i], gla_b_gate[i],
                              gla_norm[i], gla_w_out[i])
        else:
            j = i - N_A_LAYERS
            x = x + fox_mixer(h, fk, fv, fc, mk, mv, fox_w_in[j], fox_w_out[j])
        h = rmsnorm(x, norm_ffn[i])
        x = x + conv_ffn(h, ffn_w_up[i], ffn_conv_w[i], ffn_conv_b[i], ffn_w_down[i])
    return rmsnorm(x, norm_final)
```

```cpp
#define RES_BF16 0
#define EPI_RES_PERM 1
#include <hip/hip_runtime.h>
#include <cstdio>
#include <cstdint>
#ifndef MK_FUSED
#define MK_FUSED 1
#endif
__device__ __forceinline__ int opaque_tid(int wave) { int l; asm volatile("v_mbcnt_lo_u32_b32 %0, -1, 0\n\tv_mbcnt_hi_u32_b32 %0, -1, %0" : "=v"(l)); return wave * 64 + l; }
namespace pg8 {
#define PG8_LAS __attribute__((address_space(3)))
typedef unsigned short bf16_t;
typedef short bf16x8 __attribute__((ext_vector_type(8)));
typedef float f32x4 __attribute__((ext_vector_type(4)));
typedef unsigned u32x4 __attribute__((ext_vector_type(4)));
typedef unsigned u32x2 __attribute__((ext_vector_type(2)));
constexpr int BM = 256, BK = 64, HALF = 128, HTB = HALF * BK * 2  , STAGE_BYTES = 8 * HTB, NXCD = 8, WGM = 8;

__host__ __device__ __forceinline__ int lds_byte(int r, int c) { const int st = (r >> 4) * 2 + (c >> 5), rr = r & 15, cc = c & 31, ob = rr * 64 + cc * 2; return st * 1024 + (ob ^ (((ob >> 9) & 1) << 5)); }
__host__ __device__ __forceinline__ void stage_rc(int b, int& R, int& C) { const int st = b / 1024, sb = b % 1024, swz = sb ^ (((sb >> 9) & 1) << 5); R = (st >> 1) * 16 + swz / 64; C = (st & 1) * 32 + (swz % 64) / 2; }
__host__ __device__ __forceinline__ int perm32(int rho) { const int n = rho >> 4, i = rho & 15; return 8 * (i >> 2) + 4 * n + (i & 3); }

typedef _Float16 h16x8 __attribute__((ext_vector_type(8)));
typedef _Float16 h16x2 __attribute__((ext_vector_type(2)));
template <bool F16> __device__ __forceinline__ f32x4 mfma16(bf16x8 a, bf16x8 b, f32x4 c) {
    if constexpr (F16) return __builtin_amdgcn_mfma_f32_16x16x32_f16(__builtin_bit_cast(h16x8, a), __builtin_bit_cast(h16x8, b), c, 0, 0, 0);
    else return __builtin_amdgcn_mfma_f32_16x16x32_bf16(a, b, c, 0, 0, 0);
}
__device__ __forceinline__ unsigned pkh2(float lo, float hi) { h16x2 v; v.x = (_Float16)lo; v.y = (_Float16)hi; return __builtin_bit_cast(unsigned, v); }
__device__ __forceinline__ float h2lo(unsigned w) { return (float)__builtin_bit_cast(h16x2, w).x; }
__device__ __forceinline__ float h2hi(unsigned w) { return (float)__builtin_bit_cast(h16x2, w).y; }
struct Unit { int pm, pn; };
struct Gemm { const bf16_t* A; const bf16_t* Bt; int M, N, K; int lda = 0; };

struct StaticOrder {
    int nM, nN, nwg, G, c, wgm;
    __host__ __device__ void init(int M, int N, int G_, int c_, int wgm_ = WGM) { nM = M / BM; nN = N / BM; nwg = nM * nN; G = G_; c = c_; wgm = wgm_; }
    __host__ __device__ bool next(int i, Unit& u) const {
        const long L = (long)i * G + c; if (L >= nwg) return false;
        int wgid = (int)L; { const int q = nwg / NXCD, r = nwg % NXCD, xcd = wgid % NXCD, off = wgid / NXCD; wgid = (xcd < r ? xcd * (q + 1) : r * (q + 1) + (xcd - r) * q) + off; }
        const int nig = wgm * nN, gid = wgid / nig, fm = gid * wgm, gsz = (nM - fm) < wgm ? (nM - fm) : wgm;
        u.pm = fm + ((wgid % nig) % gsz); u.pn = (wgid % nig) / gsz; return true;
    }
    __device__ __forceinline__ void a_ready(const Unit&) const {}
    __device__ __forceinline__ void done(const Unit&) const {}
};

__device__ __forceinline__ unsigned cvt_pk_bf16(float lo, float hi) { unsigned r; asm volatile("v_cvt_pk_bf16_f32 %0, %1, %2" : "=v"(r) : "v"(lo), "v"(hi)); return r; }

__device__ __forceinline__ float sum_fq(float s) {
    s += __builtin_bit_cast(float, __builtin_amdgcn_ds_swizzle(__builtin_bit_cast(int, s), 0x401F));
    float a = s, b = s; asm volatile("s_nop 1\n\tv_permlane32_swap_b32 %0, %1\n\ts_nop 1" : "+v"(a), "+v"(b));
    return a + b;
}
constexpr float SS_SCALE = 1024.0f;
__device__ __forceinline__ void row_rstd(const unsigned* ss, int row0, int fq, float (&rs)[2][4]) {
#pragma unroll
    for (int ai = 0; ai < 2; ++ai)
#pragma unroll
        for (int m = 0; m < 4; ++m) rs[ai][m] = ss ? __builtin_amdgcn_rsqf((float)ss[row0 + ai * HALF + m * 16] * (1.0f / (SS_SCALE * 2048.0f)) + 1e-6f) : 1.0f;
}
__device__ __forceinline__ u32x4 bperm4(int a, u32x4 w) { u32x4 r; r.x = (unsigned)__builtin_amdgcn_ds_bpermute(a, (int)w.x); r.y = (unsigned)__builtin_amdgcn_ds_bpermute(a, (int)w.y); r.z = (unsigned)__builtin_amdgcn_ds_bpermute(a, (int)w.z); r.w = (unsigned)__builtin_amdgcn_ds_bpermute(a, (int)w.w); return r; }
#define PG8_STORE_PERM const int lane_ = fq * 16 + fr, pq = lane_ & 3, pr = 4 * ((lane_ >> 2) & 3) + (lane_ >> 4), bpa = 4 * (16 * pq + pr)
__device__ __forceinline__ void ss_load_rows(const unsigned* ss, int row0, unsigned (&raw)[8]) {
#pragma unroll
    for (int ai = 0; ai < 2; ++ai)
#pragma unroll
        for (int m = 0; m < 4; ++m) raw[ai * 4 + m] = ss ? ss[row0 + ai * HALF + m * 16] : 0u;
}
__device__ __forceinline__ void rs_from_raw(const unsigned* ss, const unsigned (&raw)[8], float (&rs)[2][4]) {
#pragma unroll
    for (int ai = 0; ai < 2; ++ai)
#pragma unroll
        for (int m = 0; m < 4; ++m) rs[ai][m] = ss ? __builtin_amdgcn_rsqf((float)raw[ai * 4 + m] * (1.0f / (SS_SCALE * 2048.0f)) + 1e-6f) : 1.0f;
}
__device__ __forceinline__ float wave_max_nn(float v) {
    v = fmaxf(v, __builtin_bit_cast(float, __builtin_amdgcn_update_dpp(0, __builtin_bit_cast(int, v), 0x111, 0xf, 0xf, true)));
    v = fmaxf(v, __builtin_bit_cast(float, __builtin_amdgcn_update_dpp(0, __builtin_bit_cast(int, v), 0x112, 0xf, 0xf, true)));
    v = fmaxf(v, __builtin_bit_cast(float, __builtin_amdgcn_update_dpp(0, __builtin_bit_cast(int, v), 0x114, 0xf, 0xf, true)));
    v = fmaxf(v, __builtin_bit_cast(float, __builtin_amdgcn_update_dpp(0, __builtin_bit_cast(int, v), 0x118, 0xf, 0xf, true)));
    v = fmaxf(v, __builtin_bit_cast(float, __builtin_amdgcn_update_dpp(0, __builtin_bit_cast(int, v), 0x142, 0xa, 0xf, false)));
    v = fmaxf(v, __builtin_bit_cast(float, __builtin_amdgcn_update_dpp(0, __builtin_bit_cast(int, v), 0x143, 0xc, 0xf, false)));
    return __builtin_bit_cast(float, __builtin_amdgcn_readlane(__builtin_bit_cast(int, v), 63));
}
template <bool F16_> struct EpiBf16T {
    static constexpr bool PERM = true, AFTER_DRAIN = false, APERM = false, F16 = F16_, KSCALE = false;
    bf16_t* O; int ldc; const unsigned* ss; unsigned* qn; PG8_LAS unsigned char* xl; int tpn = 0;
    static constexpr bool SS_PRE = true;
    __device__ __forceinline__ void ss_load(const Unit& u, int wr, int fr, unsigned (&raw)[8]) const { ss_load_rows(ss, u.pm * BM + wr * 64 + fr, raw); }
    __device__ __forceinline__ void operator()(const f32x4 (&acc)[2][2][4][2], const Unit& u, int wr, int wc, int fr, int fq, const unsigned (&raw)[8]) const {
        const int row0 = u.pm * BM + wr * 64 + fr; const int col0 = u.pn * BM + wc * 32 + 8 * fq;
        float rs[2][4]; rs_from_raw(ss, raw, rs);
#pragma unroll
        for (int ai = 0; ai < 2; ++ai)
#pragma unroll
            for (int m = 0; m < 4; ++m) { bf16_t* rowp = O + (size_t)(row0 + ai * HALF + m * 16) * ldc + col0;
#pragma unroll
                for (int bj = 0; bj < 2; ++bj) { const f32x4 v0 = acc[ai][bj][m][0] * rs[ai][m], v1 = acc[ai][bj][m][1] * rs[ai][m];
                    u32x4 w; w.x = cvt_pk_bf16(v0[0], v0[1]); w.y = cvt_pk_bf16(v0[2], v0[3]); w.z = cvt_pk_bf16(v1[0], v1[1]); w.w = cvt_pk_bf16(v1[2], v1[3]);
                    if (u.pn < tpn) *(u32x4*)(rowp + bj * HALF) = w;
                    else __builtin_nontemporal_store(w, (u32x4*)(rowp + bj * HALF));
                    if (qn != nullptr && u.pn < 6) {
                        float s = ((v0[0] * v0[0] + v0[1] * v0[1]) + (v0[2] * v0[2] + v0[3] * v0[3])) + ((v1[0] * v1[0] + v1[1] * v1[1]) + (v1[2] * v1[2] + v1[3] * v1[3]));
                        s = sum_fq(s);
                        if (fq == 0) *(PG8_LAS float*)(xl + (((bj * BM + ai * HALF + wr * 64 + m * 16 + fr) * 4 + wc) * 4)) = s; } } }
        if (qn != nullptr && u.pn < 6) {
            asm volatile("s_waitcnt lgkmcnt(0)" ::: "memory"); __builtin_amdgcn_s_barrier(); asm volatile("" ::: "memory");
            const int lane_ = fq * 16 + fr, tid_ = (wr * 4 + wc) * 64 + lane_, bj2 = tid_ >> 8, row = tid_ & 255;
            const f32x4 pp = *(const PG8_LAS f32x4*)(xl + ((bj2 * BM + row) * 4) * 4);
            float t = (pp[0] + pp[1]) + (pp[2] + pp[3]);
            t = wave_max_nn(t);
            if (lane_ == 0) atomicMax(qn + ((u.pm >> 4) * 12 + 2 * u.pn + bj2) * 16 + (u.pm & 15), __builtin_bit_cast(unsigned, t));
        }
    }
};
typedef EpiBf16T<false> EpiBf16; typedef EpiBf16T<false> EpiBf16H;
#if defined(PROBE_DRY)
struct EpiDry {
    static constexpr bool PERM = true, AFTER_DRAIN = false, APERM = false, F16 = false, KSCALE = false;
    float* sink;
    static constexpr bool SS_PRE = false;
    __device__ __forceinline__ void operator()(const f32x4 (&acc)[2][2][4][2], const Unit& u, int wr, int wc, int fr, int fq, const unsigned (&raw)[8]) const {
        int never = 0x7ffffff; asm volatile("" : "+s"(never));
        if (u.pm == never) { f32x4 s = (f32x4){0.f, 0.f, 0.f, 0.f};
#pragma unroll
            for (int ai = 0; ai < 2; ++ai)
#pragma unroll
                for (int bj = 0; bj < 2; ++bj)
#pragma unroll
                    for (int m = 0; m < 4; ++m) s += acc[ai][bj][m][0] + acc[ai][bj][m][1];
            *(f32x4*)(sink + (wr * 4 + wc) * 256 + (fq * 16 + fr) * 4) = s; }
    }
};
#endif
struct EpiSplit2 {
    static constexpr bool PERM = true, AFTER_DRAIN = false, APERM = false, F16 = false, KSCALE = false;
    bf16_t* O0; bf16_t* O1; int ldc; const unsigned* ss;
    static constexpr bool SS_PRE = true;
    __device__ __forceinline__ void ss_load(const Unit& u, int wr, int fr, unsigned (&raw)[8]) const { ss_load_rows(ss, u.pm * BM + wr * 64 + fr, raw); }
    __device__ __forceinline__ void operator()(const f32x4 (&acc)[2][2][4][2], const Unit& u, int wr, int wc, int fr, int fq, const unsigned (&raw)[8]) const {
        const int row0 = u.pm * BM + wr * 64 + fr; int colt = u.pn * BM; bf16_t* base = O0; if (colt >= ldc) { base = O1; colt -= ldc; }
        const int col0 = colt + wc * 32 + 8 * fq;
        float rs[2][4]; rs_from_raw(ss, raw, rs);
#pragma unroll
        for (int ai = 0; ai < 2; ++ai)
#pragma unroll
            for (int m = 0; m < 4; ++m) { bf16_t* rowp = base + (size_t)(row0 + ai * HALF + m * 16) * ldc + col0;
#pragma unroll
                for (int bj = 0; bj < 2; ++bj) { const f32x4 v0 = acc[ai][bj][m][0] * rs[ai][m], v1 = acc[ai][bj][m][1] * rs[ai][m];
                    u32x4 w; w.x = cvt_pk_bf16(v0[0], v0[1]); w.y = cvt_pk_bf16(v0[2], v0[3]); w.z = cvt_pk_bf16(v1[0], v1[1]); w.w = cvt_pk_bf16(v1[2], v1[3]);
                    __builtin_nontemporal_store(w, (u32x4*)(rowp + bj * HALF)); } }
    }
};
#ifndef EPI_RES_PERM
#define EPI_RES_PERM 0
#endif
#ifndef RES_BF16
#define RES_BF16 1
#endif
__device__ __forceinline__ f32x4 b4_to_f32(u32x2 w) { f32x4 r; r[0] = __builtin_bit_cast(float, w.x << 16); r[1] = __builtin_bit_cast(float, w.x & 0xffff0000u); r[2] = __builtin_bit_cast(float, w.y << 16); r[3] = __builtin_bit_cast(float, w.y & 0xffff0000u); return r; }
__device__ __forceinline__ f32x4 h4_to_f32(u32x2 w) { f32x4 r; r[0] = h2lo(w.x); r[1] = h2hi(w.x); r[2] = h2lo(w.y); r[3] = h2hi(w.y); return r; }
typedef float float2_t __attribute__((ext_vector_type(2)));
template <bool KS_> struct EpiResT {
    static constexpr bool PERM = true, AFTER_DRAIN = false, APERM = false, F16 = false, KSCALE = KS_;
    const float* base; bf16_t* xh; bf16_t* xb; unsigned* ssq; int ldc; const float* ssh; PG8_LAS unsigned char* rl; int ldx = 2048;
    static constexpr bool SS_PRE = false;
    __device__ __forceinline__ void unit_ratios(const Unit& u, int tid) const {
        const int row = tid >> 1, hp = tid & 1;
        const f32x4* p = (const f32x4*)(ssh + ((size_t)(u.pm * BM + row) * 4 + 2 * hp) * 24);
        f32x4 v[12];
#pragma unroll
        for (int i = 0; i < 12; ++i) v[i] = p[i];
        float sa = 0.f, sb = 0.f;
#pragma unroll
        for (int i = 0; i < 6; ++i) { sa += (v[i][0] + v[i][1]) + (v[i][2] + v[i][3]); sb += (v[6 + i][0] + v[6 + i][1]) + (v[6 + i][2] + v[6 + i][3]); }
        sa = __builtin_amdgcn_rsqf(sa * (1.0f / 384.0f) + 1e-6f); sb = __builtin_amdgcn_rsqf(sb * (1.0f / 384.0f) + 1e-6f);
        const float pa = __builtin_bit_cast(float, __builtin_amdgcn_update_dpp(0, __builtin_bit_cast(int, sa), 0xB1, 0xf, 0xf, true));
        const float r0 = sa * __builtin_amdgcn_rcpf(sb), r1 = hp ? sb : sb * __builtin_amdgcn_rcpf(pa);
        *(PG8_LAS float2_t*)(rl + (row * 4 + 2 * hp) * 4) = (float2_t){r0, r1};
    }
    __device__ __forceinline__ void kscale(f32x4 (&acc)[2][2][4][2], int idx, int wr, int fr) const {
#pragma unroll
        for (int ai = 0; ai < 2; ++ai)
#pragma unroll
            for (int m = 0; m < 4; ++m) { const float r = *(const PG8_LAS float*)(rl + ((ai * HALF + wr * 64 + m * 16 + fr) * 4 + idx) * 4);
#pragma unroll
                for (int bj = 0; bj < 2; ++bj) { acc[ai][bj][m][0] *= r; acc[ai][bj][m][1] *= r; } }
    }
    __device__ __forceinline__ void operator()(const f32x4 (&acc)[2][2][4][2], const Unit& u, int wr, int wc, int fr, int fq, const unsigned (&)[8]) const {
        const int row0 = u.pm * BM + wr * 64 + fr, col0 = u.pn * BM + wc * 32 + 8 * fq;
        if (base == nullptr) {
            u32x4 raw[2][4][2];
#pragma unroll
            for (int ai = 0; ai < 2; ++ai)
#pragma unroll
                for (int m = 0; m < 4; ++m) { const size_t off = (size_t)(row0 + ai * HALF + m * 16) * ldc + col0;
#pragma unroll
                    for (int bj = 0; bj < 2; ++bj) raw[ai][m][bj] = *(const u32x4*)((RES_BF16 ? xb : xh) + off + bj * HALF); }
#if EPI_RES_PERM
            PG8_STORE_PERM;
            const int srow0 = u.pm * BM + wr * 64 + pr, scol0 = u.pn * BM + wc * 32 + 8 * pq;
#else
            const int srow0 = row0, scol0 = col0;
#define bperm4(a, w) (w)
#endif
#pragma unroll
            for (int ai = 0; ai < 2; ++ai) {
#pragma unroll
                for (int m = 0; m < 4; ++m) { const size_t soff = (size_t)(srow0 + ai * HALF + m * 16) * ldc + scol0; float s = 0.f;
#pragma unroll
                    for (int bj = 0; bj < 2; ++bj) { const u32x4 r = raw[ai][m][bj];
                        const f32x4 v0 = (RES_BF16 ? b4_to_f32((u32x2){r.x, r.y}) : h4_to_f32((u32x2){r.x, r.y})) + acc[ai][bj][m][0], v1 = (RES_BF16 ? b4_to_f32((u32x2){r.z, r.w}) : h4_to_f32((u32x2){r.z, r.w})) + acc[ai][bj][m][1];
                        if (!RES_BF16) { u32x4 w; w.x = pkh2(v0[0], v0[1]); w.y = pkh2(v0[2], v0[3]); w.z = pkh2(v1[0], v1[1]); w.w = pkh2(v1[2], v1[3]); *(u32x4*)(xh + soff + bj * HALF) = bperm4(bpa, w); }
                        if (xb) { u32x4 wb; wb.x = cvt_pk_bf16(v0[0], v0[1]); wb.y = cvt_pk_bf16(v0[2], v0[3]); wb.z = cvt_pk_bf16(v1[0], v1[1]); wb.w = cvt_pk_bf16(v1[2], v1[3]); *(u32x4*)(xb + soff + bj * HALF) = bperm4(bpa, wb); }
                        s += ((v0[0] * v0[0] + v0[1] * v0[1]) + (v0[2] * v0[2] + v0[3] * v0[3])) + ((v1[0] * v1[0] + v1[1] * v1[1]) + (v1[2] * v1[2] + v1[3] * v1[3])); }
                    if (ssq) { s = sum_fq(s);
                    if (fq == 0) atomicAdd(ssq + row0 + ai * HALF + m * 16, (unsigned)(s * SS_SCALE + 0.5f)); } } }
#if !EPI_RES_PERM
#undef bperm4
#endif
            return;
        }
#pragma unroll
        for (int ai = 0; ai < 2; ++ai) {
            f32x4 b[4][2][2];
#pragma unroll
            for (int m = 0; m < 4; ++m) { const size_t off = (size_t)(row0 + ai * HALF + m * 16) * ldc + col0;
#pragma unroll
                for (int bj = 0; bj < 2; ++bj)
#pragma unroll
                    for (int n = 0; n < 2; ++n) {
                        if (base == nullptr) { if (n == 0) { const u32x4 w = *(const u32x4*)(xh + off + bj * HALF); b[m][bj][0] = h4_to_f32((u32x2){w.x, w.y}); b[m][bj][1] = h4_to_f32((u32x2){w.z, w.w}); } }
                        else b[m][bj][n] = *(const f32x4*)(base + (size_t)(row0 + ai * HALF + m * 16) * ldx + col0 + bj * HALF + n * 4); } }
#pragma unroll
            for (int m = 0; m < 4; ++m) { const size_t off = (size_t)(row0 + ai * HALF + m * 16) * ldc + col0; float s = 0.f;
#pragma unroll
                for (int bj = 0; bj < 2; ++bj) { const f32x4 v0 = b[m][bj][0] + acc[ai][bj][m][0], v1 = b[m][bj][1] + acc[ai][bj][m][1];
                    if (!RES_BF16) { u32x4 w; w.x = pkh2(v0[0], v0[1]); w.y = pkh2(v0[2], v0[3]); w.z = pkh2(v1[0], v1[1]); w.w = pkh2(v1[2], v1[3]); *(u32x4*)(xh + off + bj * HALF) = w; }
                    if (xb) { u32x4 wb; wb.x = cvt_pk_bf16(v0[0], v0[1]); wb.y = cvt_pk_bf16(v0[2], v0[3]); wb.z = cvt_pk_bf16(v1[0], v1[1]); wb.w = cvt_pk_bf16(v1[2], v1[3]); *(u32x4*)(xb + off + bj * HALF) = wb; }
                    s += ((v0[0] * v0[0] + v0[1] * v0[1]) + (v0[2] * v0[2] + v0[3] * v0[3])) + ((v1[0] * v1[0] + v1[1] * v1[1]) + (v1[2] * v1[2] + v1[3] * v1[3])); }
                if (ssq) { s = sum_fq(s);
                if (fq == 0) atomicAdd(ssq + row0 + ai * HALF + m * 16, (unsigned)(s * SS_SCALE + 0.5f)); } }
            asm volatile("" ::: "memory"); }
    }
};
typedef EpiResT<false> EpiRes; typedef EpiResT<true> EpiResK;

template <int CTRL> __device__ __forceinline__ float dpp_keep(float old, float src) {
    return __builtin_bit_cast(float, __builtin_amdgcn_update_dpp(__builtin_bit_cast(int, old), __builtin_bit_cast(int, src), CTRL, 0xf, 0xf, false)); }
template <int CTRL> __device__ __forceinline__ f32x4 dpp_keep4(f32x4 old, f32x4 src) { f32x4 r; r[0] = dpp_keep<CTRL>(old[0], src[0]); r[1] = dpp_keep<CTRL>(old[1], src[1]); r[2] = dpp_keep<CTRL>(old[2], src[2]); r[3] = dpp_keep<CTRL>(old[3], src[3]); return r; }
__device__ __forceinline__ float silu_f(float x) { return x * __builtin_amdgcn_rcpf(1.0f + __builtin_amdgcn_exp2f(-1.4426950408889634f * x)); }
struct EpiConv {
    static constexpr bool PERM = true, AFTER_DRAIN = false, APERM = true, F16 = false, KSCALE = false;
    bf16_t* G; float* halo; const float* cw; const float* cb; PG8_LAS unsigned char* xch; const unsigned* ss; int ldg;
    static __device__ __forceinline__ int xidx(int blk, int rr, int bj, int wc, int fq, int n) { return ((((blk * 2 + rr) * 2 + bj) * 4 + wc) * 4 + fq) * 2 + n; }
    static constexpr bool SS_PRE = true;
    __device__ __forceinline__ void ss_load(const Unit& u, int wr, int fr, unsigned (&raw)[8]) const {
#pragma unroll
        for (int ai = 0; ai < 2; ++ai) { const u32x4 w = *(const u32x4*)(ss + u.pm * BM + wr * 64 + 4 * fr + ai * HALF); raw[ai * 4 + 0] = w.x; raw[ai * 4 + 1] = w.y; raw[ai * 4 + 2] = w.z; raw[ai * 4 + 3] = w.w; }
    }
    __device__ __forceinline__ void operator()(const f32x4 (&acc)[2][2][4][2], const Unit& u, int wr, int wc, int fr, int fq, const unsigned (&raw)[8]) const {
        constexpr int FF = 5632, N2 = 11264;
        PG8_LAS f32x4* X = (PG8_LAS f32x4*)xch;
        const int rowb = u.pm * BM + wr * 64 + 4 * fr;
        float rs[2][4];
#pragma unroll
        for (int ai = 0; ai < 2; ++ai)
#pragma unroll
            for (int m = 0; m < 4; ++m) rs[ai][m] = __builtin_amdgcn_rsqf((float)raw[ai * 4 + m] * (1.0f / (SS_SCALE * 2048.0f)) + 1e-6f);
        if (fr == 15) {
#pragma unroll
            for (int ai = 0; ai < 2; ++ai)
#pragma unroll
                for (int rr = 0; rr < 2; ++rr)
#pragma unroll
                    for (int bj = 0; bj < 2; ++bj)
#pragma unroll
                        for (int n = 0; n < 2; ++n) X[xidx(ai * 2 + wr, rr, bj, wc, fq, n)] = acc[ai][bj][2 + rr][n] * rs[ai][2 + rr];
        }
        if (wr == 0 && fr == 0) {
#pragma unroll
            for (int rr = 0; rr < 2; ++rr)
#pragma unroll
                for (int bj = 0; bj < 2; ++bj)
#pragma unroll
                    for (int n = 0; n < 2; ++n) *(f32x4*)(halo + (size_t)(u.pm * 4 + rr) * N2 + u.pn * 256 + bj * 128 + wc * 32 + 8 * fq + 4 * n) = acc[0][bj][rr][n] * rs[0][rr];
        }
        if (wr == 1 && fr == 15) {
#pragma unroll
            for (int rr = 0; rr < 2; ++rr)
#pragma unroll
                for (int bj = 0; bj < 2; ++bj)
#pragma unroll
                    for (int n = 0; n < 2; ++n) *(f32x4*)(halo + (size_t)(u.pm * 4 + 2 + rr) * N2 + u.pn * 256 + bj * 128 + wc * 32 + 8 * fq + 4 * n) = acc[1][bj][2 + rr][n] * rs[1][2 + rr];
        }
        asm volatile("s_waitcnt lgkmcnt(0)" ::: "memory"); __builtin_amdgcn_s_barrier(); asm volatile("" ::: "memory");
        u32x2 hold[2][4];
#pragma unroll
        for (int n = 0; n < 2; ++n) {
            const int c0 = u.pn * 128 + wc * 32 + 8 * fq + 4 * n;
            const f32x4 wa0 = *(const f32x4*)(cw + c0), wa1 = *(const f32x4*)(cw + N2 + c0), wa2 = *(const f32x4*)(cw + 2 * N2 + c0), ba = *(const f32x4*)(cb + c0);
            const f32x4 wv0 = *(const f32x4*)(cw + FF + c0), wv1 = *(const f32x4*)(cw + N2 + FF + c0), wv2 = *(const f32x4*)(cw + 2 * N2 + FF + c0), bv = *(const f32x4*)(cb + FF + c0);
#pragma unroll
            for (int ai = 0; ai < 2; ++ai) {
                const int blk = ai * 2 + wr;
                f32x4 xa1 = (f32x4){0.f, 0.f, 0.f, 0.f}, xa2 = xa1, xv1 = xa1, xv2 = xa1;
                if (blk > 0) { xa2 = X[xidx(blk - 1, 0, 0, wc, fq, n)]; xa1 = X[xidx(blk - 1, 1, 0, wc, fq, n)]; xv2 = X[xidx(blk - 1, 0, 1, wc, fq, n)]; xv1 = X[xidx(blk - 1, 1, 1, wc, fq, n)]; }
                f32x4 ua[4], uv[4];
#pragma unroll
                for (int m = 0; m < 4; ++m) { ua[m] = acc[ai][0][m][n] * rs[ai][m]; uv[m] = acc[ai][1][m][n] * rs[ai][m]; }
                const f32x4 sa3 = dpp_keep4<0x111>(xa1, ua[3]), sa2 = dpp_keep4<0x111>(xa2, ua[2]);
                const f32x4 sv3 = dpp_keep4<0x111>(xv1, uv[3]), sv2 = dpp_keep4<0x111>(xv2, uv[2]);
#pragma unroll
                for (int m = 0; m < 4; ++m) {
                    const f32x4 pa1 = m == 0 ? sa3 : ua[m > 0 ? m - 1 : 0], pa2 = m == 0 ? sa2 : (m == 1 ? sa3 : ua[m > 1 ? m - 2 : 0]);
                    const f32x4 pv1 = m == 0 ? sv3 : uv[m > 0 ? m - 1 : 0], pv2 = m == 0 ? sv2 : (m == 1 ? sv3 : uv[m > 1 ? m - 2 : 0]);
                    const f32x4 ya = wa0 * pa2 + wa1 * pa1 + wa2 * ua[m] + ba;
                    const f32x4 yv = wv0 * pv2 + wv1 * pv1 + wv2 * uv[m] + bv;
                    const f32x4 tq = ya * -1.4426950408889634f; f32x4 eq; eq[0] = __builtin_amdgcn_exp2f(tq[0]); eq[1] = __builtin_amdgcn_exp2f(tq[1]); eq[2] = __builtin_amdgcn_exp2f(tq[2]); eq[3] = __builtin_amdgcn_exp2f(tq[3]);
                    const f32x4 dq = eq + 1.0f; f32x4 rq; rq[0] = __builtin_amdgcn_rcpf(dq[0]); rq[1] = __builtin_amdgcn_rcpf(dq[1]); rq[2] = __builtin_amdgcn_rcpf(dq[2]); rq[3] = __builtin_amdgcn_rcpf(dq[3]);
                    const f32x4 g = (ya * rq) * yv;
                    u32x2 w; w.x = cvt_pk_bf16(g[0], g[1]); w.y = cvt_pk_bf16(g[2], g[3]);
                    if (n == 0) hold[ai][m] = w;
                    else { u32x4 o; o.x = hold[ai][m].x; o.y = hold[ai][m].y; o.z = w.x; o.w = w.y;
                        __builtin_nontemporal_store(o, (u32x4*)(G + (size_t)(rowb + ai * HALF + m) * ldg + u.pn * 128 + wc * 32 + 8 * fq)); }
                }
            }
        }
    }
};
template <class Epi, class Sched, bool ALIGN_EPI = false, bool SP2 = false>
__device__ __forceinline__ void gemm_phase(PG8_LAS unsigned char* lds, const Gemm g, const Sched& S, const Epi& E, const int wave_in) {
    const int tid = opaque_tid(wave_in), wid = wave_in, lane = tid & 63, wr = wid >> 2, wc = wid & 3, fr = lane & 15, fq = lane >> 4;
    const int K = g.K, nt = K / BK;
    const int lda = g.lda ? g.lda : K;
    unsigned voffA[2], voffB[2];
#pragma unroll
    for (int i = 0; i < 2; ++i) { int R, C; stage_rc(tid * 16 + i * 8192, R, C); const int Rb = Epi::PERM ? ((R & ~31) + perm32(R & 31)) : R;
        const int Ra = Epi::APERM ? ((R & ~63) + 4 * (R & 15) + ((R >> 4) & 3)) : R;
        voffA[i] = (unsigned)(Ra * lda + C) * 2u; voffB[i] = (unsigned)(Rb * K + C) * 2u; }
    const size_t kstep = (size_t)(BK * 2);
    const size_t hstepA = (size_t)HALF * lda * 2, hstepB = (size_t)HALF * K * 2;
    const size_t tstepA = 2 * hstepA, tstepB = 2 * hstepB;
    const unsigned ldsw = (unsigned)wid * 1024u;
    const int aoff = lds_byte(wr * 64 + fr, fq * 8), boff = lds_byte(wc * 32 + fr, fq * 8);
#define PG8_SA(b, h) (((b) * 2 + (h)) * HTB)
#define PG8_SB(b, h) ((4 + (b) * 2 + (h)) * HTB)
#define PG8_STAGE(bufoff, gbase, voff) do { _Pragma("unroll") for (int _i = 0; _i < 2; ++_i) \
        __builtin_amdgcn_global_load_lds((const unsigned*)((const char*)(gbase) + (voff)[_i]), (PG8_LAS unsigned*)(lds + (bufoff) + ldsw + _i * 8192), 16, 0, 0); } while (0)
#define PG8_LDA(dst, b, h) do { _Pragma("unroll") for (int m = 0; m < 4; ++m) _Pragma("unroll") for (int k = 0; k < 2; ++k) dst[m][k] = *(const PG8_LAS bf16x8*)(lds + PG8_SA(b, h) + aoff + m * 2048 + k * 1024); } while (0)
#define PG8_LDB(dst, b, h) do { _Pragma("unroll") for (int n = 0; n < 2; ++n) _Pragma("unroll") for (int k = 0; k < 2; ++k) dst[n][k] = *(const PG8_LAS bf16x8*)(lds + PG8_SB(b, h) + boff + n * 2048 + k * 1024); } while (0)
#define PG8_MMA(ai, bj, At, Bt) do { __builtin_amdgcn_s_setprio(1); _Pragma("unroll") for (int m = 0; m < 4; ++m) _Pragma("unroll") for (int n = 0; n < 2; ++n) _Pragma("unroll") for (int k = 0; k < 2; ++k) \
        acc[ai][bj][m][n] = mfma16<Epi::F16>(Bt[n][k], At[m][k], acc[ai][bj][m][n]); __builtin_amdgcn_s_setprio(0); } while (0)
#define PG8_WAIT_V(n) asm volatile("s_waitcnt vmcnt(" #n ")" ::: "memory")
#define PG8_WAIT_L(n) asm volatile("s_waitcnt lgkmcnt(" #n ")" ::: "memory")
#define PG8_BAR __builtin_amdgcn_s_barrier()
#define PG8_SCHED __builtin_amdgcn_sched_barrier(0)
    Unit cur, nxt; int ui = 0;
    if (!S.next(0, cur)) return;
    f32x4 acc[2][2][4][2];
#pragma unroll
    for (int a = 0; a < 2; ++a)
#pragma unroll
        for (int b = 0; b < 2; ++b)
#pragma unroll
            for (int m = 0; m < 4; ++m)
#pragma unroll
                for (int n = 0; n < 2; ++n) acc[a][b][m][n] = (f32x4){0.f, 0.f, 0.f, 0.f};
    bf16x8 At[4][2], B0[2][2], B1[2][2];
    const char* cA = (const char*)g.A + (size_t)cur.pm * tstepA; const char* cB = (const char*)g.Bt + (size_t)cur.pn * tstepB;
    unsigned ssraw[8] = {0u, 0u, 0u, 0u, 0u, 0u, 0u, 0u};
    if constexpr (Epi::KSCALE) E.unit_ratios(cur, tid);
    if constexpr (Epi::SS_PRE) E.ss_load(cur, wr, fr, ssraw);
    S.a_ready(cur);
    if constexpr (SP2) {
        PG8_STAGE(PG8_SB(0, 0), cB, voffB); PG8_STAGE(PG8_SB(0, 1), cB + hstepB, voffB); PG8_STAGE(PG8_SA(0, 0), cA, voffA); PG8_STAGE(PG8_SA(0, 1), cA + hstepA, voffA);
        if (wr == 1) PG8_BAR;
        PG8_WAIT_V(2); PG8_BAR;
        PG8_STAGE(PG8_SB(1, 0), cB + kstep, voffB); PG8_STAGE(PG8_SA(1, 0), cA + kstep, voffA); PG8_STAGE(PG8_SB(1, 1), cB + hstepB + kstep, voffB);
        PG8_WAIT_V(6); PG8_BAR;
    } else {
        PG8_STAGE(PG8_SB(0, 0), cB, voffB); PG8_STAGE(PG8_SA(0, 0), cA, voffA); PG8_STAGE(PG8_SB(0, 1), cB + hstepB, voffB); PG8_STAGE(PG8_SA(0, 1), cA + hstepA, voffA);
        if (wr == 1) PG8_BAR;
        PG8_WAIT_V(4); PG8_BAR;
        PG8_STAGE(PG8_SB(1, 0), cB + kstep, voffB); PG8_STAGE(PG8_SA(1, 0), cA + kstep, voffA); PG8_STAGE(PG8_SB(1, 1), cB + hstepB + kstep, voffB);
        PG8_WAIT_V(6); PG8_BAR;
    }
    for (;;) {
        const bool has_next = S.next(ui + 1, nxt);
        const char* nA = has_next ? (const char*)g.A + (size_t)nxt.pm * tstepA : cA; const char* nB = has_next ? (const char*)g.Bt + (size_t)nxt.pn * tstepB : cB;
        for (int t = 0; t < nt; t += 2) {
            const bool last = (t == nt - 2);
            const char* a1 = cA + (size_t)(t + 1) * kstep;
            const char* a2 = last ? nA : cA + (size_t)(t + 2) * kstep; const char* b2 = last ? nB : cB + (size_t)(t + 2) * kstep;
            const char* a3 = a2 + kstep; const char* b3 = b2 + kstep;
            if (last && has_next) S.a_ready(nxt);
            if constexpr (Epi::KSCALE) { if (t == 6 || t == 12 || t == 18 || t == 24) E.kscale(acc, t / 6 - 1, wr, fr); }
            if constexpr (SP2) {
            PG8_LDB(B0, 0, 0); PG8_LDB(B1, 0, 1); PG8_SCHED; PG8_LDA(At, 0, 0); PG8_STAGE(PG8_SA(1, 1), a1 + hstepA, voffA);
            PG8_WAIT_V(8); PG8_WAIT_L(0); PG8_BAR; PG8_MMA(0, 0, At, B0); PG8_MMA(0, 1, At, B1); PG8_BAR; PG8_SCHED;
            PG8_LDA(At, 0, 1); PG8_STAGE(PG8_SB(0, 0), b2, voffB); PG8_STAGE(PG8_SB(0, 1), b2 + hstepB, voffB); PG8_STAGE(PG8_SA(0, 0), a2, voffA);
            PG8_WAIT_V(8); PG8_WAIT_L(0); PG8_BAR; PG8_MMA(1, 0, At, B0); PG8_MMA(1, 1, At, B1); PG8_BAR; PG8_SCHED;
            PG8_LDB(B0, 1, 0); PG8_LDB(B1, 1, 1); PG8_SCHED; PG8_LDA(At, 1, 0); PG8_STAGE(PG8_SA(0, 1), a2 + hstepA, voffA);
            PG8_WAIT_V(8); PG8_WAIT_L(0); PG8_BAR; PG8_MMA(0, 0, At, B0); PG8_MMA(0, 1, At, B1); PG8_BAR; PG8_SCHED;
            PG8_LDA(At, 1, 1); PG8_STAGE(PG8_SB(1, 0), b3, voffB); PG8_STAGE(PG8_SB(1, 1), b3 + hstepB, voffB); PG8_STAGE(PG8_SA(1, 0), a3, voffA);
            PG8_WAIT_V(8); PG8_WAIT_L(0); PG8_BAR; PG8_MMA(1, 0, At, B0); PG8_MMA(1, 1, At, B1); PG8_BAR; PG8_SCHED;
            } else {
            PG8_LDB(B0, 0, 0); PG8_SCHED; PG8_LDA(At, 0, 0); PG8_STAGE(PG8_SA(1, 1), a1 + hstepA, voffA);
            PG8_WAIT_L(8); PG8_BAR; PG8_WAIT_L(0); PG8_MMA(0, 0, At, B0); PG8_BAR; PG8_SCHED;
            PG8_LDB(B1, 0, 1); PG8_STAGE(PG8_SB(0, 0), b2, voffB);
            PG8_BAR; PG8_WAIT_L(0); PG8_MMA(0, 1, At, B1); PG8_BAR;
            PG8_LDA(At, 0, 1); PG8_STAGE(PG8_SA(0, 0), a2, voffA);
            PG8_BAR; PG8_WAIT_L(0); PG8_MMA(1, 0, At, B0); PG8_BAR; PG8_SCHED;
            PG8_STAGE(PG8_SB(0, 1), b2 + hstepB, voffB);
            PG8_WAIT_V(6); PG8_BAR; PG8_MMA(1, 1, At, B1); PG8_BAR;
            PG8_LDB(B0, 1, 0); PG8_SCHED; PG8_LDA(At, 1, 0); PG8_STAGE(PG8_SA(0, 1), a2 + hstepA, voffA);
            PG8_WAIT_L(8); PG8_BAR; PG8_WAIT_L(0); PG8_MMA(0, 0, At, B0); PG8_BAR; PG8_SCHED;
            PG8_LDB(B1, 1, 1); PG8_STAGE(PG8_SB(1, 0), b3, voffB);
            PG8_BAR; PG8_WAIT_L(0); PG8_MMA(0, 1, At, B1); PG8_BAR;
            PG8_LDA(At, 1, 1); PG8_STAGE(PG8_SA(1, 0), a3, voffA);
            PG8_BAR; PG8_WAIT_L(0); PG8_MMA(1, 0, At, B0); PG8_BAR; PG8_SCHED;
            PG8_STAGE(PG8_SB(1, 1), b3 + hstepB, voffB);
            PG8_WAIT_V(6); PG8_BAR; PG8_MMA(1, 1, At, B1); PG8_BAR;
            }
        }
        if constexpr (ALIGN_EPI) { if (wr == 0) PG8_BAR; }
        if constexpr (!Epi::AFTER_DRAIN) { E(acc, cur, wr, wc, fr, fq, ssraw); S.done(cur); if constexpr (Epi::SS_PRE) { if (has_next) E.ss_load(nxt, wr, fr, ssraw); }
            if constexpr (Epi::KSCALE) { if (has_next) E.unit_ratios(nxt, tid); } }
        if (!has_next) break;
#pragma unroll
        for (int a = 0; a < 2; ++a)
#pragma unroll
            for (int b = 0; b < 2; ++b)
#pragma unroll
                for (int m = 0; m < 4; ++m)
#pragma unroll
                    for (int n = 0; n < 2; ++n) acc[a][b][m][n] = (f32x4){0.f, 0.f, 0.f, 0.f};
        cur = nxt; cA = nA; cB = nB; ++ui;
        if constexpr (ALIGN_EPI) { if (wr == 1) PG8_BAR; }
    }
    PG8_WAIT_V(0);
    if constexpr (!ALIGN_EPI) { if (wr == 0) PG8_BAR; }
    PG8_BAR;
    if constexpr (Epi::AFTER_DRAIN) { E.fused(acc, cur, wr, wc, fr, fq, lds, wid, lane); S.done(cur); }
#undef PG8_SA
#undef PG8_SB
#undef PG8_STAGE
#undef PG8_LDA
#undef PG8_LDB
#undef PG8_MMA
#undef PG8_WAIT_V
#undef PG8_WAIT_L
#undef PG8_BAR
#undef PG8_SCHED
}
}
namespace att {
typedef unsigned short bf16;
typedef short bf16x8 __attribute__((ext_vector_type(8)));
typedef short s16x4 __attribute__((ext_vector_type(4)));
typedef float f32x16 __attribute__((ext_vector_type(16)));
typedef float f32x4 __attribute__((ext_vector_type(4)));
typedef unsigned u32x4 __attribute__((ext_vector_type(4)));
#define LASP __attribute__((address_space(3)))
constexpr int D = 128;
constexpr float SCALE = 0.08838834764831845f, INV_SCALE = 11.313708498984761f;
constexpr float THR = 8.f;
constexpr int NW = 8, QBLK = 32, KVBLK = 64, QB = NW * QBLK;
constexpr int SHM_V = KVBLK * D * 2, SHM_K = KVBLK * D * 2;
constexpr int BIAS_OFF = 2 * SHM_V + 2 * SHM_K + NW * 64 * 4;
constexpr int LDS_BYTES = BIAS_OFF + 2 * 64 * 4;
constexpr int WBIG = 1 << 30;

#define KSWZ(row, colB) ((row) * 256 + ((colB) ^ (((row) & 7) << 4)))
#define SBAR() __builtin_amdgcn_sched_barrier(0)
__device__ __forceinline__ int v_st(int k, int c) { const int kk = (k & ~0xC) | ((k & 4) << 1) | ((k & 8) >> 1); return ((kk >> 3) * 4 + (c >> 5)) * 512 + ((kk & 7) * 32 + (c & 31)) * 2; }
__device__ __forceinline__ int v_rd_base(int lane) { return ((lane & 3) << 3) | (((lane >> 2) & 3) << 6) | (((lane >> 4) & 1) << 5) | (((lane >> 5) & 1) << 8); }
constexpr int v_rd_off(int d0, int ks, int half) { return d0 * 512 + ks * 4096 + half * 2048; }
__device__ __forceinline__ int crow(int r, int hi) { return (r & 3) + 8 * (r >> 2) + 4 * hi; }
__device__ __forceinline__ unsigned cvtpk(float lo, float hi) { unsigned r; asm volatile("v_cvt_pk_bf16_f32 %0, %1, %2" : "=v"(r) : "v"(lo), "v"(hi)); return r; }
__device__ __forceinline__ bf16x8 load8(const bf16* p) { return *reinterpret_cast<const bf16x8*>(p); }
__device__ __forceinline__ void mask_tile(f32x16& p0, f32x16& p1, int dq, unsigned W) {
    const float NEG = -__builtin_inff();
#pragma unroll
    for (int r = 0; r < 16; ++r) {
        const int c = (r & 3) + 8 * (r >> 2);
        if ((unsigned)(dq - c) >= W) p0[r] = NEG;
        if ((unsigned)(dq - c - 32) >= W) p1[r] = NEG;
    }
}
__device__ __forceinline__ void partialSM(f32x16& p0, f32x16& p1, float& m_reg, float& mn, float& alpha) {
    float pmax = p0[0]; for (int r = 1; r < 16; ++r) pmax = fmaxf(pmax, p0[r]); for (int r = 0; r < 16; ++r) pmax = fmaxf(pmax, p1[r]);
    { auto rr = __builtin_amdgcn_permlane32_swap(__float_as_uint(pmax), __float_as_uint(pmax), false, false);
      pmax = fmaxf(__uint_as_float(rr[0]), __uint_as_float(rr[1])); }
    constexpr float C2 = 1.4426950408889634f * SCALE;
    if (__builtin_expect(__all((pmax - m_reg) * SCALE <= THR), 1)) { mn = m_reg; alpha = 1.f; }
    else { mn = fmaxf(m_reg, pmax); alpha = __builtin_amdgcn_exp2f((m_reg - mn) * C2); m_reg = mn; }
    const float mnL = -mn * C2;
    for (int r = 0; r < 16; ++r) p0[r] = fmaf(p0[r], C2, mnL); for (int r = 0; r < 16; ++r) p1[r] = fmaf(p1[r], C2, mnL);
    for (int r = 0; r < 16; ++r) p0[r] = __builtin_amdgcn_exp2f(p0[r]);
}
__device__ __forceinline__ void finishSM(f32x16& p0, f32x16& p1, float alpha, float& l_reg, bf16x8& pa0, bf16x8& pa1, bf16x8& pa2, bf16x8& pa3) {
    for (int r = 0; r < 16; ++r) p1[r] = __builtin_amdgcn_exp2f(p1[r]);
    float ps = 0; for (int r = 0; r < 16; ++r) ps += p0[r]; for (int r = 0; r < 16; ++r) ps += p1[r];
    { auto rr = __builtin_amdgcn_permlane32_swap(__float_as_uint(ps), __float_as_uint(ps), false, false);
      ps = __uint_as_float(rr[0]) + __uint_as_float(rr[1]); }
    l_reg = l_reg * alpha + ps;
#define PK4(P, B_, OUT) do { unsigned a0 = cvtpk(P[B_+0], P[B_+1]), a1 = cvtpk(P[B_+2], P[B_+3]);                          \
        unsigned b0 = cvtpk(P[B_+4], P[B_+5]), b1 = cvtpk(P[B_+6], P[B_+7]);                                             \
        auto r0 = __builtin_amdgcn_permlane32_swap(a0, b0, false, false); auto r1 = __builtin_amdgcn_permlane32_swap(a1, b1, false, false); \
        u32x4 w = {r0[0], r1[0], r0[1], r1[1]}; OUT = *reinterpret_cast<bf16x8*>(&w); } while (0)
    PK4(p0, 0, pa0); PK4(p0, 8, pa1); PK4(p1, 0, pa2); PK4(p1, 8, pa3);
#undef PK4
}
template <int KB>
__device__ __forceinline__ void qkt(f32x16& p0, f32x16& p1, const char* K_lds, const char* B_lds, int r32, int hi, const bf16x8* qr) {
    p0 = *reinterpret_cast<const f32x16*>(B_lds + KB * 256 + hi * 64); p1 = *reinterpret_cast<const f32x16*>(B_lds + KB * 256 + 128 + hi * 64);
    const char* kb[4];
#pragma unroll
    for (int dd = 0; dd < 4; ++dd) kb[dd] = K_lds + KB * SHM_K + KSWZ(r32, (dd * 16 + hi * 8) * 2);
#pragma unroll
    for (int d0 = 0; d0 < 8; ++d0) { const char* a = kb[d0 & 3] + (d0 >> 2) * 128;
        bf16x8 b0 = *reinterpret_cast<const bf16x8*>(a);
        bf16x8 b1 = *reinterpret_cast<const bf16x8*>(a + 32 * 256);
        p0 = __builtin_amdgcn_mfma_f32_32x32x16_bf16(b0, qr[d0], p0, 0, 0, 0);
        p1 = __builtin_amdgcn_mfma_f32_32x32x16_bf16(b1, qr[d0], p1, 0, 0, 0); }
}
template <int VB>
__device__ __forceinline__ void pv_tile(f32x16* o, int vb0, bf16x8 pa0, bf16x8 pa1, bf16x8 pa2, bf16x8 pa3) {
#define TRRD(dst, off) asm volatile("ds_read_b64_tr_b16 %0, %1 offset:%2" : "=&v"(dst) : "v"(vb0), "i"(off) : "memory")
#define PV_D0(d0) do { s16x4 l0, l1, l2, l3, h0, h1, h2, h3; constexpr int b_ = VB * SHM_V + v_rd_off(d0, 0, 0);   \
        TRRD(l0, b_); TRRD(h0, b_ + 2048); TRRD(l1, b_ + 4096); TRRD(h1, b_ + 6144); TRRD(l2, b_ + 8192); TRRD(h2, b_ + 10240); TRRD(l3, b_ + 12288); TRRD(h3, b_ + 14336); \
        asm volatile("s_waitcnt lgkmcnt(0)" ::: "memory"); SBAR();   \
        o[d0] = __builtin_amdgcn_mfma_f32_32x32x16_bf16(pa0, (bf16x8){l0[0], l0[1], l0[2], l0[3], h0[0], h0[1], h0[2], h0[3]}, o[d0], 0, 0, 0);   \
        o[d0] = __builtin_amdgcn_mfma_f32_32x32x16_bf16(pa1, (bf16x8){l1[0], l1[1], l1[2], l1[3], h1[0], h1[1], h1[2], h1[3]}, o[d0], 0, 0, 0);   \
        o[d0] = __builtin_amdgcn_mfma_f32_32x32x16_bf16(pa2, (bf16x8){l2[0], l2[1], l2[2], l2[3], h2[0], h2[1], h2[2], h2[3]}, o[d0], 0, 0, 0);   \
        o[d0] = __builtin_amdgcn_mfma_f32_32x32x16_bf16(pa3, (bf16x8){l3[0], l3[1], l3[2], l3[3], h3[0], h3[1], h3[2], h3[3]}, o[d0], 0, 0, 0); } while (0)
    PV_D0(0); PV_D0(1); PV_D0(2); PV_D0(3);
#undef PV_D0
#undef TRRD
}
struct BlockRef { const bf16* Q; const bf16* K; const bf16* V; bf16* O; const float* cb; int qs, kvs, os, P0, skv, jlo; };
struct Seam { bf16x8 qr[8]; bf16x8 st_v0, st_v1, st_k0, st_k1; };
#define ROW(p, k0, rr, st) ((p) + (int)((k0) * (st)) + (int)((rr) * (st) + sc))
#define VMW() asm volatile("s_waitcnt vmcnt(0)" ::: "memory")
#define VMWN(n) asm volatile("s_waitcnt vmcnt(%0)" :: "i"(n) : "memory")
#define SLOAD_H(B_, k0, bf) do { S.st_v0 = load8(ROW((B_).V, k0, sr, (B_).kvs)); S.st_v1 = load8(ROW((B_).V, k0, 32 + sr, (B_).kvs));              \
                         S.st_k0 = load8(ROW((B_).K, k0, sr, (B_).kvs)); S.st_k1 = load8(ROW((B_).K, k0, 32 + sr, (B_).kvs));                \
                         if (wid == 0) __builtin_amdgcn_global_load_lds((const unsigned*)((B_).cb + (k0) + bias_key(lane)), (LASP unsigned*)(B_lds + (bf) * 256), 4, 0, 0); } while (0)
#define SWRITE_HK(bf, cref_) do { *(bf16x8*)(K_lds + (bf) * SHM_K + kws) = S.st_k0; *(bf16x8*)(K_lds + (bf) * SHM_K + kws + 32 * 256) = S.st_k1; } while (0)
#define SWRITE_HV(bf) do { *(bf16x8*)(V_lds + (bf) * SHM_V + vst0) = S.st_v0; *(bf16x8*)(V_lds + (bf) * SHM_V + vst1) = S.st_v1; } while (0)
#define SWRITE_H(bf, cref_) do { SWRITE_HV(bf); SWRITE_HK(bf, cref_); } while (0)
__device__ __forceinline__ int bias_key(int L) { const int p = L >> 5, hi = (L >> 4) & 1, r = L & 15; return 32 * p + (r & 3) + 8 * (r >> 2) + 4 * hi; }
__device__ __forceinline__ void attn_prime(const BlockRef& cur, char* lds, Seam& S, const int wave_in) {
    const int tid = opaque_tid(wave_in), wid = wave_in, lane = tid & 63, r32 = lane & 31, hi = lane >> 5;
    const int sr = tid >> 4, sc = (tid & 15) * 8, kws = KSWZ(sr, sc * 2); char* K_lds = lds + 2 * SHM_V; char* B_lds = lds + BIAS_OFF;
    for (int d0 = 0; d0 < 8; ++d0) S.qr[d0] = load8(cur.Q + (int)((wid * QBLK + r32) * cur.qs + hi * 8) + d0 * 16);
    SLOAD_H(cur, cur.jlo * KVBLK, 0); VMW(); SWRITE_HK(0, 0);
    __syncthreads();
}
__device__ __forceinline__ void attn_block(const BlockRef& cur, const BlockRef& nxt, char* lds, Seam& S, const int wave_in) {
    const int tid = opaque_tid(wave_in), wid = wave_in, lane = tid & 63, r32 = lane & 31, hi = lane >> 5;
    constexpr int W = WBIG;
    int j_hi = (cur.P0 + QB - 1) / KVBLK + 1; if (j_hi > cur.skv / KVBLK) j_hi = cur.skv / KVBLK;
    const int j_lo = cur.jlo; const int NT = j_hi - j_lo;
    const int qlo = cur.P0 + wid * QBLK, qm = qlo + r32 - 4 * hi;
    char* V_lds = lds; char* K_lds = lds + 2 * SHM_V; char* B_lds = lds + BIAS_OFF;
    float* ws = (float*)(lds + 2 * SHM_V + 2 * SHM_K) + wid * 64; float* li_l = ws, * al_l = ws + 32;
    float m_reg = -1e30f, l_reg = 0; f32x16 o[4] = {};
    const int sr = tid >> 4, sc = (tid & 15) * 8, vst0 = v_st(sr, sc), vst1 = v_st(32 + sr, sc), kws = KSWZ(sr, sc * 2);
    const int vb0 = (int)(uintptr_t)V_lds + v_rd_base(lane);
#define RESC(a) do { if (__any((a) < 1.f)) { if (hi == 0) al_l[r32] = (a); asm volatile("s_waitcnt lgkmcnt(0)" ::: "memory");              \
                     for (int d_ = 0; d_ < 4; ++d_) for (int r = 0; r < 16; ++r) o[d_][r] *= al_l[crow(r, hi)]; } } while (0)
#define KBASE(t) ((j_lo + (t)) * KVBLK)
#define MASKT(P0_, P1_, t) do { const int kb_ = KBASE(t); if (kb_ + KVBLK - 1 > qlo) mask_tile(P0_, P1_, qm - kb_, (unsigned)W); } while (0)
    constexpr int NQL = 8;
#define SEAM_K0() do { VMWN(NQL); SWRITE_HK(0, 0); SBAR(); } while (0)
    f32x16 pA0, pA1, pB0, pB1; float mnA, mnB, alA, alB; bf16x8 pa0, pa1, pa2, pa3;
    SWRITE_HV(0); SBAR();
    if (NT > 1) { SLOAD_H(cur, KBASE(1), 1); }
    SBAR(); qkt<0>(pA0, pA1, K_lds, B_lds, r32, hi, S.qr);
    MASKT(pA0, pA1, 0); partialSM(pA0, pA1, m_reg, mnA, alA);
    if (NT > 1) { VMW(); SWRITE_H(1, 0); }
    __syncthreads();
#define HALF_STEP(PX0, PX1, mnX, alX, PY0, PY1, alY, t, KB, VB, SB) do {                                                      \
        SBAR(); qkt<KB>(PX0, PX1, K_lds, B_lds, r32, hi, S.qr);                                                               \
        finishSM(PY0, PY1, alY, l_reg, pa0, pa1, pa2, pa3); SBAR();                                                           \
        if ((t) + 1 < NT) { SLOAD_H(cur, KBASE((t) + 1), SB); SBAR(); }                                                           \
        pv_tile<VB>(o, vb0, pa0, pa1, pa2, pa3); MASKT(PX0, PX1, (t)); partialSM(PX0, PX1, m_reg, mnX, alX);                  \
        __syncthreads();                                                                                                      \
        if ((t) + 1 < NT) { VMW(); SWRITE_H(SB, 0); }                                                                      \
        RESC(alX); __syncthreads(); } while (0)
    for (int t = 1; t + 1 < NT; t += 2) {
        HALF_STEP(pB0, pB1, mnB, alB, pA0, pA1, alA, t, 1, 0, 0);
        HALF_STEP(pA0, pA1, mnA, alA, pB0, pB1, alB, t + 1, 0, 1, 1);
    }
    const bool even = (NT & 1) == 0;
    if (even) { SBAR(); qkt<1>(pB0, pB1, K_lds, B_lds, r32, hi, S.qr); SBAR(); }
    SLOAD_H(nxt, nxt.jlo * KVBLK, 0); SBAR();
#pragma unroll
    for (int d0 = 0; d0 < 8; ++d0) S.qr[d0] = load8(nxt.Q + (int)((wid * QBLK + r32) * nxt.qs + hi * 8) + d0 * 16);
    SBAR();
    finishSM(pA0, pA1, alA, l_reg, pa0, pa1, pa2, pa3); SBAR();
    pv_tile<0>(o, vb0, pa0, pa1, pa2, pa3);
    if (even) { MASKT(pB0, pB1, NT - 1); partialSM(pB0, pB1, m_reg, mnB, alB); __syncthreads(); RESC(alB);
        finishSM(pB0, pB1, alB, l_reg, pa0, pa1, pa2, pa3); SBAR(); pv_tile<1>(o, vb0, pa0, pa1, pa2, pa3); }
    SBAR(); SEAM_K0();
    if (hi == 0) li_l[r32] = l_reg; asm volatile("s_waitcnt lgkmcnt(0)" ::: "memory");
    bf16* Ow = cur.O + (int)(wid * QBLK * cur.os); const int ooff = 4 * hi * cur.os + r32;
#pragma unroll
    for (int r = 0; r < 16; ++r) { const int orc = (r & 3) + 8 * (r >> 2);
        const float rl = __builtin_amdgcn_rcpf(li_l[orc + 4 * hi]);
#pragma unroll
        for (int d0 = 0; d0 < 4; ++d0) { const float v = o[d0][r] * rl;
            const float vn = __builtin_bit_cast(float, __builtin_amdgcn_update_dpp(0, __builtin_bit_cast(int, v), 0xB1, 0xf, 0xf, false));
            if ((r32 & 1) == 0) *(unsigned*)(Ow + (orc * cur.os + d0 * 32) + ooff) = cvtpk(v, vn); } }
    __syncthreads();
#undef RESC
#undef KBASE
#undef MASKT
#undef SEAM_K0
#undef HALF_STEP
}
#undef ROW
#undef VMW
#undef VMWN
#undef SLOAD_H
#undef SWRITE_HK
#undef SWRITE_HV
#undef SWRITE_H
#undef KSWZ
#undef SBAR
}
constexpr int NWAVES = 8, NTHREADS = 512;
constexpr int DM = 2048, BATCH = 8, SEQ = 4096, MTOK = BATCH * SEQ, NMEM = 256, MMEM = BATCH * NMEM;
constexpr int GLA_H = 4, GLA_DK = 256, GLA_DV = 384, GLA_QK = 1024, GLA_V = 1536, GLA_IN_SRC = 5648, GLA_IN = 5632;
constexpr int FOX_H = 12, FOX_W = 1536, FOX_KV_SRC = 3084, MEM_H = 4, MEM_W = 512;
constexpr int FFH = 5632, FF2 = 11264, FFP = FFH + 64;
constexpr int ZQ = 0, ZK = 1024, ZV = 2048, ZOG = 3584, ZMQ = 5120;
constexpr float EPS = 1e-6f;
constexpr size_t al256(size_t x) { return (x + 255) & ~(size_t)255; }
constexpr size_t WS_CTL = 0, CTL_BYTES = 1u << 20;
constexpr size_t WS_SS    = WS_CTL + CTL_BYTES;
constexpr size_t WS_WMEM  = WS_SS + (size_t)10 * MTOK * 4;
constexpr size_t WS_WGIN  = WS_WMEM  + (size_t)4 * 1024 * DM * 2;
constexpr size_t WS_WGLR  = WS_WGIN  + (size_t)2 * GLA_IN * DM * 2;
constexpr size_t WS_WGOUT = WS_WGLR  + (size_t)2 * 16 * DM * 2;
constexpr size_t WS_WFKV  = WS_WGOUT + (size_t)2 * DM * DM * 2;
constexpr size_t WS_WFL   = WS_WFKV  + (size_t)3072 * DM * 2;
constexpr size_t WS_WFIN  = WS_WFL   + (size_t)16 * DM * 2;
constexpr size_t WS_WFOUT = WS_WFIN  + (size_t)2 * DM * DM * 2;
constexpr size_t WS_WUP   = WS_WFOUT + (size_t)2 * DM * DM * 2;
constexpr size_t WS_WDOWN = WS_WUP   + (size_t)4 * FF2 * DM * 2;
constexpr size_t WS_MEMN  = WS_WDOWN + (size_t)4 * DM * FFH * 2;
constexpr size_t WS_MKV   = WS_MEMN  + (size_t)MMEM * DM * 2;
constexpr size_t WS_H     = WS_MKV   + (size_t)MMEM * 4096 * 2;
#ifndef XBPAD
#define XBPAD 0
#endif
constexpr int XBP = RES_BF16 ? DM + XBPAD : DM;
constexpr size_t WS_Z     = WS_H     + (size_t)MTOK * XBP * 2;
constexpr size_t WS_MIX   = WS_Z     + (size_t)MTOK * FFP * 2;
constexpr size_t WS_U     = WS_MIX   + (size_t)MTOK * DM * 2;
constexpr size_t WS_KET   = WS_U;
constexpr size_t WS_VT    = WS_KET   + (size_t)2048 * 256 * 64 * 2;
constexpr size_t WS_UEND_A = WS_VT   + (size_t)2048 * 384 * 64 * 2;
constexpr size_t WS_KF    = WS_U;
constexpr size_t WS_VF    = WS_KF    + (size_t)MTOK * FOX_W * 2;
constexpr size_t WS_UEND_B = WS_VF   + (size_t)MTOK * FOX_W * 2;
constexpr size_t WS_UEND  = WS_UEND_A > WS_UEND_B ? WS_UEND_A : WS_UEND_B;
constexpr size_t WS_EL    = WS_UEND;
constexpr size_t WS_GLR   = WS_EL    + (size_t)2048 * 256 * 4;
constexpr size_t WS_CF    = WS_GLR   + (size_t)MTOK * 16 * 4;
constexpr size_t WS_HALO  = WS_CF    + (size_t)96 * SEQ * 4;
constexpr size_t WS_XH    = WS_HALO  + (size_t)128 * 4 * FF2 * 4;
constexpr size_t WS_END   = WS_XH    + (size_t)MTOK * DM * 2;
constexpr size_t WS_SSH   = WS_END;
constexpr size_t WS_NQ    = WS_SSH   + (size_t)MTOK * 4 * 24 * 4;
constexpr int CW_BAR = 4096;
constexpr int RING_BYTES = 131072, MISC_OFF = RING_BYTES, XTRA_OFF = RING_BYTES + 1024, LDS_BYTES = 163840;

#define GAS __attribute__((address_space(1)))
#define LAS __attribute__((address_space(3)))
typedef unsigned short bf16;
typedef unsigned v4u __attribute__((ext_vector_type(4)));
typedef unsigned v2u __attribute__((ext_vector_type(2)));
typedef float f32x4 __attribute__((ext_vector_type(4)));
typedef short bf16x8 __attribute__((ext_vector_type(8)));
#define LDS_WAIT() asm volatile("s_waitcnt lgkmcnt(0)" ::: "memory")
#define VM_WAIT() asm volatile("s_waitcnt vmcnt(0)" ::: "memory")
__device__ __forceinline__ unsigned f2bf(float f) { unsigned u = __builtin_bit_cast(unsigned, f); return (u + 0x7fffu + ((u >> 16) & 1u)) >> 16; }
__device__ __forceinline__ unsigned pk2(float lo, float hi) { return f2bf(lo) | (f2bf(hi) << 16); }
__device__ __forceinline__ float bf2f(unsigned short b) { return __builtin_bit_cast(float, (unsigned)b << 16); }
__device__ __forceinline__ float bflo(unsigned w) { return __builtin_bit_cast(float, w << 16); }
__device__ __forceinline__ float bfhi(unsigned w) { return __builtin_bit_cast(float, w & 0xffff0000u); }
__device__ __forceinline__ float dpp_shr_add(float v, const int n) {
    int r; const int iv = __builtin_bit_cast(int, v);
    if (n == 1) r = __builtin_amdgcn_update_dpp(0, iv, 0x111, 0xf, 0xf, true); else if (n == 2) r = __builtin_amdgcn_update_dpp(0, iv, 0x112, 0xf, 0xf, true);
    else if (n == 4) r = __builtin_amdgcn_update_dpp(0, iv, 0x114, 0xf, 0xf, true); else r = __builtin_amdgcn_update_dpp(0, iv, 0x118, 0xf, 0xf, true);
    return v + __builtin_bit_cast(float, r);
}
__device__ __forceinline__ float dpp_shr_max(float v, const int n) {
    int r; const int iv = __builtin_bit_cast(int, v);
    if (n == 1) r = __builtin_amdgcn_update_dpp(0, iv, 0x111, 0xf, 0xf, true); else if (n == 2) r = __builtin_amdgcn_update_dpp(0, iv, 0x112, 0xf, 0xf, true);
    else if (n == 4) r = __builtin_amdgcn_update_dpp(0, iv, 0x114, 0xf, 0xf, true); else r = __builtin_amdgcn_update_dpp(0, iv, 0x118, 0xf, 0xf, true);
    return fmaxf(v, __builtin_bit_cast(float, r));
}
__device__ __forceinline__ float wave_max(float v) {
    v = dpp_shr_max(v, 1); v = dpp_shr_max(v, 2); v = dpp_shr_max(v, 4); v = dpp_shr_max(v, 8);
    v = fmaxf(v, __builtin_bit_cast(float, __builtin_amdgcn_update_dpp(0, __builtin_bit_cast(int, v), 0x142, 0xa, 0xf, false)));
    v = fmaxf(v, __builtin_bit_cast(float, __builtin_amdgcn_update_dpp(0, __builtin_bit_cast(int, v), 0x143, 0xc, 0xf, false)));
    return __builtin_bit_cast(float, __builtin_amdgcn_readlane(__builtin_bit_cast(int, v), 63));
}
__device__ __forceinline__ float wave_sum(float v) {
    v = dpp_shr_add(v, 1); v = dpp_shr_add(v, 2); v = dpp_shr_add(v, 4); v = dpp_shr_add(v, 8);
    v += __builtin_bit_cast(float, __builtin_amdgcn_update_dpp(0, __builtin_bit_cast(int, v), 0x142, 0xa, 0xf, false));
    v += __builtin_bit_cast(float, __builtin_amdgcn_update_dpp(0, __builtin_bit_cast(int, v), 0x143, 0xc, 0xf, false));
    return __builtin_bit_cast(float, __builtin_amdgcn_readlane(__builtin_bit_cast(int, v), 63));
}
#define XB_TMO      128
#define XB_XCNT(j)  (256  + 64 * (j))
#define XB_XSUB(j)  (1280 + 64 * (j))
#define XB_XGEN(j)  (2304 + 64 * (j))
#define XB_TOP      3328
#define XB_TOPGEN   3392
#define XCD_BAR_WORDS 3456
#define XB_SPIN_CAP (1u << 18)

__device__ __forceinline__ unsigned xb_ld(unsigned* p)              { return __hip_atomic_load(p, __ATOMIC_RELAXED, __HIP_MEMORY_SCOPE_AGENT); }
__device__ __forceinline__ unsigned xb_add(unsigned* p, unsigned v) { return __hip_atomic_fetch_add(p, v, __ATOMIC_RELAXED, __HIP_MEMORY_SCOPE_AGENT); }
__device__ __forceinline__ unsigned xb_xcc_id() { return (unsigned)__builtin_amdgcn_s_getreg((3 << 11) | 20) & 0xFu; }
#define XB_SPIN(cond, bar) do { unsigned _sp = 0; while (cond) { __builtin_amdgcn_s_sleep(1); \
    if ((++_sp & 255u) == 0u) { if (xb_ld(&(bar)[XB_TMO])) break; if (_sp > XB_SPIN_CAP) { atomicAdd(&(bar)[XB_TMO], 1u); break; } } } } while (0)

struct XcdBarrier {
    unsigned* bar; unsigned x;
    volatile LAS unsigned* st;
};

__device__ __forceinline__ XcdBarrier xcd_barrier_post(unsigned* bar, volatile LAS unsigned* st, const int wave_in) {
    XcdBarrier b; b.bar = bar; b.x = xb_xcc_id(); b.st = st;
    if (opaque_tid(wave_in) == 0) (void)xb_add(&bar[XB_XCNT(b.x)], 1u);
    return b;
}
__device__ __forceinline__ void xcd_barrier_complete(unsigned* bar, unsigned x, unsigned& nloc, unsigned& nx) {
    const unsigned G = gridDim.x * gridDim.y * gridDim.z;
    unsigned sum, cnt, mine, sp = 0u;
    for (;;) {
        sum = 0u; cnt = 0u; mine = 0u;
#pragma unroll
        for (unsigned j = 0; j < 16; ++j) { const unsigned c = xb_ld(&bar[XB_XCNT(j)]); sum += c; cnt += (c > 0u) ? 1u : 0u; mine = (j == x) ? c : mine; }
        if (sum == G) break;
        __builtin_amdgcn_s_sleep(1);
        if ((++sp & 255u) == 0u) { if (xb_ld(&bar[XB_TMO])) break; if (sp > XB_SPIN_CAP) { atomicAdd(&bar[XB_TMO], 1u); break; } }
    }
    nloc = mine > 0u ? mine : 1u; nx = cnt > 0u ? cnt : 1u;
}

__device__ __forceinline__ void xcd_barrier(const XcdBarrier& b, const int wave_in) {
    asm volatile("s_waitcnt vmcnt(0)" ::: "memory");
    __syncthreads();
    if (opaque_tid(wave_in) == 0) {
        unsigned* bar = b.bar;
        __builtin_amdgcn_s_waitcnt(0);
        unsigned nloc = b.st[0], nx = b.st[1];
        if (nloc == 0u) { xcd_barrier_complete(bar, b.x, nloc, nx); b.st[0] = nloc; b.st[1] = nx; }
        const unsigned old = xb_add(&bar[XB_XSUB(b.x)], 1u);
        const unsigned gen = old / nloc;
        if (old + 1u == (gen + 1u) * nloc) {
            __builtin_amdgcn_fence(__ATOMIC_RELEASE, "agent");
            asm volatile("s_waitcnt vmcnt(0)" ::: "memory");
            const unsigned og = xb_add(&bar[XB_TOP], 1u);
            const unsigned tg = og / nx;
            if (og + 1u == (tg + 1u) * nx) xb_add(&bar[XB_TOPGEN], 1u);
            else XB_SPIN(xb_ld(&bar[XB_TOPGEN]) == tg, bar);
            __builtin_amdgcn_fence(__ATOMIC_ACQUIRE, "agent");
            xb_add(&bar[XB_XGEN(b.x)], 1u);
            asm volatile("s_waitcnt vmcnt(0)" ::: "memory");
        } else {
            XB_SPIN(xb_ld(&bar[XB_XGEN(b.x)]) == gen, bar);
            __builtin_amdgcn_fence(__ATOMIC_ACQUIRE, "agent");
            asm volatile("s_waitcnt vmcnt(0)" ::: "memory");
        }
    }
    __syncthreads();
}
struct Ctx {
    LAS unsigned char* lds;
    int tid, lane, wave, vcu, bx, G;
    const float* in[21]; float* out; unsigned char* ws;
};
template <class T> __device__ __forceinline__ T* wsp(const Ctx& C, size_t off) { return (T*)(C.ws + off); }

struct XpItem { const float* src; const float* gain; bf16* dst; int Nsrc, K; };
__device__ __forceinline__ void xp_load(const XpItem& X, f32x4 (&v)[8], float (&gk)[8]) {
#pragma unroll
    for (int i = 0; i < 8; ++i) { v[i] = *(const GAS f32x4*)(X.src + (size_t)(8 * i) * X.Nsrc); gk[i] = X.gain ? X.gain[8 * i] : 1.0f; }
}
__device__ __forceinline__ void xp_finish(const XpItem& X, const f32x4 (&v)[8], const float (&gk)[8], LAS float* scr, int lane) {
#pragma unroll
    for (int i = 0; i < 8; ++i) { const int kk = 8 * i + (lane >> 3); LAS float* d = scr + kk * 33 + (lane & 7) * 4; const f32x4 y = v[i] * gk[i]; d[0] = y.x; d[1] = y.y; d[2] = y.z; d[3] = y.w; }
    LDS_WAIT(); asm volatile("" ::: "memory");
    const int c = lane & 7;
#pragma unroll
    for (int j = 0; j < 4; ++j) { const int n = (lane >> 3) + 8 * j; const LAS float* s = scr + (8 * c) * 33 + n;
        v4u o; o.x = pk2(s[0 * 33], s[1 * 33]); o.y = pk2(s[2 * 33], s[3 * 33]); o.z = pk2(s[4 * 33], s[5 * 33]); o.w = pk2(s[6 * 33], s[7 * 33]);
        *(GAS v4u*)(X.dst + (size_t)(8 * j) * X.K) = o; }
    LDS_WAIT(); asm volatile("" ::: "memory");
}
__device__ __forceinline__ int colmap(int type, int g) {
    if (type == 1) return g < 112 ? 32 * g : 32 * g + 16;
    if (type == 2) { const int pn = g >> 3, gg = g & 7; return gg < 4 ? 128 * pn + 32 * gg : FFH + 128 * pn + 32 * (gg - 4); }
    return 32 * g;
}
__device__ __forceinline__ bool xpose_family(int& r, XpItem& X, int lane, const float* W, int K, int Nsrc, int Ndst, int l0, int nl, int type, bf16* WT, const float* gain = nullptr, int gstride = 0, int gmax = 1 << 30) {
    const int per = (K / 64) * (Ndst / 32), tot = per * nl;
    if (r >= tot) { r -= tot; return false; }
    const int l = l0 + r / per, q = r - (l - l0) * per, g = q / (K / 64), kb = q - g * (K / 64), k0 = 64 * kb;
    X.src = W + (size_t)l * K * Nsrc + (size_t)(k0 + (lane >> 3)) * Nsrc + colmap(type, g) + (lane & 7) * 4; X.Nsrc = Nsrc; X.K = K;
    X.gain = (gain && k0 < gmax) ? gain + (size_t)l * gstride + k0 + (lane >> 3) : nullptr;
    X.dst = WT + (size_t)l * Ndst * K + (size_t)(32 * g + (lane >> 3)) * K + k0 + 8 * (lane & 7);
    return true;
}
__device__ __forceinline__ void xp_resolve(const Ctx& C, int list, int it, XpItem& X) {
    int r = it; const int lane = C.lane;
    if (list == 0) {
        if (xpose_family(r, X, lane, C.in[7], DM, GLA_IN_SRC, GLA_IN, 0, 2, 1, wsp<bf16>(C, WS_WGIN), C.in[2], DM)) return;
        if (xpose_family(r, X, lane, C.in[6], DM, 1024, 1024, 0, 4, 0, wsp<bf16>(C, WS_WMEM))) return;
        if (xpose_family(r, X, lane, C.in[11], DM, DM, DM, 0, 2, 0, wsp<bf16>(C, WS_WGOUT), C.in[10], GLA_V, GLA_V)) return;
        if (xpose_family(r, X, lane, C.in[17], DM, FF2, FF2, 0, 2, 2, wsp<bf16>(C, WS_WUP), C.in[3], DM)) return;
        xpose_family(r, X, lane, C.in[20], FFH, DM, DM, 0, 2, 0, wsp<bf16>(C, WS_WDOWN));
    } else {
        if (xpose_family(r, X, lane, C.in[13], DM, FOX_KV_SRC, 3072, 0, 1, 0, wsp<bf16>(C, WS_WFKV), C.in[12], 0)) return;
        if (xpose_family(r, X, lane, C.in[15], DM, DM, DM, 0, 2, 0, wsp<bf16>(C, WS_WFIN), C.in[2] + 2 * DM, DM)) return;
        if (xpose_family(r, X, lane, C.in[16], DM, DM, DM, 0, 2, 0, wsp<bf16>(C, WS_WFOUT))) return;
        if (xpose_family(r, X, lane, C.in[17], DM, FF2, FF2, 2, 2, 2, wsp<bf16>(C, WS_WUP), C.in[3], DM)) return;
        xpose_family(r, X, lane, C.in[20], FFH, DM, DM, 2, 2, 0, wsp<bf16>(C, WS_WDOWN));
    }
}
constexpr int NX_EARLY = 4 * 32 * 32 + 2 * 32 * 176 + 2 * 32 * 64 + 2 * 32 * 352 + 2 * 88 * 64;
constexpr int NX_LATE = 32 * 96 + 2 * 32 * 64 + 2 * 32 * 64 + 2 * 32 * 352 + 2 * 88 * 64;
__device__ __forceinline__ void xp_run(const Ctx& C, int list, int first, int end, int stride) {
    LAS float* scr = (LAS float*)(C.lds + C.wave * 16384);
    XpItem Xa, Xb; f32x4 va[8], vb[8]; float ga[8], gb[8];
    int it = first; if (it < end) { xp_resolve(C, list, it, Xa); xp_load(Xa, va, ga); }
    while (it < end) {
        const int it1 = it + stride, it2 = it1 + stride;
        if (it1 < end) { xp_resolve(C, list, it1, Xb); xp_load(Xb, vb, gb); }
        xp_finish(Xa, va, ga, scr, C.lane);
        if (it2 < end) { xp_resolve(C, list, it2, Xa); xp_load(Xa, va, ga); }
        if (it1 < end) xp_finish(Xb, vb, gb, scr, C.lane);
        it = it2;
    }
}
__device__ __forceinline__ void rms_row(const Ctx& C, const float* xrow, const float* g1, bf16* o1, const float* g2, bf16* o2, float* of32) {
    const GAS f32x4* xr = (const GAS f32x4*)xrow + C.lane;
    f32x4 v[8]; float s = 0.f;
#pragma unroll
    for (int j = 0; j < 8; ++j) { v[j] = xr[64 * j]; s += (v[j].x * v[j].x + v[j].y * v[j].y) + (v[j].z * v[j].z + v[j].w * v[j].w); }
    const float rstd = 1.0f / sqrtf(wave_sum(s) * (1.f / DM) + EPS);
#pragma unroll
    for (int j = 0; j < 8; ++j) { const f32x4 g = ((const GAS f32x4*)g1)[C.lane + 64 * j]; const f32x4 y = v[j] * rstd * g;
        if (of32) ((GAS f32x4*)of32)[C.lane + 64 * j] = y;
        else ((GAS v2u*)o1)[C.lane + 64 * j] = (v2u){pk2(y.x, y.y), pk2(y.z, y.w)}; }
    if (o2) {
#pragma unroll
        for (int j = 0; j < 8; ++j) { const f32x4 g = ((const GAS f32x4*)g2)[C.lane + 64 * j]; const f32x4 y = v[j] * rstd * g;
            ((GAS v2u*)o2)[C.lane + 64 * j] = (v2u){pk2(y.x, y.y), pk2(y.z, y.w)}; }
    }
}
__device__ __forceinline__ void rms_phase(const Ctx& C, const float* x, int rows, const float* g1, bf16* o1, const float* g2, bf16* o2, float* of32) {
    const int gw = C.vcu * NWAVES + C.wave, NGW = C.G * NWAVES;
    for (int m = gw; m < rows; m += NGW) rms_row(C, x + (size_t)m * DM, g1, o1 ? o1 + (size_t)m * DM : nullptr, g2, o2 ? o2 + (size_t)m * DM : nullptr, of32 ? of32 + (size_t)m * DM : nullptr);
}
__device__ __forceinline__ void convert_late(const Ctx& C, int half, int widx, int nw) { xp_run(C, 1, half * (NX_LATE / 2) + widx, (half + 1) * (NX_LATE / 2), nw); }
__device__ __forceinline__ void rms_bf16_phase(const Ctx& C, const bf16* xb, const float* g, float* out) {
    const int gw = C.vcu * NWAVES + C.wave, NGW = C.G * NWAVES;
    for (int m = gw; m < MTOK; m += NGW) { f32x4 v[8]; float s = 0.f;
#pragma unroll
        for (int j = 0; j < 8; ++j) { const v2u w = ((const GAS v2u*)(xb + (size_t)m * XBP))[C.lane + 64 * j]; v[j] = RES_BF16 ? (f32x4){bflo(w.x), bfhi(w.x), bflo(w.y), bfhi(w.y)} : (f32x4){pg8::h2lo(w.x), pg8::h2hi(w.x), pg8::h2lo(w.y), pg8::h2hi(w.y)}; s += (v[j].x * v[j].x + v[j].y * v[j].y) + (v[j].z * v[j].z + v[j].w * v[j].w); }
        const float rstd = 1.0f / sqrtf(wave_sum(s) * (1.f / DM) + EPS);
#pragma unroll
        for (int j = 0; j < 8; ++j) { const f32x4 gg = ((const GAS f32x4*)g)[C.lane + 64 * j]; ((GAS f32x4*)(out + (size_t)m * DM))[C.lane + 64 * j] = v[j] * rstd * gg; } }
}
__device__ __forceinline__ void p0_prologue(const Ctx& C) {
    const int gw = C.vcu * NWAVES + C.wave, NGW = C.G * NWAVES;
    xp_run(C, 0, gw, NX_EARLY, NGW);
    { const int gt = C.vcu * NTHREADS + C.tid, NT = C.G * NTHREADS;
      for (int i = gt; i < 3 * 16 * DM; i += NT) { const int l = i / (16 * DM), n = (i / DM) & 15, k = i % DM;
          if (l < 2) wsp<bf16>(C, WS_WGLR)[i] = (bf16)f2bf(C.in[7][((size_t)l * DM + k) * GLA_IN_SRC + 3584 + n] * C.in[2][l * DM + k]);
          else wsp<bf16>(C, WS_WFL)[i - 2 * 16 * DM] = (bf16)(n < 12 ? f2bf(C.in[13][(size_t)k * FOX_KV_SRC + 3072 + n] * C.in[12][k]) : 0u); } }
    rms_phase(C, C.in[1], MMEM, C.in[4], wsp<bf16>(C, WS_MEMN), nullptr, nullptr, nullptr);
    { unsigned* SS = wsp<unsigned>(C, WS_SS); bf16* XB = wsp<bf16>(C, WS_H);
      for (int m = gw; m < MTOK; m += NGW) { const GAS f32x4* xr = (const GAS f32x4*)(C.in[0] + (size_t)m * DM) + C.lane; f32x4 v[8]; float s = 0.f;
#pragma unroll
          for (int j = 0; j < 8; ++j) { v[j] = xr[64 * j]; s += (v[j].x * v[j].x + v[j].y * v[j].y) + (v[j].z * v[j].z + v[j].w * v[j].w); }
          const float rstd = 1.0f / sqrtf(wave_sum(s) * (1.f / DM) + EPS);
#pragma unroll
          for (int j = 0; j < 8; ++j) { const f32x4 y = v[j] * rstd; ((GAS v2u*)(XB + (size_t)m * XBP))[C.lane + 64 * j] = (v2u){pk2(y.x, y.y), pk2(y.z, y.w)}; }
          if (C.lane == 0) SS[m] = (unsigned)(2048.0f * (1.0f - 1e-6f) * pg8::SS_SCALE); }
    }
}
__device__ __forceinline__ void skinny16_phase(const Ctx& C, const bf16* A, const bf16* Wt, float* out, const unsigned* ss, int gw = -1, int NGW = 0) {
    if (gw < 0) { gw = C.vcu * NWAVES + C.wave; NGW = C.G * NWAVES; }
    const int fr = C.lane & 15, fq = C.lane >> 4;
    for (int t = gw; t < MTOK / 16; t += NGW) {
        const bf16* ap = A + (size_t)(t * 16 + fr) * XBP + fq * 8; const bf16* bp = Wt + (size_t)fr * DM + fq * 8;
        f32x4 acc[4] = {};
#pragma unroll 4
        for (int ks = 0; ks < 64; ks += 4) {
#pragma unroll
            for (int u = 0; u < 4; ++u) { const bf16x8 a = *(const bf16x8*)(ap + (ks + u) * 32), b = *(const bf16x8*)(bp + (ks + u) * 32);
                acc[u] = pg8::mfma16<false>(a, b, acc[u]); }
        }
        const f32x4 r = (acc[0] + acc[1]) + (acc[2] + acc[3]);
#pragma unroll
        for (int j = 0; j < 4; ++j) out[(size_t)(t * 16 + 4 * fq + j) * 16 + fr] = r[j] * __builtin_amdgcn_rsqf((float)ss[t * 16 + 4 * fq + j] * (1.0f / (pg8::SS_SCALE * DM)) + EPS);
    }
}

__device__ __forceinline__ void gla_prep_phase(const Ctx& C, int layer) {
    bf16* Z = wsp<bf16>(C, WS_Z); const float* GLR = wsp<float>(C, WS_GLR);
    const float* Wg = C.in[8] + (size_t)layer * 16 * GLA_QK; const float* bg = C.in[9] + (size_t)layer * GLA_QK;
    LAS float* GL = (LAS float*)C.lds; LAS float* WG = (LAS float*)(C.lds + 4096); LAS float* TOT = (LAS float*)(C.lds + 20480);
    const int tid = C.tid, cg = tid & 31, rg = tid >> 5;
    for (int it0 = C.vcu; it0 < 2048; it0 += C.G) {
        const int h = it0 & 3, ch = (it0 >> 2) & 63, b = it0 >> 8, bh = b * 4 + h, item = bh * 64 + ch; const size_t r0 = (size_t)b * SEQ + ch * 64;
        if (tid < 256) ((LAS f32x4*)GL)[tid] = ((const GAS f32x4*)(GLR + r0 * 16))[tid];
#pragma unroll
        for (int i = 0; i < 2; ++i) { const int q = tid + NTHREADS * i, j = q >> 6, c4 = q & 63; ((LAS f32x4*)WG)[q] = *(const GAS f32x4*)(Wg + j * GLA_QK + h * GLA_DK + c4 * 4); }
        const f32x4 b0 = *(const GAS f32x4*)(bg + h * GLA_DK + 8 * cg), b1 = *(const GAS f32x4*)(bg + h * GLA_DK + 8 * cg + 4);
        v4u qv[4], kv[4];
        bf16* qp = Z + (r0 + 4 * rg) * GLA_IN + ZQ + h * GLA_DK + 8 * cg; bf16* kp = qp + ZK;
#pragma unroll
        for (int r = 0; r < 4; ++r) { qv[r] = *(const GAS v4u*)(qp + (size_t)r * GLA_IN); kv[r] = *(const GAS v4u*)(kp + (size_t)r * GLA_IN); }
        __syncthreads();
        float x[4][8];
#pragma unroll
        for (int r = 0; r < 4; ++r) { x[r][0] = b0[0]; x[r][1] = b0[1]; x[r][2] = b0[2]; x[r][3] = b0[3]; x[r][4] = b1[0]; x[r][5] = b1[1]; x[r][6] = b1[2]; x[r][7] = b1[3]; }
#pragma unroll
        for (int j4 = 0; j4 < 4; ++j4) {
            f32x4 g[4];
#pragma unroll
            for (int r = 0; r < 4; ++r) g[r] = ((const LAS f32x4*)(GL + (4 * rg + r) * 16))[j4];
#pragma unroll
            for (int jj = 0; jj < 4; ++jj) { const int j = 4 * j4 + jj; const f32x4 w0 = ((const LAS f32x4*)(WG + j * 256 + 8 * cg))[0], w1 = ((const LAS f32x4*)(WG + j * 256 + 8 * cg))[1];
#pragma unroll
                for (int r = 0; r < 4; ++r) { const float gv = g[r][jj];
                    x[r][0] += gv * w0[0]; x[r][1] += gv * w0[1]; x[r][2] += gv * w0[2]; x[r][3] += gv * w0[3]; x[r][4] += gv * w1[0]; x[r][5] += gv * w1[1]; x[r][6] += gv * w1[2]; x[r][7] += gv * w1[3]; } }
        }
#pragma unroll
        for (int c = 0; c < 8; ++c) { float cum = 0.f;
#pragma unroll
            for (int r = 0; r < 4; ++r) { const float v = x[r][c]; const float ls = fminf(v, 0.f) - 0.6931471805599453f * __builtin_amdgcn_logf(1.0f + __builtin_amdgcn_exp2f(-1.4426950408889634f * fabsf(v)));
                cum += ls * 0.0625f; x[r][c] = cum; } }
        ((LAS f32x4*)(TOT + rg * 256 + 8 * cg))[0] = (f32x4){x[3][0], x[3][1], x[3][2], x[3][3]}; ((LAS f32x4*)(TOT + rg * 256 + 8 * cg))[1] = (f32x4){x[3][4], x[3][5], x[3][6], x[3][7]};
        __syncthreads();
        { f32x4 o0 = (f32x4){0.f, 0.f, 0.f, 0.f}, o1 = o0;
#pragma unroll
          for (int q = 0; q < 15; ++q) { const float msk = q < rg ? 1.0f : 0.0f; o0 += ((const LAS f32x4*)(TOT + q * 256 + 8 * cg))[0] * msk; o1 += ((const LAS f32x4*)(TOT + q * 256 + 8 * cg))[1] * msk; }
#pragma unroll
          for (int r = 0; r < 4; ++r) { x[r][0] += o0[0]; x[r][1] += o0[1]; x[r][2] += o0[2]; x[r][3] += o0[3]; x[r][4] += o1[0]; x[r][5] += o1[1]; x[r][6] += o1[2]; x[r][7] += o1[3]; } }
        if (rg == 15) { float* el = wsp<float>(C, WS_EL) + (size_t)item * 256 + 8 * cg;
            f32x4 e0, e1;
#pragma unroll
            for (int c = 0; c < 4; ++c) { e0[c] = __builtin_amdgcn_exp2f(1.4426950408889634f * x[3][c]); e1[c] = __builtin_amdgcn_exp2f(1.4426950408889634f * x[3][4 + c]); }
            *(GAS f32x4*)el = e0; *(GAS f32x4*)(el + 4) = e1; }
        const int pb = ((8 * cg) & ~31) + 16 * (cg & 1) + 4 * ((cg >> 1) & 1);
        unsigned ket[8][2];
#pragma unroll
        for (int r = 0; r < 4; ++r) { unsigned qo[4], ko[4];
#pragma unroll
            for (int c2 = 0; c2 < 4; ++c2) {
                const float e0 = __builtin_amdgcn_exp2f(1.4426950408889634f * x[r][2 * c2]), e1 = __builtin_amdgcn_exp2f(1.4426950408889634f * x[r][2 * c2 + 1]);
                const float q0 = bflo(qv[r][c2]) * 0.0625f * e0, q1 = bfhi(qv[r][c2]) * 0.0625f * e1;
                const unsigned k0 = f2bf(bflo(kv[r][c2]) * __builtin_amdgcn_rcpf(e0)), k1 = f2bf(bfhi(kv[r][c2]) * __builtin_amdgcn_rcpf(e1));
                qo[c2] = pk2(q0, q1); ko[c2] = k0 | (k1 << 16);
                if (r & 1) { ket[2 * c2][r >> 1] |= k0 << 16; ket[2 * c2 + 1][r >> 1] |= k1 << 16; } else { ket[2 * c2][r >> 1] = k0; ket[2 * c2 + 1][r >> 1] = k1; } }
            bf16* qr = Z + (r0 + 4 * rg + r) * GLA_IN + ZQ + h * GLA_DK; bf16* kr = qr + ZK;
            *(GAS v2u*)(qr + pb) = (v2u){qo[0], qo[1]}; *(GAS v2u*)(qr + pb + 8) = (v2u){qo[2], qo[3]};
            *(GAS v2u*)(kr + pb) = (v2u){ko[0], ko[1]}; *(GAS v2u*)(kr + pb + 8) = (v2u){ko[2], ko[3]}; }
        { bf16* ketp = wsp<bf16>(C, WS_KET) + (size_t)item * 256 * 64 + (size_t)(8 * cg) * 64 + 4 * rg;
#pragma unroll
          for (int c = 0; c < 8; ++c) *(GAS v2u*)(ketp + c * 64) = (v2u){ket[c][0], ket[c][1]}; }
        __syncthreads();
    }
}

__device__ __forceinline__ int sw512(int row, int ch) { return row * 512 + ((ch ^ (row & 15)) << 4); }
__device__ __forceinline__ int sw128(int row, int ch) { return row * 128 + ((ch ^ ((row >> 1) & 7)) << 4); }
__device__ __forceinline__ void gla_scan_phase(const Ctx& C) {
    constexpr int SQE = 0, SKE = 32768, SKET = 65536, SVT = 98304, SATT = 106496, SEL = 114688, SPART = XTRA_OFF;
    const bf16* Z = wsp<bf16>(C, WS_Z); const bf16* KETg = wsp<bf16>(C, WS_KET); const float* ELg = wsp<float>(C, WS_EL);
    bf16* Og = wsp<bf16>(C, WS_MIX);
    LAS unsigned char* L = C.lds;
    const int tid = C.tid, lane = C.lane, w = C.wave, dh = w >> 2, nt = w & 3, fr = lane & 15, fq = lane >> 4;
    if (C.vcu < 192) { const int it = C.vcu;
        const int bh = it / 6, slice = it - bh * 6, b = bh >> 2, h = bh & 3;
        v4u rq[4], rk[4], rt[4], rv, re;
#define SCAN_LOAD_A(c_) do { const size_t r0_ = (size_t)b * SEQ + (size_t)(c_) * 64;                                                                           \
        _Pragma("unroll") for (int j_ = 0; j_ < 4; ++j_) { const int i_ = tid + NTHREADS * j_;                                                                \
            rq[j_] = *(const GAS v4u*)(Z + (r0_ + (i_ >> 5)) * GLA_IN + ZQ + h * GLA_DK + (i_ & 31) * 8);                                                     \
            rk[j_] = *(const GAS v4u*)(Z + (r0_ + (i_ >> 5)) * GLA_IN + ZK + h * GLA_DK + (i_ & 31) * 8); } } while (0)
#define SCAN_LOAD_B(c_) do { const size_t ci_ = (size_t)bh * 64 + (c_);                                                                                       \
        _Pragma("unroll") for (int j_ = 0; j_ < 4; ++j_) { const int i_ = tid + NTHREADS * j_; rt[j_] = *(const GAS v4u*)(KETg + ci_ * 16384 + (size_t)i_ * 8); } \
        rv = *(const GAS v4u*)(Z + ((size_t)b * SEQ + (size_t)(c_) * 64 + (tid >> 3)) * GLA_IN + ZV + h * GLA_DV + slice * 64 + (tid & 7) * 8);     \
        if (tid < 64) re = *(const GAS v4u*)(ELg + ci_ * 256 + tid * 4); } while (0)
#define SCAN_WRITE() do {                                                                                                                                      \
        _Pragma("unroll") for (int j_ = 0; j_ < 4; ++j_) { const int i_ = tid + NTHREADS * j_;                                                                \
            *(LAS v4u*)(L + SQE + sw512(i_ >> 5, i_ & 31)) = rq[j_]; *(LAS v4u*)(L + SKE + sw512(i_ >> 5, i_ & 31)) = rk[j_];                                 \
            *(LAS v4u*)(L + SKET + sw128(i_ >> 3, i_ & 7)) = rt[j_]; }                                                                                         \
        _Pragma("unroll") for (int e_ = 0; e_ < 8; ++e_) {                \
            *(LAS unsigned short*)(L + SVT + sw128(8 * (tid & 7) + e_, tid >> 6) + ((tid >> 3) & 7) * 2) = (unsigned short)(rv[e_ >> 1] >> (16 * (e_ & 1))); }                    \
        if (tid < 64) *(LAS v4u*)(L + SEL + tid * 16) = re; } while (0)
        SCAN_LOAD_A(0); SCAN_LOAD_B(0);
        for (int i = tid; i < 512; i += NTHREADS) *(LAS v4u*)(L + SATT + i * 16) = (v4u){0u, 0u, 0u, 0u};
        VM_WAIT(); SCAN_WRITE();
        f32x4 S[8];
#pragma unroll
        for (int i = 0; i < 8; ++i) S[i] = (f32x4){0.f, 0.f, 0.f, 0.f};
        __syncthreads();
        float* SSHg = wsp<float>(C, WS_SSH);
        for (int c = 0; c < 64; ++c) {
            if (c + 1 < 64) { SCAN_LOAD_A(c + 1); SCAN_LOAD_B(c + 1); }
            unsigned short ogv[8];
            { const bf16* ogp = Z + ((size_t)b * SEQ + (size_t)c * 64 + 32 * dh + 4 * fq) * GLA_IN + ZOG + h * GLA_DV + slice * 64 + 16 * nt + fr;
#pragma unroll
              for (int i = 0; i < 2; ++i)
#pragma unroll
                  for (int j = 0; j < 4; ++j) ogv[i * 4 + j] = ogp[(size_t)(16 * i + j) * GLA_IN]; }
#pragma unroll
            for (int rep = 0; rep < 2; ++rep) {
                const int id = w + 8 * rep;
                if (id < 10) {
                    int mt = 0; if (id >= 1) mt = 1; if (id >= 3) mt = 2; if (id >= 6) mt = 3; const int nn = id - (mt * (mt + 1)) / 2;
                    f32x4 a = (f32x4){0.f, 0.f, 0.f, 0.f};
#pragma unroll
                    for (int ks = 0; ks < 8; ++ks) {
                        const bf16x8 af = *(const LAS bf16x8*)(L + SQE + sw512(16 * mt + fr, 4 * ks + fq)), bfm = *(const LAS bf16x8*)(L + SKE + sw512(16 * nn + fr, 4 * ks + fq));
                        a = __builtin_amdgcn_mfma_f32_16x16x32_bf16(af, bfm, a, 0, 0, 0); }
#pragma unroll
                    for (int j = 0; j < 4; ++j) { const int t = 16 * mt + 4 * fq + j, s = 16 * nn + fr; const float v = (s <= t) ? a[j] : 0.f;
                        *(LAS unsigned short*)(L + SATT + sw128(t, s >> 3) + (s & 7) * 2) = (unsigned short)f2bf(v); }
                }
            }
            f32x4 ao[4];
            { bf16x8 sf[4];
#pragma unroll
              for (int k2 = 0; k2 < 4; ++k2) { v4u p; p.x = pg8::cvt_pk_bf16(S[2 * k2][0], S[2 * k2][1]); p.y = pg8::cvt_pk_bf16(S[2 * k2][2], S[2 * k2][3]);
                  p.z = pg8::cvt_pk_bf16(S[2 * k2 + 1][0], S[2 * k2 + 1][1]); p.w = pg8::cvt_pk_bf16(S[2 * k2 + 1][2], S[2 * k2 + 1][3]); sf[k2] = __builtin_bit_cast(bf16x8, p); }
#pragma unroll
              for (int mt = 0; mt < 4; ++mt) { f32x4 a = (f32x4){0.f, 0.f, 0.f, 0.f};
#pragma unroll
                  for (int k2 = 0; k2 < 4; ++k2) { const bf16x8 af = *(const LAS bf16x8*)(L + SQE + sw512(16 * mt + fr, 4 * (4 * dh + k2) + fq));
                      a = __builtin_amdgcn_mfma_f32_16x16x32_bf16(af, sf[k2], a, 0, 0, 0); }
                  ao[mt] = a; } }
            { const f32x4 e0 = dh ? ao[0] : ao[2], e1 = dh ? ao[1] : ao[3];
              *(LAS f32x4*)(L + SPART + ((w * 2 + 0) * 64 + lane) * 16) = e0; *(LAS f32x4*)(L + SPART + ((w * 2 + 1) * 64 + lane) * 16) = e1; }
            { const bf16x8 v0 = *(const LAS bf16x8*)(L + SVT + sw128(16 * nt + fr, fq)), v1 = *(const LAS bf16x8*)(L + SVT + sw128(16 * nt + fr, 4 + fq));
#pragma unroll
              for (int i = 0; i < 8; ++i) { const int row = 128 * dh + 16 * i + fr;
                  const bf16x8 a0 = *(const LAS bf16x8*)(L + SKET + sw128(row, fq)), a1 = *(const LAS bf16x8*)(L + SKET + sw128(row, 4 + fq));
                  S[i] = __builtin_amdgcn_mfma_f32_16x16x32_bf16(a0, v0, S[i], 0, 0, 0); S[i] = __builtin_amdgcn_mfma_f32_16x16x32_bf16(a1, v1, S[i], 0, 0, 0);
                  const f32x4 el = *(const LAS f32x4*)(L + SEL + (128 * dh + 16 * i + 4 * fq) * 4); S[i] = S[i] * el; } }
            LDS_WAIT(); __syncthreads();
            { const int wo = (1 - dh) * 4 + nt;
              const bf16x8 v0 = *(const LAS bf16x8*)(L + SVT + sw128(16 * nt + fr, fq)), v1 = *(const LAS bf16x8*)(L + SVT + sw128(16 * nt + fr, 4 + fq));
#pragma unroll
              for (int i = 0; i < 2; ++i) { const int mt = 2 * dh + i;
                  f32x4 a = (i == 0 ? (dh ? ao[2] : ao[0]) : (dh ? ao[3] : ao[1])) + *(const LAS f32x4*)(L + SPART + ((wo * 2 + i) * 64 + lane) * 16);
                  const bf16x8 t0 = *(const LAS bf16x8*)(L + SATT + sw128(16 * mt + fr, fq)); a = __builtin_amdgcn_mfma_f32_16x16x32_bf16(t0, v0, a, 0, 0, 0);
                  if (dh) { const bf16x8 t1 = *(const LAS bf16x8*)(L + SATT + sw128(16 * mt + fr, 4 + fq)); a = __builtin_amdgcn_mfma_f32_16x16x32_bf16(t1, v1, a, 0, 0, 0); }
                  const size_t grow = (size_t)b * SEQ + (size_t)c * 64 + 16 * mt + 4 * fq;
                  bf16* op = Og + grow * DM + h * GLA_DV + slice * 64 + 16 * nt + fr;
#pragma unroll
                  for (int j = 0; j < 4; ++j) { float s2 = a[j] * a[j]; s2 = dpp_shr_add(s2, 1); s2 = dpp_shr_add(s2, 2); s2 = dpp_shr_add(s2, 4); s2 = dpp_shr_add(s2, 8);
                      if (fr == 15) SSHg[((grow + j) * 4 + h) * 24 + slice * 4 + nt] = s2;
                      op[(size_t)j * DM] = (bf16)f2bf(a[j] * pg8::silu_f(bf2f(ogv[i * 4 + j]))); } } }
            __syncthreads();
            if (c + 1 < 64) { VM_WAIT(); SCAN_WRITE(); }
            LDS_WAIT(); __syncthreads();
        }
#undef SCAN_LOAD_A
#undef SCAN_LOAD_B
#undef SCAN_WRITE
    }
}

__device__ __forceinline__ void gla_onorm_phase(const Ctx& C, int layer) {
    const bf16* Z = wsp<bf16>(C, WS_Z); bf16* MIX = wsp<bf16>(C, WS_MIX); const float* gain = C.in[10] + (size_t)layer * GLA_V;
    const int gw = C.vcu * NWAVES + C.wave, NGW = C.G * NWAVES, lane = C.lane;
    for (int m = gw; m < MTOK; m += NGW) {
#pragma unroll
        for (int h = 0; h < 4; ++h) {
            float o[8], g[8]; float ss = 0.f;
            if (lane < 48) { const v4u ov = *(const GAS v4u*)(MIX + (size_t)m * DM + h * GLA_DV + lane * 8), gv = *(const GAS v4u*)(Z + (size_t)m * GLA_IN + ZOG + h * GLA_DV + lane * 8);
#pragma unroll
                for (int j = 0; j < 4; ++j) { o[2 * j] = bflo(ov[j]); o[2 * j + 1] = bfhi(ov[j]); g[2 * j] = bflo(gv[j]); g[2 * j + 1] = bfhi(gv[j]); }
#pragma unroll
                for (int j = 0; j < 8; ++j) ss += o[j] * o[j]; }
            const float rstd = 1.0f / sqrtf(wave_sum(ss) * (1.f / GLA_DV) + EPS);
            if (lane < 48) { const f32x4 ga = *(const GAS f32x4*)(gain + h * GLA_DV + lane * 8), gb = *(const GAS f32x4*)(gain + h * GLA_DV + lane * 8 + 4);
                float y[8];
#pragma unroll
                for (int j = 0; j < 8; ++j) { const float gn = j < 4 ? ga[j] : gb[j - 4]; y[j] = o[j] * rstd * gn * pg8::silu_f(g[j]); }
                *(GAS v4u*)(MIX + (size_t)m * DM + h * GLA_DV + lane * 8) = (v4u){pk2(y[0], y[1]), pk2(y[2], y[3]), pk2(y[4], y[5]), pk2(y[6], y[7])}; }
        }
    }
}

__device__ __forceinline__ void fox_cumsum_phase(const Ctx& C) {
    const float* FL = wsp<float>(C, WS_GLR); float* CF = wsp<float>(C, WS_CF); const float* bfp = C.in[14];
    const int gw = C.vcu * NWAVES + C.wave, NGW = C.G * NWAVES, lane = C.lane;
    for (int q = gw; q < BATCH * FOX_H; q += NGW) { const int b = q / FOX_H, h = q - b * FOX_H; const float bias = bfp[h];
        float v[64]; float run = 0.f;
#pragma unroll
        for (int i = 0; i < 64; ++i) { const float x = FL[((size_t)b * SEQ + lane * 64 + i) * 16 + h] + bias; run += fminf(x, 0.f) - 0.6931471805599453f * __builtin_amdgcn_logf(1.0f + __builtin_amdgcn_exp2f(-1.4426950408889634f * fabsf(x))); v[i] = run; }
        LAS float* tot = (LAS float*)(C.lds + C.wave * 256);
        tot[lane] = run; LDS_WAIT(); asm volatile("" ::: "memory");
        float excl = 0.f;
        for (int j = 0; j < 64; ++j) { const float t = tot[j]; excl += (j < lane) ? t : 0.f; }
        LDS_WAIT(); asm volatile("" ::: "memory");
#pragma unroll
        for (int i = 0; i < 64; i += 4) *(GAS f32x4*)(CF + (size_t)q * SEQ + lane * 64 + i) = (f32x4){v[i] + excl, v[i + 1] + excl, v[i + 2] + excl, v[i + 3] + excl} * (-att::INV_SCALE);
    }
}

__device__ __forceinline__ void conv_fix_phase(const Ctx& C, int layer) {
    const float* HALO = wsp<float>(C, WS_HALO); bf16* G = wsp<bf16>(C, WS_Z); const float* cw = C.in[18] + (size_t)layer * 3 * FF2; const float* cb = C.in[19] + (size_t)layer * FF2;
    const int gt = C.vcu * NTHREADS + C.tid, NT = C.G * NTHREADS;
    for (int i = gt; i < 128 * (FFH / 4); i += NT) { const int pm = i / (FFH / 4), c = 4 * (i - pm * (FFH / 4)), pn = c >> 7, cc = c & 127;
        const int ca = pn * 256 + cc, cv = ca + 128;
        const float* h0 = HALO + (size_t)pm * 4 * FF2; const bool first = (pm & 15) == 0; const float* hp = HALO + (size_t)(first ? pm : pm - 1) * 4 * FF2;
        const f32x4 z4 = (f32x4){0.f, 0.f, 0.f, 0.f};
        const f32x4 a0 = *(const GAS f32x4*)(h0 + ca), a1 = *(const GAS f32x4*)(h0 + FF2 + ca), v0 = *(const GAS f32x4*)(h0 + cv), v1 = *(const GAS f32x4*)(h0 + FF2 + cv);
        f32x4 am2 = *(const GAS f32x4*)(hp + 2 * FF2 + ca), am1 = *(const GAS f32x4*)(hp + 3 * FF2 + ca), vm2 = *(const GAS f32x4*)(hp + 2 * FF2 + cv), vm1 = *(const GAS f32x4*)(hp + 3 * FF2 + cv);
        if (first) { am2 = z4; am1 = z4; vm2 = z4; vm1 = z4; }
        const f32x4 wa0 = *(const GAS f32x4*)(cw + c), wa1 = *(const GAS f32x4*)(cw + FF2 + c), wa2 = *(const GAS f32x4*)(cw + 2 * FF2 + c), ba = *(const GAS f32x4*)(cb + c);
        const f32x4 wv0 = *(const GAS f32x4*)(cw + FFH + c), wv1 = *(const GAS f32x4*)(cw + FF2 + FFH + c), wv2 = *(const GAS f32x4*)(cw + 2 * FF2 + FFH + c), bv = *(const GAS f32x4*)(cb + FFH + c);
        const f32x4 ya0 = wa0 * am2 + wa1 * am1 + wa2 * a0 + ba, yv0 = wv0 * vm2 + wv1 * vm1 + wv2 * v0 + bv;
        const f32x4 ya1 = wa0 * am1 + wa1 * a0 + wa2 * a1 + ba, yv1 = wv0 * vm1 + wv1 * v0 + wv2 * v1 + bv;
        float g0[4], g1[4];
#pragma unroll
        for (int j = 0; j < 4; ++j) { g0[j] = pg8::silu_f(ya0[j]) * yv0[j]; g1[j] = pg8::silu_f(ya1[j]) * yv1[j]; }
        *(GAS v2u*)(G + (size_t)(pm * 256) * FFP + c) = (v2u){pk2(g0[0], g0[1]), pk2(g0[2], g0[3])}; *(GAS v2u*)(G + (size_t)(pm * 256 + 1) * FFP + c) = (v2u){pk2(g1[0], g1[1]), pk2(g1[2], g1[3])};
    }
}

struct AttnPlan { int fox; const bf16* Q; int qs; int mqcol; const bf16* MKV; int idx, stride; };
__device__ __forceinline__ att::BlockRef attn_decode(const Ctx& C, const AttnPlan& P, int i, int nfox) {
    att::BlockRef r;
    bf16* MIX = wsp<bf16>(C, WS_MIX);
    if (i < nfox) {
        const int L = P.idx + P.stride * (i >> 1), pass = i & 1;
        const int xcd = L & 7, k = L >> 3, bh = xcd * 12 + (k >> 3), x = k & 7, qb = pass ? 15 - x : x, b = bh / FOX_H, h = bh - b * FOX_H;
        const size_t row0 = (size_t)b * SEQ + (size_t)qb * 256;
        r.Q = P.Q + row0 * P.qs + h * 128; r.qs = P.qs;
        r.K = wsp<bf16>(C, WS_KF) + (size_t)b * SEQ * FOX_W + h * 128; r.V = wsp<bf16>(C, WS_VF) + (size_t)b * SEQ * FOX_W + h * 128; r.kvs = FOX_W;
        r.O = MIX + row0 * DM + h * 128; r.os = DM; r.cb = wsp<float>(C, WS_CF) + (size_t)bh * SEQ; r.P0 = qb * 256; r.skv = SEQ; r.jlo = 0;
    } else {
        const int L = P.idx + P.stride * (i - nfox);
        const int bmh = L >> 4, qb = L & 15, b = bmh >> 2, mh = bmh & 3; const size_t row0 = (size_t)b * SEQ + (size_t)qb * 256;
        r.Q = P.Q + row0 * P.qs + P.mqcol + mh * 128; r.qs = P.qs;
        r.K = P.MKV + (size_t)b * NMEM * 4096 + mh * 128; r.V = r.K + 512; r.kvs = 4096;
        r.O = MIX + row0 * DM + FOX_W + mh * 128; r.os = DM; r.cb = wsp<float>(C, WS_CTL); r.P0 = NMEM; r.skv = NMEM; r.jlo = 0;
    }
    return r;
}
__device__ __forceinline__ void attn_phase(const Ctx& C, const AttnPlan& P) {
    int nfox = 0; if (P.fox) { for (int L = P.idx; L < 768; L += P.stride) nfox += 2; }
    int nmem = 0; for (int L = P.idx; L < 512; L += P.stride) nmem += 1;
    const int n = nfox + nmem; if (n == 0) return;
    att::Seam S; att::BlockRef cur = attn_decode(C, P, 0, nfox);
    att::attn_prime(cur, (char*)C.lds, S, C.wave);
    for (int i = 0; i < n; ++i) {
        const att::BlockRef nxt = (i + 1 < n) ? attn_decode(C, P, i + 1, nfox) : cur;
        att::attn_block(cur, nxt, (char*)C.lds, S, C.wave);
        cur = nxt;
    }
}

#ifndef FOX_BLOCK_QMAX
#define FOX_BLOCK_QMAX 0
#endif
constexpr int CW_NQB = 32768;
constexpr int CW_NK2 = 16384, CW_NQ2 = 16640  , CW_QHEAD = 17408  ;
__device__ __forceinline__ void head_norms_phase(const Ctx& C, const bf16* src, int stride, unsigned* out2, const bool per_block = false) {
    const int gw = C.vcu * NWAVES + C.wave, NGW = C.G * NWAVES, lane = C.lane;
    for (int task = gw; task < BATCH * FOX_H * 16; task += NGW) { const int bh = task >> 4, rb = task & 15, b = bh / FOX_H, h = bh - b * FOX_H;
        const bf16* p = src + ((size_t)b * SEQ + (size_t)rb * 256 + (lane >> 4)) * stride + h * 128 + (lane & 15) * 8; float mx = 0.f;
#pragma unroll 8
        for (int i = 0; i < 64; ++i) { const v4u w = *(const GAS v4u*)(p + (size_t)(4 * i) * stride); float s = 0.f;
#pragma unroll
            for (int j = 0; j < 4; ++j) { const float lo = bflo(w[j]), hi = bfhi(w[j]); s += lo * lo + hi * hi; }
            s = dpp_shr_add(s, 1); s = dpp_shr_add(s, 2); s = dpp_shr_add(s, 4); s = dpp_shr_add(s, 8);
            mx = fmaxf(mx, s); }
        float m0 = __builtin_bit_cast(float, __builtin_amdgcn_readlane(__builtin_bit_cast(int, mx), 15)), m1 = __builtin_bit_cast(float, __builtin_amdgcn_readlane(__builtin_bit_cast(int, mx), 31));
        float m2 = __builtin_bit_cast(float, __builtin_amdgcn_readlane(__builtin_bit_cast(int, mx), 47)), m3 = __builtin_bit_cast(float, __builtin_amdgcn_readlane(__builtin_bit_cast(int, mx), 63));
        const float m = fmaxf(fmaxf(m0, m1), fmaxf(m2, m3));
        if (lane == 0) { if (per_block) out2[task] = __builtin_bit_cast(unsigned, m); else atomicMax(out2 + bh, __builtin_bit_cast(unsigned, m)); } }
}
__device__ __forceinline__ int fox_jlo(const float* cb, int P0, float thr, int lane) {
    const int last = 64 * lane + 63; const bool cand = last < P0;
    const float d = cand ? cb[last] - cb[P0] : 0.f;
    const unsigned long long m = __ballot(cand && d < thr);
    return __builtin_amdgcn_readfirstlane((int)__builtin_ctzll(~m));
}
__device__ __forceinline__ att::BlockRef fox_decode(const Ctx& C, int layer, int code, int lane) {
    att::BlockRef r; bf16* MIX = wsp<bf16>(C, WS_MIX); const bf16* Qz = wsp<bf16>(C, WS_Z);
    const int x = code >> 8, v = code & 255;
    if (v < 192) { const int hl = v % 12, qb = 15 - v / 12, bh = x * 12 + hl, b = bh / FOX_H, h = bh - b * FOX_H; const size_t row0 = (size_t)b * SEQ + (size_t)qb * 256;
        r.Q = Qz + row0 * DM + h * 128; r.qs = DM;
        r.K = wsp<bf16>(C, WS_KF) + (size_t)b * SEQ * FOX_W + h * 128; r.V = wsp<bf16>(C, WS_VF) + (size_t)b * SEQ * FOX_W + h * 128; r.kvs = FOX_W;
        r.O = MIX + row0 * DM + h * 128; r.os = DM; r.cb = wsp<float>(C, WS_CF) + (size_t)bh * SEQ; r.P0 = qb * 256; r.skv = SEQ;
        const unsigned* ctl = (const unsigned*)(C.ws + WS_CTL);
#if FOX_BLOCK_QMAX
        float qn2;
        { float s = 0.f; if (C.tid < 256) s = (float)wsp<unsigned>(C, WS_NQ)[(size_t)(layer - 2) * MTOK * 12 + (row0 + C.tid) * 12 + h];
          const float m = wave_max(s);
          volatile LAS float* mx = (volatile LAS float*)(C.lds + MISC_OFF + 256);
          if (lane == 0) mx[C.wave] = m;
          __syncthreads();
          qn2 = fmaxf(fmaxf(fmaxf(mx[0], mx[1]), fmaxf(mx[2], mx[3])), fmaxf(fmaxf(mx[4], mx[5]), fmaxf(mx[6], mx[7]))) * (1.0f / 256.0f);
          __syncthreads(); }
        const float kn2 = __builtin_bit_cast(float, ctl[CW_NK2 + bh]);
#else
        const float qn2 = __builtin_bit_cast(float, ctl[CW_NQB + 2048 * (layer - 2) + bh * 16 + qb]), kn2 = __builtin_bit_cast(float, ctl[CW_NK2 + bh]);
#endif
        r.jlo = fox_jlo(r.cb, r.P0, -(45.0f * att::INV_SCALE + 2.0f * sqrtf(qn2 * kn2) * 1.01f), lane);
    } else { const int id = x * 64 + (v - 192), bmh = id >> 4, qb = id & 15, b = bmh >> 2, mh = bmh & 3; const size_t row0 = (size_t)b * SEQ + (size_t)qb * 256;
        r.Q = Qz + row0 * DM + FOX_W + mh * 128; r.qs = DM;
        r.K = wsp<bf16>(C, WS_MKV) + 1024 * layer + (size_t)b * NMEM * 4096 + mh * 128; r.V = r.K + 512; r.kvs = 4096;
        r.O = MIX + row0 * DM + FOX_W + mh * 128; r.os = DM; r.cb = wsp<float>(C, WS_CTL); r.P0 = NMEM; r.skv = NMEM; r.jlo = 0; }
    return r;
}
__device__ __forceinline__ int fox_grab(const Ctx& C, int layer) {
    volatile LAS int* box = (volatile LAS int*)(C.lds + MISC_OFF + 128);
    if (C.tid == 0) { unsigned* heads = (unsigned*)(C.ws + WS_CTL) + CW_QHEAD + 64 * 8 * (layer - 2); int code = -1;
        for (int i = 0; i < 8 && code < 0; ++i) { const int q = (C.bx + i) & 7; const unsigned v = __hip_atomic_fetch_add(heads + 64 * q, 1u, __ATOMIC_RELAXED, __HIP_MEMORY_SCOPE_AGENT); if (v < 256u) code = q * 256 + (int)v; }
        box[0] = code; }
    __syncthreads();
    const int code = box[0];
    __syncthreads();
    return code;
}
__device__ __forceinline__ void fox_attn_phase(const Ctx& C, int layer) {
    int code = fox_grab(C, layer); if (code < 0) return;
    att::Seam S; att::BlockRef cur = fox_decode(C, layer, code, C.lane);
    att::attn_prime(cur, (char*)C.lds, S, C.wave);
    for (;;) {
        const int nc = fox_grab(C, layer);
        const att::BlockRef nxt = nc >= 0 ? fox_decode(C, layer, nc, C.lane) : cur;
        att::attn_block(cur, nxt, (char*)C.lds, S, C.wave);
        if (nc < 0) break;
        cur = nxt;
    }
}
enum Kind { K_PROLOGUE = 0, K_MEMKV, K_IN, K_MIX1, K_PREP, K_SCAN, K_ONORM, K_OUT, K_RMSF, K_UP, K_FIX, K_DOWN, K_NORMN, K_KV, K_CUM, K_QN, K_DRYUP, K_DRYDOWN, K_COUNT };
#ifndef KEEP_ONORM
#define KEEP_ONORM 0
#endif
#ifndef QN_IN_EPI
#define QN_IN_EPI 0
#endif
#ifndef IN_WGM
#define IN_WGM 8
#endif
#ifndef MEMKV_FILL
#define MEMKV_FILL 1
#endif
#ifndef QK_TEMPORAL_TILES
#define QK_TEMPORAL_TILES 0
#endif
#ifndef DOWN_WGM
#define DOWN_WGM 4
#endif
#ifndef SKINNY_STAGGER
#define SKINNY_STAGGER 0
#endif
#ifndef PROBE_DUP_IN
#define PROBE_DUP_IN 0
#endif
#ifndef PROBE_DUP_UP
#define PROBE_DUP_UP 0
#endif
#ifndef PROBE_DRY_UP
#define PROBE_DRY_UP 0
#endif
#ifndef PROBE_DRY_DOWN
#define PROBE_DRY_DOWN 0
#endif
__device__ __forceinline__ unsigned* ss_arr(const Ctx& C, int id) { return wsp<unsigned>(C, WS_SS) + (size_t)id * MTOK; }
struct Args { const float* in[21]; float* out; unsigned char* ws; int layer, fused, ph_lo, ph_hi; };
__device__ __forceinline__ void make_ctx(Ctx& C, const Args& args, unsigned char* lds_raw, int wave) {
    int bx = blockIdx.x; asm volatile("" : "+s"(bx));
    int G = gridDim.x; asm volatile("" : "+s"(G));
    unsigned long long z = 0; asm volatile("" : "+s"(z));
    const Args* ap = (const Args*)((const char*)&args + z);
    C.lds = (LAS unsigned char*)lds_raw;
    C.wave = wave; C.tid = opaque_tid(wave); C.lane = C.tid & 63;
    C.G = G; C.bx = bx; C.vcu = (C.G % 8 == 0) ? (C.bx % 8) * (C.G / 8) + C.bx / 8 : C.bx;
#pragma unroll
    for (int i = 0; i < 21; ++i) C.in[i] = ap->in[i];
    C.out = ap->out; C.ws = ap->ws;
}
__device__ __forceinline__ int wave_index() { int w = __builtin_amdgcn_readfirstlane((int)threadIdx.x >> 6); asm volatile("" : "+s"(w)); return w; }
template <int KIND> __device__ __forceinline__ void run_phase(const Ctx& C, int layer) {
    LAS unsigned char* ring = C.lds;
    const bool gla = layer < 2; const int lj = gla ? layer : layer - 2;
    if constexpr (KIND == K_PROLOGUE) { p0_prologue(C); }
    if constexpr (KIND == K_MEMKV) {
        pg8::Gemm g{wsp<bf16>(C, WS_MEMN), wsp<bf16>(C, WS_WMEM), MMEM, 4096, DM}; pg8::StaticOrder S; S.init(MMEM, 4096, C.G, C.bx);
        pg8::EpiBf16 E{wsp<bf16>(C, WS_MKV), 4096, nullptr, nullptr, C.lds + XTRA_OFF};
        pg8::gemm_phase<pg8::EpiBf16, pg8::StaticOrder, true, true>(ring, g, S, E, C.wave);
        if (MEMKV_FILL && C.G > 128 && C.bx >= 128)
            skinny16_phase(C, wsp<bf16>(C, WS_H), wsp<bf16>(C, WS_WGLR), wsp<float>(C, WS_GLR), ss_arr(C, 0), (C.bx - 128) * NWAVES + C.wave, (C.G - 128) * NWAVES);
    }
    if constexpr (KIND == K_IN) {
        const int N = gla ? GLA_IN : DM;
        const bf16* Bt = gla ? wsp<bf16>(C, WS_WGIN) + (size_t)lj * GLA_IN * DM : wsp<bf16>(C, WS_WFIN) + (size_t)lj * DM * DM;
        const bf16* Aop = wsp<bf16>(C, WS_H); const unsigned* ssp = ss_arr(C, 2 * layer);
        pg8::Gemm g{Aop, Bt, MTOK, N, DM, XBP}; pg8::StaticOrder S; S.init(MTOK, N, C.G, C.bx, IN_WGM);
        pg8::EpiBf16H E{wsp<bf16>(C, WS_Z), N, ssp, (QN_IN_EPI && !gla) ? (unsigned*)(C.ws + WS_CTL) + CW_NQB + 2048 * lj : nullptr, C.lds + XTRA_OFF, gla ? QK_TEMPORAL_TILES : 0};
        const bool early = SKINNY_STAGGER && ((C.bx >> 3) & 1) != 0;
        if (gla && early) skinny16_phase(C, Aop, wsp<bf16>(C, WS_WGLR) + (size_t)lj * 16 * DM, wsp<float>(C, WS_GLR), ssp);
        pg8::gemm_phase<pg8::EpiBf16H, pg8::StaticOrder, true, true>(ring, g, S, E, C.wave);
        if (gla && !early && !(MEMKV_FILL && layer == 0 && C.G > 128)) skinny16_phase(C, Aop, wsp<bf16>(C, WS_WGLR) + (size_t)lj * 16 * DM, wsp<float>(C, WS_GLR), ssp);
    }
    if constexpr (KIND == K_MIX1) { fox_attn_phase(C, layer); }
    if constexpr (KIND == K_QN) { head_norms_phase(C, wsp<bf16>(C, WS_Z), DM, (unsigned*)(C.ws + WS_CTL) + CW_NQB + 2048 * (layer - 2), true); }
    if constexpr (KIND == K_PREP) { gla_prep_phase(C, lj); }
    if constexpr (KIND == K_SCAN) {
        if (C.vcu < 192) gla_scan_phase(C);
        else { AttnPlan P; P.fox = 0; P.Q = wsp<bf16>(C, WS_Z); P.qs = GLA_IN; P.mqcol = ZMQ; P.MKV = wsp<bf16>(C, WS_MKV) + 1024 * layer; P.idx = C.vcu - 192; P.stride = C.G - 192;
            attn_phase(C, P); __syncthreads(); convert_late(C, layer, (C.vcu - 192) * NWAVES + C.wave, (C.G - 192) * NWAVES); }
    }
    if constexpr (KIND == K_ONORM) { gla_onorm_phase(C, lj); }
    if constexpr (KIND == K_OUT) {
        const float* xin = (layer == 0) ? C.in[0] : nullptr;
        const bf16* Bt = gla ? wsp<bf16>(C, WS_WGOUT) + (size_t)lj * DM * DM : wsp<bf16>(C, WS_WFOUT) + (size_t)lj * DM * DM;
        pg8::Gemm g{wsp<bf16>(C, WS_MIX), Bt, MTOK, DM, DM}; pg8::StaticOrder S; S.init(MTOK, DM, C.G, C.bx, DOWN_WGM);
        if (gla) { pg8::EpiResK E{xin, wsp<bf16>(C, WS_XH), wsp<bf16>(C, WS_H), ss_arr(C, 1 + 2 * layer), XBP, wsp<float>(C, WS_SSH), C.lds + XTRA_OFF};
            pg8::gemm_phase<pg8::EpiResK, pg8::StaticOrder, true, true>(ring, g, S, E, C.wave); }
        else { pg8::EpiRes E{xin, wsp<bf16>(C, WS_XH), wsp<bf16>(C, WS_H), ss_arr(C, 1 + 2 * layer), XBP, nullptr, C.lds + XTRA_OFF};
            pg8::gemm_phase<pg8::EpiRes, pg8::StaticOrder, true, true>(ring, g, S, E, C.wave); }
    }
    if constexpr (KIND == K_UP) {
        const bf16* Aop = wsp<bf16>(C, WS_H); const unsigned* ssp = ss_arr(C, 1 + 2 * layer);
        pg8::Gemm g{Aop, wsp<bf16>(C, WS_WUP) + (size_t)layer * FF2 * DM, MTOK, FF2, DM, XBP}; pg8::StaticOrder S; S.init(MTOK, FF2, C.G, C.bx);
        pg8::EpiConv E{wsp<bf16>(C, WS_Z), wsp<float>(C, WS_HALO), C.in[18] + (size_t)layer * 3 * FF2, C.in[19] + (size_t)layer * FF2, C.lds + XTRA_OFF, ssp, FFP};
        pg8::gemm_phase<pg8::EpiConv, pg8::StaticOrder, true, true>(ring, g, S, E, C.wave);
    }
#if defined(PROBE_DRY)
    if constexpr (KIND == K_DRYUP) {
        pg8::Gemm g{wsp<bf16>(C, WS_H), wsp<bf16>(C, WS_WUP) + (size_t)layer * FF2 * DM, MTOK, FF2, DM, XBP}; pg8::StaticOrder S; S.init(MTOK, FF2, C.G, C.bx);
        pg8::EpiDry E{wsp<float>(C, WS_HALO)};
        pg8::gemm_phase<pg8::EpiDry, pg8::StaticOrder, true, true>(ring, g, S, E, C.wave);
    }
    if constexpr (KIND == K_DRYDOWN) {
        pg8::Gemm g{wsp<bf16>(C, WS_Z), wsp<bf16>(C, WS_WDOWN) + (size_t)layer * DM * FFH, MTOK, DM, FFH}; pg8::StaticOrder S; S.init(MTOK, DM, C.G, C.bx);
        pg8::EpiDry E{wsp<float>(C, WS_HALO)};
        pg8::gemm_phase<pg8::EpiDry, pg8::StaticOrder, true, true>(ring, g, S, E, C.wave);
    }
#endif
    if constexpr (KIND == K_FIX) { conv_fix_phase(C, layer); }
    if constexpr (KIND == K_DOWN) {
        pg8::Gemm g{wsp<bf16>(C, WS_Z), wsp<bf16>(C, WS_WDOWN) + (size_t)layer * DM * FFH, MTOK, DM, FFH, FFP}; pg8::StaticOrder S; S.init(MTOK, DM, C.G, C.bx, DOWN_WGM);
        pg8::EpiRes E{nullptr, wsp<bf16>(C, WS_XH), (RES_BF16 || layer < 3) ? wsp<bf16>(C, WS_H) : nullptr, layer < 3 ? ss_arr(C, 2 + 2 * layer) : nullptr, XBP, nullptr, C.lds + XTRA_OFF};
        pg8::gemm_phase<pg8::EpiRes, pg8::StaticOrder, true, true>(ring, g, S, E, C.wave);
    }
    if constexpr (KIND == K_NORMN) { rms_bf16_phase(C, wsp<bf16>(C, RES_BF16 ? WS_H : WS_XH), C.in[5], C.out); }
    if constexpr (KIND == K_KV) {
        const bf16* Aop = wsp<bf16>(C, WS_H); const unsigned* ssp = ss_arr(C, 4);
        pg8::Gemm g{Aop, wsp<bf16>(C, WS_WFKV), MTOK, 3072, DM, XBP}; pg8::StaticOrder S; S.init(MTOK, 3072, C.G, C.bx);
        pg8::EpiSplit2 E{wsp<bf16>(C, WS_KF), wsp<bf16>(C, WS_VF), FOX_W, ssp};
        const bool early = SKINNY_STAGGER && ((C.bx >> 3) & 1) != 0;
        if (early) skinny16_phase(C, Aop, wsp<bf16>(C, WS_WFL), wsp<float>(C, WS_GLR), ssp);
        pg8::gemm_phase<pg8::EpiSplit2, pg8::StaticOrder, true, true>(ring, g, S, E, C.wave);
        if (!early) skinny16_phase(C, Aop, wsp<bf16>(C, WS_WFL), wsp<float>(C, WS_GLR), ssp);
    }
    if constexpr (KIND == K_CUM) { fox_cumsum_phase(C); head_norms_phase(C, wsp<bf16>(C, WS_KF), FOX_W, (unsigned*)(C.ws + WS_CTL) + CW_NK2); }
}
template <int KIND> __global__ void __launch_bounds__(NTHREADS, 2) phase_kernel(Args args) {
    extern __shared__ __attribute__((aligned(16))) unsigned char lds_raw[];
    Ctx C; make_ctx(C, args, lds_raw, wave_index());
    run_phase<KIND>(C, args.layer);
}
__global__ void __launch_bounds__(NTHREADS, 2) hybrid_fwd(Args args) {
    extern __shared__ __attribute__((aligned(16))) unsigned char lds_raw[];
    const int wave = wave_index();
    volatile LAS unsigned* MISC = (volatile LAS unsigned*)((LAS unsigned char*)lds_raw + MISC_OFF);
    { const int t = opaque_tid(wave); if (t < 64) MISC[t] = 0u; }
    __syncthreads();
    XcdBarrier bar = xcd_barrier_post((unsigned*)(args.ws + WS_CTL) + CW_BAR, MISC + 8, wave);
#define PHASE(KIND, L) do { Ctx C; make_ctx(C, args, lds_raw, wave); run_phase<KIND>(C, (L)); } while (0)
#define SEAM() do { XcdBarrier b_ = bar; asm volatile("" : "+s"(b_.bar)); xcd_barrier(b_, wave); } while (0)
    PHASE(K_PROLOGUE, 0); SEAM();
    PHASE(K_MEMKV, 0);
#define LAYER(layer) do {                                                                                   \
        if (PROBE_DUP_IN && (layer) == 0) { PHASE(K_IN, layer); SEAM(); }                                   \
        PHASE(K_IN, layer); SEAM();                                                                         \
        if ((layer) == 2) { PHASE(K_CUM, layer); if (FOX_BLOCK_QMAX || QN_IN_EPI) SEAM(); }     \
        if (!FOX_BLOCK_QMAX && !QN_IN_EPI && (layer) >= 2) { PHASE(K_QN, layer); SEAM(); }                                \
        if ((layer) < 2) { PHASE(K_PREP, layer); } else { PHASE(K_MIX1, layer); } SEAM();                   \
        if ((layer) < 2) { PHASE(K_SCAN, layer); SEAM(); if (KEEP_ONORM) { PHASE(K_ONORM, layer); SEAM(); } }  \
        PHASE(K_OUT, layer); SEAM();                                                \
        if (PROBE_DRY_UP && (layer) == 2) { PHASE(K_DRYUP, layer); SEAM(); }                                \
        if (PROBE_DUP_UP && (layer) == 2) { PHASE(K_UP, layer); SEAM(); }                                   \
        PHASE(K_UP, layer); SEAM();                                                               \
        PHASE(K_FIX, layer); SEAM();                                                                        \
        if (PROBE_DRY_DOWN && (layer) == 2) { PHASE(K_DRYDOWN, layer); SEAM(); }                            \
        PHASE(K_DOWN, layer); SEAM();                                               \
        if ((layer) == 3) { PHASE(K_NORMN, layer); }                                                        \
        if ((layer) == 1) { PHASE(K_KV, layer); } } while (0)
    LAYER(0); LAYER(1); LAYER(2); LAYER(3);
#undef LAYER
#undef PHASE
#undef SEAM
}
template <int KIND> static void launch_phase(Args& a, int layer, int grid, hipStream_t stream) {
    static bool attr = false;
    if (!attr) { (void)hipFuncSetAttribute((const void*)phase_kernel<KIND>, hipFuncAttributeMaxDynamicSharedMemorySize, LDS_BYTES); attr = true; }
    a.layer = layer;
    hipLaunchKernelGGL(phase_kernel<KIND>, dim3(grid), dim3(NTHREADS), LDS_BYTES, stream, a);
}

constexpr size_t WS_NEED = WS_NQ + (size_t)2 * MTOK * 12 * 4;
extern "C" void kernel_launch(void* const* d_in, const int* in_sizes, int n_in, void* d_out, int out_size, void* d_ws, size_t ws_size, hipStream_t stream) {
    static int grid = 0;
    if (grid == 0) {
        if (n_in != 21 || in_sizes[0] != MTOK * DM || out_size != MTOK * DM || ws_size < WS_NEED) {
            fprintf(stderr, "kernel_launch: unexpected shapes / workspace (n_in %d, in0 %d, out %d, ws %zu < %zu); nothing launched\n", n_in, n_in > 0 ? in_sizes[0] : -1, out_size, ws_size, (size_t)WS_END); grid = -1; return; }
        int dev = 0, cus = 0;
        if (hipGetDevice(&dev) != hipSuccess || hipDeviceGetAttribute(&cus, hipDeviceAttributeMultiprocessorCount, dev) != hipSuccess) { grid = -1; return; }
        if (cus < 192) { fprintf(stderr, "kernel_launch: needs >= 192 CUs\n"); grid = -1; return; }
        grid = cus;
    }
    if (grid < 0) return;
    if (hipMemsetAsync((char*)d_ws + WS_CTL, 0, CTL_BYTES + (size_t)9 * MTOK * 4, stream) != hipSuccess) return;
    Args a{};
    for (int i = 0; i < 21; ++i) a.in[i] = (const float*)d_in[i];
    a.out = (float*)d_out; a.ws = (unsigned char*)d_ws;
#if MK_FUSED
    static bool attr = false;
    if (!attr) { if (hipFuncSetAttribute((const void*)hybrid_fwd, hipFuncAttributeMaxDynamicSharedMemorySize, LDS_BYTES) != hipSuccess) { fprintf(stderr, "kernel_launch: hipFuncSetAttribute failed\n"); return; } attr = true; }
    a.fused = 1;
    hipLaunchKernelGGL(hybrid_fwd, dim3(grid), dim3(NTHREADS), LDS_BYTES, stream, a);
#else
    launch_phase<K_PROLOGUE>(a, 0, grid, stream);
    launch_phase<K_MEMKV>(a, 0, grid, stream);
    for (int layer = 0; layer < 4; ++layer) {
        launch_phase<K_IN>(a, layer, grid, stream);
        if (layer < 2) launch_phase<K_PREP>(a, layer, grid, stream); else { launch_phase<K_QN>(a, layer, grid, stream); launch_phase<K_MIX1>(a, layer, grid, stream); }
        if (layer < 2) { launch_phase<K_SCAN>(a, layer, grid, stream); launch_phase<K_ONORM>(a, layer, grid, stream); }
        launch_phase<K_OUT>(a, layer, grid, stream);
        launch_phase<K_UP>(a, layer, grid, stream);
        launch_phase<K_FIX>(a, layer, grid, stream);
        launch_phase<K_DOWN>(a, layer, grid, stream);
        if (layer == 3) launch_phase<K_NORMN>(a, layer, grid, stream);
        if (layer == 1) { launch_phase<K_KV>(a, layer, grid, stream); launch_phase<K_CUM>(a, layer, grid, stream); }
    }
#endif
}
```

```cpp
#include <hip/hip_runtime.h>
#include <cstdio>
#include <cstdint>
#ifndef MK_FUSED
#define MK_FUSED 1
#endif
__device__ __forceinline__ int opaque_tid(int wave) { int l; asm volatile("v_mbcnt_lo_u32_b32 %0, -1, 0\n\tv_mbcnt_hi_u32_b32 %0, -1, %0" : "=v"(l)); return wave * 64 + l; }
namespace pg8 {
#define PG8_LAS __attribute__((address_space(3)))
typedef unsigned short bf16_t;
typedef short bf16x8 __attribute__((ext_vector_type(8)));
typedef float f32x4 __attribute__((ext_vector_type(4)));
typedef unsigned u32x4 __attribute__((ext_vector_type(4)));
typedef unsigned u32x2 __attribute__((ext_vector_type(2)));
constexpr int BM = 256, BK = 64, HALF = 128, HTB = HALF * BK * 2  , STAGE_BYTES = 8 * HTB, NXCD = 8, WGM = 8;

__host__ __device__ __forceinline__ int lds_byte(int r, int c) { const int st = (r >> 4) * 2 + (c >> 5), rr = r & 15, cc = c & 31, ob = rr * 64 + cc * 2; return st * 1024 + (ob ^ (((ob >> 9) & 1) << 5)); }
__host__ __device__ __forceinline__ void stage_rc(int b, int& R, int& C) { const int st = b / 1024, sb = b % 1024, swz = sb ^ (((sb >> 9) & 1) << 5); R = (st >> 1) * 16 + swz / 64; C = (st & 1) * 32 + (swz % 64) / 2; }
__host__ __device__ __forceinline__ int perm32(int rho) { const int n = rho >> 4, i = rho & 15; return 8 * (i >> 2) + 4 * n + (i & 3); }

typedef _Float16 h16x8 __attribute__((ext_vector_type(8)));
typedef _Float16 h16x2 __attribute__((ext_vector_type(2)));
template <bool F16> __device__ __forceinline__ f32x4 mfma16(bf16x8 a, bf16x8 b, f32x4 c) {
    if constexpr (F16) return __builtin_amdgcn_mfma_f32_16x16x32_f16(__builtin_bit_cast(h16x8, a), __builtin_bit_cast(h16x8, b), c, 0, 0, 0);
    else return __builtin_amdgcn_mfma_f32_16x16x32_bf16(a, b, c, 0, 0, 0);
}
__device__ __forceinline__ unsigned pkh2(float lo, float hi) { h16x2 v; v.x = (_Float16)lo; v.y = (_Float16)hi; return __builtin_bit_cast(unsigned, v); }
__device__ __forceinline__ float h2lo(unsigned w) { return (float)__builtin_bit_cast(h16x2, w).x; }
__device__ __forceinline__ float h2hi(unsigned w) { return (float)__builtin_bit_cast(h16x2, w).y; }
struct Unit { int pm, pn; };
struct Gemm { const bf16_t* A; const bf16_t* Bt; int M, N, K; int lda = 0; };

struct StaticOrder {
    int nM, nN, nwg, G, c, wgm;
    __host__ __device__ void init(int M, int N, int G_, int c_, int wgm_ = WGM) { nM = M / BM; nN = N / BM; nwg = nM * nN; G = G_; c = c_; wgm = wgm_; }
    __host__ __device__ bool next(int i, Unit& u) const {
        const long L = (long)i * G + c; if (L >= nwg) return false;
        int wgid = (int)L; { const int q = nwg / NXCD, r = nwg % NXCD, xcd = wgid % NXCD, off = wgid / NXCD; wgid = (xcd < r ? xcd * (q + 1) : r * (q + 1) + (xcd - r) * q) + off; }
        const int nig = wgm * nN, gid = wgid / nig, fm = gid * wgm, gsz = (nM - fm) < wgm ? (nM - fm) : wgm;
        u.pm = fm + ((wgid % nig) % gsz); u.pn = (wgid % nig) / gsz; return true;
    }
    __device__ __forceinline__ void a_ready(const Unit&) const {}
    __device__ __forceinline__ void done(const Unit&) const {}
};

__device__ __forceinline__ unsigned cvt_pk_bf16(float lo, float hi) { unsigned r; asm volatile("v_cvt_pk_bf16_f32 %0, %1, %2" : "=v"(r) : "v"(lo), "v"(hi)); return r; }

__device__ __forceinline__ float sum_fq(float s) {
    s += __builtin_bit_cast(float, __builtin_amdgcn_ds_swizzle(__builtin_bit_cast(int, s), 0x401F));
    float a = s, b = s; asm volatile("s_nop 1\n\tv_permlane32_swap_b32 %0, %1\n\ts_nop 1" : "+v"(a), "+v"(b));
    return a + b;
}
constexpr float SS_SCALE = 1024.0f;
__device__ __forceinline__ void row_rstd(const unsigned* ss, int row0, int fq, float (&rs)[2][4]) {
#pragma unroll
    for (int ai = 0; ai < 2; ++ai)
#pragma unroll
        for (int m = 0; m < 4; ++m) rs[ai][m] = ss ? __builtin_amdgcn_rsqf((float)ss[row0 + ai * HALF + m * 16] * (1.0f / (SS_SCALE * 2048.0f)) + 1e-6f) : 1.0f;
}
__device__ __forceinline__ u32x4 bperm4(int a, u32x4 w) { u32x4 r; r.x = (unsigned)__builtin_amdgcn_ds_bpermute(a, (int)w.x); r.y = (unsigned)__builtin_amdgcn_ds_bpermute(a, (int)w.y); r.z = (unsigned)__builtin_amdgcn_ds_bpermute(a, (int)w.z); r.w = (unsigned)__builtin_amdgcn_ds_bpermute(a, (int)w.w); return r; }
#define PG8_STORE_PERM const int lane_ = fq * 16 + fr, pq = lane_ & 3, pr = 4 * ((lane_ >> 2) & 3) + (lane_ >> 4), bpa = 4 * (16 * pq + pr)
__device__ __forceinline__ void ss_load_rows(const unsigned* ss, int row0, unsigned (&raw)[8]) {
#pragma unroll
    for (int ai = 0; ai < 2; ++ai)
#pragma unroll
        for (int m = 0; m < 4; ++m) raw[ai * 4 + m] = ss ? ss[row0 + ai * HALF + m * 16] : 0u;
}
__device__ __forceinline__ void rs_from_raw(const unsigned* ss, const unsigned (&raw)[8], float (&rs)[2][4]) {
#pragma unroll
    for (int ai = 0; ai < 2; ++ai)
#pragma unroll
        for (int m = 0; m < 4; ++m) rs[ai][m] = ss ? __builtin_amdgcn_rsqf((float)raw[ai * 4 + m] * (1.0f / (SS_SCALE * 2048.0f)) + 1e-6f) : 1.0f;
}
__device__ __forceinline__ float wave_max_nn(float v) {
    v = fmaxf(v, __builtin_bit_cast(float, __builtin_amdgcn_update_dpp(0, __builtin_bit_cast(int, v), 0x111, 0xf, 0xf, true)));
    v = fmaxf(v, __builtin_bit_cast(float, __builtin_amdgcn_update_dpp(0, __builtin_bit_cast(int, v), 0x112, 0xf, 0xf, true)));
    v = fmaxf(v, __builtin_bit_cast(float, __builtin_amdgcn_update_dpp(0, __builtin_bit_cast(int, v), 0x114, 0xf, 0xf, true)));
    v = fmaxf(v, __builtin_bit_cast(float, __builtin_amdgcn_update_dpp(0, __builtin_bit_cast(int, v), 0x118, 0xf, 0xf, true)));
    v = fmaxf(v, __builtin_bit_cast(float, __builtin_amdgcn_update_dpp(0, __builtin_bit_cast(int, v), 0x142, 0xa, 0xf, false)));
    v = fmaxf(v, __builtin_bit_cast(float, __builtin_amdgcn_update_dpp(0, __builtin_bit_cast(int, v), 0x143, 0xc, 0xf, false)));
    return __builtin_bit_cast(float, __builtin_amdgcn_readlane(__builtin_bit_cast(int, v), 63));
}
template <bool F16_> struct EpiBf16T {
    static constexpr bool PERM = true, AFTER_DRAIN = false, APERM = false, F16 = F16_, KSCALE = false;
    bf16_t* O; int ldc; const unsigned* ss; unsigned* qn; PG8_LAS unsigned char* xl; int tpn = 0;
    static constexpr bool SS_PRE = true;
    __device__ __forceinline__ void ss_load(const Unit& u, int wr, int fr, unsigned (&raw)[8]) const { ss_load_rows(ss, u.pm * BM + wr * 64 + fr, raw); }
    __device__ __forceinline__ void operator()(const f32x4 (&acc)[2][2][4][2], const Unit& u, int wr, int wc, int fr, int fq, const unsigned (&raw)[8]) const {
        const int row0 = u.pm * BM + wr * 64 + fr; const int col0 = u.pn * BM + wc * 32 + 8 * fq;
        float rs[2][4]; rs_from_raw(ss, raw, rs);
#pragma unroll
        for (int ai = 0; ai < 2; ++ai)
#pragma unroll
            for (int m = 0; m < 4; ++m) { bf16_t* rowp = O + (size_t)(row0 + ai * HALF + m * 16) * ldc + col0;
#pragma unroll
                for (int bj = 0; bj < 2; ++bj) { const f32x4 v0 = acc[ai][bj][m][0] * rs[ai][m], v1 = acc[ai][bj][m][1] * rs[ai][m];
                    u32x4 w; w.x = cvt_pk_bf16(v0[0], v0[1]); w.y = cvt_pk_bf16(v0[2], v0[3]); w.z = cvt_pk_bf16(v1[0], v1[1]); w.w = cvt_pk_bf16(v1[2], v1[3]);
                    if (u.pn < tpn) *(u32x4*)(rowp + bj * HALF) = w;
                    else __builtin_nontemporal_store(w, (u32x4*)(rowp + bj * HALF));
                    if (qn != nullptr && u.pn < 6) {
                        float s = ((v0[0] * v0[0] + v0[1] * v0[1]) + (v0[2] * v0[2] + v0[3] * v0[3])) + ((v1[0] * v1[0] + v1[1] * v1[1]) + (v1[2] * v1[2] + v1[3] * v1[3]));
                        s = sum_fq(s);
                        if (fq == 0) *(PG8_LAS float*)(xl + (((bj * BM + ai * HALF + wr * 64 + m * 16 + fr) * 4 + wc) * 4)) = s; } } }
        if (qn != nullptr && u.pn < 6) {
            asm volatile("s_waitcnt lgkmcnt(0)" ::: "memory"); __builtin_amdgcn_s_barrier(); asm volatile("" ::: "memory");
            const int lane_ = fq * 16 + fr, tid_ = (wr * 4 + wc) * 64 + lane_, bj2 = tid_ >> 8, row = tid_ & 255;
            const f32x4 pp = *(const PG8_LAS f32x4*)(xl + ((bj2 * BM + row) * 4) * 4);
            float t = (pp[0] + pp[1]) + (pp[2] + pp[3]);
            t = wave_max_nn(t);
            if (lane_ == 0) atomicMax(qn + ((u.pm >> 4) * 12 + 2 * u.pn + bj2) * 16 + (u.pm & 15), __builtin_bit_cast(unsigned, t));
        }
    }
};
typedef EpiBf16T<false> EpiBf16; typedef EpiBf16T<false> EpiBf16H;
#if defined(PROBE_DRY)
struct EpiDry {
    static constexpr bool PERM = true, AFTER_DRAIN = false, APERM = false, F16 = false, KSCALE = false;
    float* sink;
    static constexpr bool SS_PRE = false;
    __device__ __forceinline__ void operator()(const f32x4 (&acc)[2][2][4][2], const Unit& u, int wr, int wc, int fr, int fq, const unsigned (&raw)[8]) const {
        int never = 0x7ffffff; asm volatile("" : "+s"(never));
        if (u.pm == never) { f32x4 s = (f32x4){0.f, 0.f, 0.f, 0.f};
#pragma unroll
            for (int ai = 0; ai < 2; ++ai)
#pragma unroll
                for (int bj = 0; bj < 2; ++bj)
#pragma unroll
                    for (int m = 0; m < 4; ++m) s += acc[ai][bj][m][0] + acc[ai][bj][m][1];
            *(f32x4*)(sink + (wr * 4 + wc) * 256 + (fq * 16 + fr) * 4) = s; }
    }
};
#endif
struct EpiSplit2 {
    static constexpr bool PERM = true, AFTER_DRAIN = false, APERM = false, F16 = false, KSCALE = false;
    bf16_t* O0; bf16_t* O1; int ldc; const unsigned* ss;
    static constexpr bool SS_PRE = true;
    __device__ __forceinline__ void ss_load(const Unit& u, int wr, int fr, unsigned (&raw)[8]) const { ss_load_rows(ss, u.pm * BM + wr * 64 + fr, raw); }
    __device__ __forceinline__ void operator()(const f32x4 (&acc)[2][2][4][2], const Unit& u, int wr, int wc, int fr, int fq, const unsigned (&raw)[8]) const {
        const int row0 = u.pm * BM + wr * 64 + fr; int colt = u.pn * BM; bf16_t* base = O0; if (colt >= ldc) { base = O1; colt -= ldc; }
        const int col0 = colt + wc * 32 + 8 * fq;
        float rs[2][4]; rs_from_raw(ss, raw, rs);
#pragma unroll
        for (int ai = 0; ai < 2; ++ai)
#pragma unroll
            for (int m = 0; m < 4; ++m) { bf16_t* rowp = base + (size_t)(row0 + ai * HALF + m * 16) * ldc + col0;
#pragma unroll
                for (int bj = 0; bj < 2; ++bj) { const f32x4 v0 = acc[ai][bj][m][0] * rs[ai][m], v1 = acc[ai][bj][m][1] * rs[ai][m];
                    u32x4 w; w.x = cvt_pk_bf16(v0[0], v0[1]); w.y = cvt_pk_bf16(v0[2], v0[3]); w.z = cvt_pk_bf16(v1[0], v1[1]); w.w = cvt_pk_bf16(v1[2], v1[3]);
                    __builtin_nontemporal_store(w, (u32x4*)(rowp + bj * HALF)); } }
    }
};
#ifndef EPI_RES_PERM
#define EPI_RES_PERM 0
#endif
#ifndef RES_BF16
#define RES_BF16 1
#endif
__device__ __forceinline__ f32x4 b4_to_f32(u32x2 w) { f32x4 r; r[0] = __builtin_bit_cast(float, w.x << 16); r[1] = __builtin_bit_cast(float, w.x & 0xffff0000u); r[2] = __builtin_bit_cast(float, w.y << 16); r[3] = __builtin_bit_cast(float, w.y & 0xffff0000u); return r; }
__device__ __forceinline__ f32x4 h4_to_f32(u32x2 w) { f32x4 r; r[0] = h2lo(w.x); r[1] = h2hi(w.x); r[2] = h2lo(w.y); r[3] = h2hi(w.y); return r; }
typedef float float2_t __attribute__((ext_vector_type(2)));
template <bool KS_> struct EpiResT {
    static constexpr bool PERM = true, AFTER_DRAIN = false, APERM = false, F16 = false, KSCALE = KS_;
    const float* base; bf16_t* xh; bf16_t* xb; unsigned* ssq; int ldc; const float* ssh; PG8_LAS unsigned char* rl; int ldx = 2048;
    static constexpr bool SS_PRE = false;
    __device__ __forceinline__ void unit_ratios(const Unit& u, int tid) const {
        const int row = tid >> 1, hp = tid & 1;
        const f32x4* p = (const f32x4*)(ssh + ((size_t)(u.pm * BM + row) * 4 + 2 * hp) * 24);
        f32x4 v[12];
#pragma unroll
        for (int i = 0; i < 12; ++i) v[i] = p[i];
        float sa = 0.f, sb = 0.f;
#pragma unroll
        for (int i = 0; i < 6; ++i) { sa += (v[i][0] + v[i][1]) + (v[i][2] + v[i][3]); sb += (v[6 + i][0] + v[6 + i][1]) + (v[6 + i][2] + v[6 + i][3]); }
        sa = __builtin_amdgcn_rsqf(sa * (1.0f / 384.0f) + 1e-6f); sb = __builtin_amdgcn_rsqf(sb * (1.0f / 384.0f) + 1e-6f);
        const float pa = __builtin_bit_cast(float, __builtin_amdgcn_update_dpp(0, __builtin_bit_cast(int, sa), 0xB1, 0xf, 0xf, true));
        const float r0 = sa * __builtin_amdgcn_rcpf(sb), r1 = hp ? sb : sb * __builtin_amdgcn_rcpf(pa);
        *(PG8_LAS float2_t*)(rl + (row * 4 + 2 * hp) * 4) = (float2_t){r0, r1};
    }
    __device__ __forceinline__ void kscale(f32x4 (&acc)[2][2][4][2], int idx, int wr, int fr) const {
#pragma unroll
        for (int ai = 0; ai < 2; ++ai)
#pragma unroll
            for (int m = 0; m < 4; ++m) { const float r = *(const PG8_LAS float*)(rl + ((ai * HALF + wr * 64 + m * 16 + fr) * 4 + idx) * 4);
#pragma unroll
                for (int bj = 0; bj < 2; ++bj) { acc[ai][bj][m][0] *= r; acc[ai][bj][m][1] *= r; } }
    }
    __device__ __forceinline__ void operator()(const f32x4 (&acc)[2][2][4][2], const Unit& u, int wr, int wc, int fr, int fq, const unsigned (&)[8]) const {
        const int row0 = u.pm * BM + wr * 64 + fr, col0 = u.pn * BM + wc * 32 + 8 * fq;
        if (base == nullptr) {
            u32x4 raw[2][4][2];
#pragma unroll
            for (int ai = 0; ai < 2; ++ai)
#pragma unroll
                for (int m = 0; m < 4; ++m) { const size_t off = (size_t)(row0 + ai * HALF + m * 16) * ldc + col0;
#pragma unroll
                    for (int bj = 0; bj < 2; ++bj) raw[ai][m][bj] = *(const u32x4*)((RES_BF16 ? xb : xh) + off + bj * HALF); }
#if EPI_RES_PERM
            PG8_STORE_PERM;
            const int srow0 = u.pm * BM + wr * 64 + pr, scol0 = u.pn * BM + wc * 32 + 8 * pq;
#else
            const int srow0 = row0, scol0 = col0;
#define bperm4(a, w) (w)
#endif
#pragma unroll
            for (int ai = 0; ai < 2; ++ai) {
#pragma unroll
                for (int m = 0; m < 4; ++m) { const size_t soff = (size_t)(srow0 + ai * HALF + m * 16) * ldc + scol0; float s = 0.f;
#pragma unroll
                    for (int bj = 0; bj < 2; ++bj) { const u32x4 r = raw[ai][m][bj];
                        const f32x4 v0 = (RES_BF16 ? b4_to_f32((u32x2){r.x, r.y}) : h4_to_f32((u32x2){r.x, r.y})) + acc[ai][bj][m][0], v1 = (RES_BF16 ? b4_to_f32((u32x2){r.z, r.w}) : h4_to_f32((u32x2){r.z, r.w})) + acc[ai][bj][m][1];
                        if (!RES_BF16) { u32x4 w; w.x = pkh2(v0[0], v0[1]); w.y = pkh2(v0[2], v0[3]); w.z = pkh2(v1[0], v1[1]); w.w = pkh2(v1[2], v1[3]); *(u32x4*)(xh + soff + bj * HALF) = bperm4(bpa, w); }
                        if (xb) { u32x4 wb; wb.x = cvt_pk_bf16(v0[0], v0[1]); wb.y = cvt_pk_bf16(v0[2], v0[3]); wb.z = cvt_pk_bf16(v1[0], v1[1]); wb.w = cvt_pk_bf16(v1[2], v1[3]); *(u32x4*)(xb + soff + bj * HALF) = bperm4(bpa, wb); }
                        s += ((v0[0] * v0[0] + v0[1] * v0[1]) + (v0[2] * v0[2] + v0[3] * v0[3])) + ((v1[0] * v1[0] + v1[1] * v1[1]) + (v1[2] * v1[2] + v1[3] * v1[3])); }
                    if (ssq) { s = sum_fq(s);
                    if (fq == 0) atomicAdd(ssq + row0 + ai * HALF + m * 16, (unsigned)(s * SS_SCALE + 0.5f)); } } }
#if !EPI_RES_PERM
#undef bperm4
#endif
            return;
        }
#pragma unroll
        for (int ai = 0; ai < 2; ++ai) {
            f32x4 b[4][2][2];
#pragma unroll
            for (int m = 0; m < 4; ++m) { const size_t off = (size_t)(row0 + ai * HALF + m * 16) * ldc + col0;
#pragma unroll
                for (int bj = 0; bj < 2; ++bj)
#pragma unroll
                    for (int n = 0; n < 2; ++n) {
                        if (base == nullptr) { if (n == 0) { const u32x4 w = *(const u32x4*)(xh + off + bj * HALF); b[m][bj][0] = h4_to_f32((u32x2){w.x, w.y}); b[m][bj][1] = h4_to_f32((u32x2){w.z, w.w}); } }
                        else b[m][bj][n] = *(const f32x4*)(base + (size_t)(row0 + ai * HALF + m * 16) * ldx + col0 + bj * HALF + n * 4); } }
#pragma unroll
            for (int m = 0; m < 4; ++m) { const size_t off = (size_t)(row0 + ai * HALF + m * 16) * ldc + col0; float s = 0.f;
#pragma unroll
                for (int bj = 0; bj < 2; ++bj) { const f32x4 v0 = b[m][bj][0] + acc[ai][bj][m][0], v1 = b[m][bj][1] + acc[ai][bj][m][1];
                    if (!RES_BF16) { u32x4 w; w.x = pkh2(v0[0], v0[1]); w.y = pkh2(v0[2], v0[3]); w.z = pkh2(v1[0], v1[1]); w.w = pkh2(v1[2], v1[3]); *(u32x4*)(xh + off + bj * HALF) = w; }
                    if (xb) { u32x4 wb; wb.x = cvt_pk_bf16(v0[0], v0[1]); wb.y = cvt_pk_bf16(v0[2], v0[3]); wb.z = cvt_pk_bf16(v1[0], v1[1]); wb.w = cvt_pk_bf16(v1[2], v1[3]); *(u32x4*)(xb + off + bj * HALF) = wb; }
                    s += ((v0[0] * v0[0] + v0[1] * v0[1]) + (v0[2] * v0[2] + v0[3] * v0[3])) + ((v1[0] * v1[0] + v1[1] * v1[1]) + (v1[2] * v1[2] + v1[3] * v1[3])); }
                if (ssq) { s = sum_fq(s);
                if (fq == 0) atomicAdd(ssq + row0 + ai * HALF + m * 16, (unsigned)(s * SS_SCALE + 0.5f)); } }
            asm volatile("" ::: "memory"); }
    }
};
typedef EpiResT<false> EpiRes; typedef EpiResT<true> EpiResK;

template <int CTRL> __device__ __forceinline__ float dpp_keep(float old, float src) {
    return __builtin_bit_cast(float, __builtin_amdgcn_update_dpp(__builtin_bit_cast(int, old), __builtin_bit_cast(int, src), CTRL, 0xf, 0xf, false)); }
template <int CTRL> __device__ __forceinline__ f32x4 dpp_keep4(f32x4 old, f32x4 src) { f32x4 r; r[0] = dpp_keep<CTRL>(old[0], src[0]); r[1] = dpp_keep<CTRL>(old[1], src[1]); r[2] = dpp_keep<CTRL>(old[2], src[2]); r[3] = dpp_keep<CTRL>(old[3], src[3]); return r; }
__device__ __forceinline__ float silu_f(float x) { return x * __builtin_amdgcn_rcpf(1.0f + __builtin_amdgcn_exp2f(-1.4426950408889634f * x)); }
struct EpiConv {
    static constexpr bool PERM = true, AFTER_DRAIN = false, APERM = true, F16 = false, KSCALE = false;
    bf16_t* G; float* halo; const float* cw; const float* cb; PG8_LAS unsigned char* xch; const unsigned* ss; int ldg;
    static __device__ __forceinline__ int xidx(int blk, int rr, int bj, int wc, int fq, int n) { return ((((blk * 2 + rr) * 2 + bj) * 4 + wc) * 4 + fq) * 2 + n; }
    static constexpr bool SS_PRE = true;
    __device__ __forceinline__ void ss_load(const Unit& u, int wr, int fr, unsigned (&raw)[8]) const {
#pragma unroll
        for (int ai = 0; ai < 2; ++ai) { const u32x4 w = *(const u32x4*)(ss + u.pm * BM + wr * 64 + 4 * fr + ai * HALF); raw[ai * 4 + 0] = w.x; raw[ai * 4 + 1] = w.y; raw[ai * 4 + 2] = w.z; raw[ai * 4 + 3] = w.w; }
    }
    __device__ __forceinline__ void operator()(const f32x4 (&acc)[2][2][4][2], const Unit& u, int wr, int wc, int fr, int fq, const unsigned (&raw)[8]) const {
        constexpr int FF = 5632, N2 = 11264;
        PG8_LAS f32x4* X = (PG8_LAS f32x4*)xch;
        const int rowb = u.pm * BM + wr * 64 + 4 * fr;
        float rs[2][4];
#pragma unroll
        for (int ai = 0; ai < 2; ++ai)
#pragma unroll
            for (int m = 0; m < 4; ++m) rs[ai][m] = __builtin_amdgcn_rsqf((float)raw[ai * 4 + m] * (1.0f / (SS_SCALE * 2048.0f)) + 1e-6f);
        if (fr == 15) {
#pragma unroll
            for (int ai = 0; ai < 2; ++ai)
#pragma unroll
                for (int rr = 0; rr < 2; ++rr)
#pragma unroll
                    for (int bj = 0; bj < 2; ++bj)
#pragma unroll
                        for (int n = 0; n < 2; ++n) X[xidx(ai * 2 + wr, rr, bj, wc, fq, n)] = acc[ai][bj][2 + rr][n] * rs[ai][2 + rr];
        }
        if (wr == 0 && fr == 0) {
#pragma unroll
            for (int rr = 0; rr < 2; ++rr)
#pragma unroll
                for (int bj = 0; bj < 2; ++bj)
#pragma unroll
                    for (int n = 0; n < 2; ++n) *(f32x4*)(halo + (size_t)(u.pm * 4 + rr) * N2 + u.pn * 256 + bj * 128 + wc * 32 + 8 * fq + 4 * n) = acc[0][bj][rr][n] * rs[0][rr];
        }
        if (wr == 1 && fr == 15) {
#pragma unroll
            for (int rr = 0; rr < 2; ++rr)
#pragma unroll
                for (int bj = 0; bj < 2; ++bj)
#pragma unroll
                    for (int n = 0; n < 2; ++n) *(f32x4*)(halo + (size_t)(u.pm * 4 + 2 + rr) * N2 + u.pn * 256 + bj * 128 + wc * 32 + 8 * fq + 4 * n) = acc[1][bj][2 + rr][n] * rs[1][2 + rr];
        }
        asm volatile("s_waitcnt lgkmcnt(0)" ::: "memory"); __builtin_amdgcn_s_barrier(); asm volatile("" ::: "memory");
        u32x2 hold[2][4];
#pragma unroll
        for (int n = 0; n < 2; ++n) {
            const int c0 = u.pn * 128 + wc * 32 + 8 * fq + 4 * n;
            const f32x4 wa0 = *(const f32x4*)(cw + c0), wa1 = *(const f32x4*)(cw + N2 + c0), wa2 = *(const f32x4*)(cw + 2 * N2 + c0), ba = *(const f32x4*)(cb + c0);
            const f32x4 wv0 = *(const f32x4*)(cw + FF + c0), wv1 = *(const f32x4*)(cw + N2 + FF + c0), wv2 = *(const f32x4*)(cw + 2 * N2 + FF + c0), bv = *(const f32x4*)(cb + FF + c0);
#pragma unroll
            for (int ai = 0; ai < 2; ++ai) {
                const int blk = ai * 2 + wr;
                f32x4 xa1 = (f32x4){0.f, 0.f, 0.f, 0.f}, xa2 = xa1, xv1 = xa1, xv2 = xa1;
                if (blk > 0) { xa2 = X[xidx(blk - 1, 0, 0, wc, fq, n)]; xa1 = X[xidx(blk - 1, 1, 0, wc, fq, n)]; xv2 = X[xidx(blk - 1, 0, 1, wc, fq, n)]; xv1 = X[xidx(blk - 1, 1, 1, wc, fq, n)]; }
                f32x4 ua[4], uv[4];
#pragma unroll
                for (int m = 0; m < 4; ++m) { ua[m] = acc[ai][0][m][n] * rs[ai][m]; uv[m] = acc[ai][1][m][n] * rs[ai][m]; }
                const f32x4 sa3 = dpp_keep4<0x111>(xa1, ua[3]), sa2 = dpp_keep4<0x111>(xa2, ua[2]);
                const f32x4 sv3 = dpp_keep4<0x111>(xv1, uv[3]), sv2 = dpp_keep4<0x111>(xv2, uv[2]);
#pragma unroll
                for (int m = 0; m < 4; ++m) {
                    const f32x4 pa1 = m == 0 ? sa3 : ua[m > 0 ? m - 1 : 0], pa2 = m == 0 ? sa2 : (m == 1 ? sa3 : ua[m > 1 ? m - 2 : 0]);
                    const f32x4 pv1 = m == 0 ? sv3 : uv[m > 0 ? m - 1 : 0], pv2 = m == 0 ? sv2 : (m == 1 ? sv3 : uv[m > 1 ? m - 2 : 0]);
                    const f32x4 ya = wa0 * pa2 + wa1 * pa1 + wa2 * ua[m] + ba;
                    const f32x4 yv = wv0 * pv2 + wv1 * pv1 + wv2 * uv[m] + bv;
                    const f32x4 tq = ya * -1.4426950408889634f; f32x4 eq; eq[0] = __builtin_amdgcn_exp2f(tq[0]); eq[1] = __builtin_amdgcn_exp2f(tq[1]); eq[2] = __builtin_amdgcn_exp2f(tq[2]); eq[3] = __builtin_amdgcn_exp2f(tq[3]);
                    const f32x4 dq = eq + 1.0f; f32x4 rq; rq[0] = __builtin_amdgcn_rcpf(dq[0]); rq[1] = __builtin_amdgcn_rcpf(dq[1]); rq[2] = __builtin_amdgcn_rcpf(dq[2]); rq[3] = __builtin_amdgcn_rcpf(dq[3]);
                    const f32x4 g = (ya * rq) * yv;
                    u32x2 w; w.x = cvt_pk_bf16(g[0], g[1]); w.y = cvt_pk_bf16(g[2], g[3]);
                    if (n == 0) hold[ai][m] = w;
                    else { u32x4 o; o.x = hold[ai][m].x; o.y = hold[ai][m].y; o.z = w.x; o.w = w.y;
                        __builtin_nontemporal_store(o, (u32x4*)(G + (size_t)(rowb + ai * HALF + m) * ldg + u.pn * 128 + wc * 32 + 8 * fq)); }
                }
            }
        }
    }
};
template <class Epi, class Sched, bool ALIGN_EPI = false, bool SP2 = false>
__device__ __forceinline__ void gemm_phase(PG8_LAS unsigned char* lds, const Gemm g, const Sched& S, const Epi& E, const int wave_in) {
    const int tid = opaque_tid(wave_in), wid = wave_in, lane = tid & 63, wr = wid >> 2, wc = wid & 3, fr = lane & 15, fq = lane >> 4;
    const int K = g.K, nt = K / BK;
    const int lda = g.lda ? g.lda : K;
    unsigned voffA[2], voffB[2];
#pragma unroll
    for (int i = 0; i < 2; ++i) { int R, C; stage_rc(tid * 16 + i * 8192, R, C); const int Rb = Epi::PERM ? ((R & ~31) + perm32(R & 31)) : R;
        const int Ra = Epi::APERM ? ((R & ~63) + 4 * (R & 15) + ((R >> 4) & 3)) : R;
        voffA[i] = (unsigned)(Ra * lda + C) * 2u; voffB[i] = (unsigned)(Rb * K + C) * 2u; }
    const size_t kstep = (size_t)(BK * 2);
    const size_t hstepA = (size_t)HALF * lda * 2, hstepB = (size_t)HALF * K * 2;
    const size_t tstepA = 2 * hstepA, tstepB = 2 * hstepB;
    const unsigned ldsw = (unsigned)wid * 1024u;
    const int aoff = lds_byte(wr * 64 + fr, fq * 8), boff = lds_byte(wc * 32 + fr, fq * 8);
#define PG8_SA(b, h) (((b) * 2 + (h)) * HTB)
#define PG8_SB(b, h) ((4 + (b) * 2 + (h)) * HTB)
#define PG8_STAGE(bufoff, gbase, voff) do { _Pragma("unroll") for (int _i = 0; _i < 2; ++_i) \
        __builtin_amdgcn_global_load_lds((const unsigned*)((const char*)(gbase) + (voff)[_i]), (PG8_LAS unsigned*)(lds + (bufoff) + ldsw + _i * 8192), 16, 0, 0); } while (0)
#define PG8_LDA(dst, b, h) do { _Pragma("unroll") for (int m = 0; m < 4; ++m) _Pragma("unroll") for (int k = 0; k < 2; ++k) dst[m][k] = *(const PG8_LAS bf16x8*)(lds + PG8_SA(b, h) + aoff + m * 2048 + k * 1024); } while (0)
#define PG8_LDB(dst, b, h) do { _Pragma("unroll") for (int n = 0; n < 2; ++n) _Pragma("unroll") for (int k = 0; k < 2; ++k) dst[n][k] = *(const PG8_LAS bf16x8*)(lds + PG8_SB(b, h) + boff + n * 2048 + k * 1024); } while (0)
#define PG8_MMA(ai, bj, At, Bt) do { __builtin_amdgcn_s_setprio(1); _Pragma("unroll") for (int m = 0; m < 4; ++m) _Pragma("unroll") for (int n = 0; n < 2; ++n) _Pragma("unroll") for (int k = 0; k < 2; ++k) \
        acc[ai][bj][m][n] = mfma16<Epi::F16>(Bt[n][k], At[m][k], acc[ai][bj][m][n]); __builtin_amdgcn_s_setprio(0); } while (0)
#define PG8_WAIT_V(n) asm volatile("s_waitcnt vmcnt(" #n ")" ::: "memory")
#define PG8_WAIT_L(n) asm volatile("s_waitcnt lgkmcnt(" #n ")" ::: "memory")
#define PG8_BAR __builtin_amdgcn_s_barrier()
#define PG8_SCHED __builtin_amdgcn_sched_barrier(0)
    Unit cur, nxt; int ui = 0;
    if (!S.next(0, cur)) return;
    f32x4 acc[2][2][4][2];
#pragma unroll
    for (int a = 0; a < 2; ++a)
#pragma unroll
        for (int b = 0; b < 2; ++b)
#pragma unroll
            for (int m = 0; m < 4; ++m)
#pragma unroll
                for (int n = 0; n < 2; ++n) acc[a][b][m][n] = (f32x4){0.f, 0.f, 0.f, 0.f};
    bf16x8 At[4][2], B0[2][2], B1[2][2];
    const char* cA = (const char*)g.A + (size_t)cur.pm * tstepA; const char* cB = (const char*)g.Bt + (size_t)cur.pn * tstepB;
    unsigned ssraw[8] = {0u, 0u, 0u, 0u, 0u, 0u, 0u, 0u};
    if constexpr (Epi::KSCALE) E.unit_ratios(cur, tid);
    if constexpr (Epi::SS_PRE) E.ss_load(cur, wr, fr, ssraw);
    S.a_ready(cur);
    if constexpr (SP2) {
        PG8_STAGE(PG8_SB(0, 0), cB, voffB); PG8_STAGE(PG8_SB(0, 1), cB + hstepB, voffB); PG8_STAGE(PG8_SA(0, 0), cA, voffA); PG8_STAGE(PG8_SA(0, 1), cA + hstepA, voffA);
        if (wr == 1) PG8_BAR;
        PG8_WAIT_V(2); PG8_BAR;
        PG8_STAGE(PG8_SB(1, 0), cB + kstep, voffB); PG8_STAGE(PG8_SA(1, 0), cA + kstep, voffA); PG8_STAGE(PG8_SB(1, 1), cB + hstepB + kstep, voffB);
        PG8_WAIT_V(6); PG8_BAR;
    } else {
        PG8_STAGE(PG8_SB(0, 0), cB, voffB); PG8_STAGE(PG8_SA(0, 0), cA, voffA); PG8_STAGE(PG8_SB(0, 1), cB + hstepB, voffB); PG8_STAGE(PG8_SA(0, 1), cA + hstepA, voffA);
        if (wr == 1) PG8_BAR;
        PG8_WAIT_V(4); PG8_BAR;
        PG8_STAGE(PG8_SB(1, 0), cB + kstep, voffB); PG8_STAGE(PG8_SA(1, 0), cA + kstep, voffA); PG8_STAGE(PG8_SB(1, 1), cB + hstepB + kstep, voffB);
        PG8_WAIT_V(6); PG8_BAR;
    }
    for (;;) {
        const bool has_next = S.next(ui + 1, nxt);
        const char* nA = has_next ? (const char*)g.A + (size_t)nxt.pm * tstepA : cA; const char* nB = has_next ? (const char*)g.Bt + (size_t)nxt.pn * tstepB : cB;
        for (int t = 0; t < nt; t += 2) {
            const bool last = (t == nt - 2);
            const char* a1 = cA + (size_t)(t + 1) * kstep;
            const char* a2 = last ? nA : cA + (size_t)(t + 2) * kstep; const char* b2 = last ? nB : cB + (size_t)(t + 2) * kstep;
            const char* a3 = a2 + kstep; const char* b3 = b2 + kstep;
            if (last && has_next) S.a_ready(nxt);
            if constexpr (Epi::KSCALE) { if (t == 6 || t == 12 || t == 18 || t == 24) E.kscale(acc, t / 6 - 1, wr, fr); }
            if constexpr (SP2) {
            PG8_LDB(B0, 0, 0); PG8_LDB(B1, 0, 1); PG8_SCHED; PG8_LDA(At, 0, 0); PG8_STAGE(PG8_SA(1, 1), a1 + hstepA, voffA);
            PG8_WAIT_V(8); PG8_WAIT_L(0); PG8_BAR; PG8_MMA(0, 0, At, B0); PG8_MMA(0, 1, At, B1); PG8_BAR; PG8_SCHED;
            PG8_LDA(At, 0, 1); PG8_STAGE(PG8_SB(0, 0), b2, voffB); PG8_STAGE(PG8_SB(0, 1), b2 + hstepB, voffB); PG8_STAGE(PG8_SA(0, 0), a2, voffA);
            PG8_WAIT_V(8); PG8_WAIT_L(0); PG8_BAR; PG8_MMA(1, 0, At, B0); PG8_MMA(1, 1, At, B1); PG8_BAR; PG8_SCHED;
            PG8_LDB(B0, 1, 0); PG8_LDB(B1, 1, 1); PG8_SCHED; PG8_LDA(At, 1, 0); PG8_STAGE(PG8_SA(0, 1), a2 + hstepA, voffA);
            PG8_WAIT_V(8); PG8_WAIT_L(0); PG8_BAR; PG8_MMA(0, 0, At, B0); PG8_MMA(0, 1, At, B1); PG8_BAR; PG8_SCHED;
            PG8_LDA(At, 1, 1); PG8_STAGE(PG8_SB(1, 0), b3, voffB); PG8_STAGE(PG8_SB(1, 1), b3 + hstepB, voffB); PG8_STAGE(PG8_SA(1, 0), a3, voffA);
            PG8_WAIT_V(8); PG8_WAIT_L(0); PG8_BAR; PG8_MMA(1, 0, At, B0); PG8_MMA(1, 1, At, B1); PG8_BAR; PG8_SCHED;
            } else {
            PG8_LDB(B0, 0, 0); PG8_SCHED; PG8_LDA(At, 0, 0); PG8_STAGE(PG8_SA(1, 1), a1 + hstepA, voffA);
            PG8_WAIT_L(8); PG8_BAR; PG8_WAIT_L(0); PG8_MMA(0, 0, At, B0); PG8_BAR; PG8_SCHED;
            PG8_LDB(B1, 0, 1); PG8_STAGE(PG8_SB(0, 0), b2, voffB);
            PG8_BAR; PG8_WAIT_L(0); PG8_MMA(0, 1, At, B1); PG8_BAR;
            PG8_LDA(At, 0, 1); PG8_STAGE(PG8_SA(0, 0), a2, voffA);
            PG8_BAR; PG8_WAIT_L(0); PG8_MMA(1, 0, At, B0); PG8_BAR; PG8_SCHED;
            PG8_STAGE(PG8_SB(0, 1), b2 + hstepB, voffB);
            PG8_WAIT_V(6); PG8_BAR; PG8_MMA(1, 1, At, B1); PG8_BAR;
            PG8_LDB(B0, 1, 0); PG8_SCHED; PG8_LDA(At, 1, 0); PG8_STAGE(PG8_SA(0, 1), a2 + hstepA, voffA);
            PG8_WAIT_L(8); PG8_BAR; PG8_WAIT_L(0); PG8_MMA(0, 0, At, B0); PG8_BAR; PG8_SCHED;
            PG8_LDB(B1, 1, 1); PG8_STAGE(PG8_SB(1, 0), b3, voffB);
            PG8_BAR; PG8_WAIT_L(0); PG8_MMA(0, 1, At, B1); PG8_BAR;
            PG8_LDA(At, 1, 1); PG8_STAGE(PG8_SA(1, 0), a3, voffA);
            PG8_BAR; PG8_WAIT_L(0); PG8_MMA(1, 0, At, B0); PG8_BAR; PG8_SCHED;
            PG8_STAGE(PG8_SB(1, 1), b3 + hstepB, voffB);
            PG8_WAIT_V(6); PG8_BAR; PG8_MMA(1, 1, At, B1); PG8_BAR;
            }
        }
        if constexpr (ALIGN_EPI) { if (wr == 0) PG8_BAR; }
        if constexpr (!Epi::AFTER_DRAIN) { E(acc, cur, wr, wc, fr, fq, ssraw); S.done(cur); if constexpr (Epi::SS_PRE) { if (has_next) E.ss_load(nxt, wr, fr, ssraw); }
            if constexpr (Epi::KSCALE) { if (has_next) E.unit_ratios(nxt, tid); } }
        if (!has_next) break;
#pragma unroll
        for (int a = 0; a < 2; ++a)
#pragma unroll
            for (int b = 0; b < 2; ++b)
#pragma unroll
                for (int m = 0; m < 4; ++m)
#pragma unroll
                    for (int n = 0; n < 2; ++n) acc[a][b][m][n] = (f32x4){0.f, 0.f, 0.f, 0.f};
        cur = nxt; cA = nA; cB = nB; ++ui;
        if constexpr (ALIGN_EPI) { if (wr == 1) PG8_BAR; }
    }
    PG8_WAIT_V(0);
    if constexpr (!ALIGN_EPI) { if (wr == 0) PG8_BAR; }
    PG8_BAR;
    if constexpr (Epi::AFTER_DRAIN) { E.fused(acc, cur, wr, wc, fr, fq, lds, wid, lane); S.done(cur); }
#undef PG8_SA
#undef PG8_SB
#undef PG8_STAGE
#undef PG8_LDA
#undef PG8_LDB
#undef PG8_MMA
#undef PG8_WAIT_V
#undef PG8_WAIT_L
#undef PG8_BAR
#undef PG8_SCHED
}
}
namespace att {
typedef unsigned short bf16;
typedef short bf16x8 __attribute__((ext_vector_type(8)));
typedef short s16x4 __attribute__((ext_vector_type(4)));
typedef float f32x16 __attribute__((ext_vector_type(16)));
typedef float f32x4 __attribute__((ext_vector_type(4)));
typedef unsigned u32x4 __attribute__((ext_vector_type(4)));
#define LASP __attribute__((address_space(3)))
constexpr int D = 128;
constexpr float SCALE = 0.08838834764831845f, INV_SCALE = 11.313708498984761f;
constexpr float THR = 8.f;
constexpr int NW = 8, QBLK = 32, KVBLK = 64, QB = NW * QBLK;
constexpr int SHM_V = KVBLK * D * 2, SHM_K = KVBLK * D * 2;
constexpr int BIAS_OFF = 2 * SHM_V + 2 * SHM_K + NW * 64 * 4;
constexpr int LDS_BYTES = BIAS_OFF + 2 * 64 * 4;
constexpr int WBIG = 1 << 30;

#define KSWZ(row, colB) ((row) * 256 + ((colB) ^ (((row) & 7) << 4)))
#define SBAR() __builtin_amdgcn_sched_barrier(0)
__device__ __forceinline__ int v_st(int k, int c) { const int kk = (k & ~0xC) | ((k & 4) << 1) | ((k & 8) >> 1); return ((kk >> 3) * 4 + (c >> 5)) * 512 + ((kk & 7) * 32 + (c & 31)) * 2; }
__device__ __forceinline__ int v_rd_base(int lane) { return ((lane & 3) << 3) | (((lane >> 2) & 3) << 6) | (((lane >> 4) & 1) << 5) | (((lane >> 5) & 1) << 8); }
constexpr int v_rd_off(int d0, int ks, int half) { return d0 * 512 + ks * 4096 + half * 2048; }
__device__ __forceinline__ int crow(int r, int hi) { return (r & 3) + 8 * (r >> 2) + 4 * hi; }
__device__ __forceinline__ unsigned cvtpk(float lo, float hi) { unsigned r; asm volatile("v_cvt_pk_bf16_f32 %0, %1, %2" : "=v"(r) : "v"(lo), "v"(hi)); return r; }
__device__ __forceinline__ bf16x8 load8(const bf16* p) { return *reinterpret_cast<const bf16x8*>(p); }
__device__ __forceinline__ void mask_tile(f32x16& p0, f32x16& p1, int dq, unsigned W) {
    const float NEG = -__builtin_inff();
#pragma unroll
    for (int r = 0; r < 16; ++r) {
        const int c = (r & 3) + 8 * (r >> 2);
        if ((unsigned)(dq - c) >= W) p0[r] = NEG;
        if ((unsigned)(dq - c - 32) >= W) p1[r] = NEG;
    }
}
__device__ __forceinline__ void partialSM(f32x16& p0, f32x16& p1, float& m_reg, float& mn, float& alpha) {
    float pmax = p0[0]; for (int r = 1; r < 16; ++r) pmax = fmaxf(pmax, p0[r]); for (int r = 0; r < 16; ++r) pmax = fmaxf(pmax, p1[r]);
    { auto rr = __builtin_amdgcn_permlane32_swap(__float_as_uint(pmax), __float_as_uint(pmax), false, false);
      pmax = fmaxf(__uint_as_float(rr[0]), __uint_as_float(rr[1])); }
    constexpr float C2 = 1.4426950408889634f * SCALE;
    if (__builtin_expect(__all((pmax - m_reg) * SCALE <= THR), 1)) { mn = m_reg; alpha = 1.f; }
    else { mn = fmaxf(m_reg, pmax); alpha = __builtin_amdgcn_exp2f((m_reg - mn) * C2); m_reg = mn; }
    const float mnL = -mn * C2;
    for (int r = 0; r < 16; ++r) p0[r] = fmaf(p0[r], C2, mnL); for (int r = 0; r < 16; ++r) p1[r] = fmaf(p1[r], C2, mnL);
    for (int r = 0; r < 16; ++r) p0[r] = __builtin_amdgcn_exp2f(p0[r]);
}
__device__ __forceinline__ void finishSM(f32x16& p0, f32x16& p1, float alpha, float& l_reg, bf16x8& pa0, bf16x8& pa1, bf16x8& pa2, bf16x8& pa3) {
    for (int r = 0; r < 16; ++r) p1[r] = __builtin_amdgcn_exp2f(p1[r]);
    float ps = 0; for (int r = 0; r < 16; ++r) ps += p0[r]; for (int r = 0; r < 16; ++r) ps += p1[r];
    { auto rr = __builtin_amdgcn_permlane32_swap(__float_as_uint(ps), __float_as_uint(ps), false, false);
      ps = __uint_as_float(rr[0]) + __uint_as_float(rr[1]); }
    l_reg = l_reg * alpha + ps;
#define PK4(P, B_, OUT) do { unsigned a0 = cvtpk(P[B_+0], P[B_+1]), a1 = cvtpk(P[B_+2], P[B_+3]);                          \
        unsigned b0 = cvtpk(P[B_+4], P[B_+5]), b1 = cvtpk(P[B_+6], P[B_+7]);                                             \
        auto r0 = __builtin_amdgcn_permlane32_swap(a0, b0, false, false); auto r1 = __builtin_amdgcn_permlane32_swap(a1, b1, false, false); \
        u32x4 w = {r0[0], r1[0], r0[1], r1[1]}; OUT = *reinterpret_cast<bf16x8*>(&w); } while (0)
    PK4(p0, 0, pa0); PK4(p0, 8, pa1); PK4(p1, 0, pa2); PK4(p1, 8, pa3);
#undef PK4
}
template <int KB>
__device__ __forceinline__ void qkt(f32x16& p0, f32x16& p1, const char* K_lds, const char* B_lds, int r32, int hi, const bf16x8* qr) {
    p0 = *reinterpret_cast<const f32x16*>(B_lds + KB * 256 + hi * 64); p1 = *reinterpret_cast<const f32x16*>(B_lds + KB * 256 + 128 + hi * 64);
    const char* kb[4];
#pragma unroll
    for (int dd = 0; dd < 4; ++dd) kb[dd] = K_lds + KB * SHM_K + KSWZ(r32, (dd * 16 + hi * 8) * 2);
#pragma unroll
    for (int d0 = 0; d0 < 8; ++d0) { const char* a = kb[d0 & 3] + (d0 >> 2) * 128;
        bf16x8 b0 = *reinterpret_cast<const bf16x8*>(a);
        bf16x8 b1 = *reinterpret_cast<const bf16x8*>(a + 32 * 256);
        p0 = __builtin_amdgcn_mfma_f32_32x32x16_bf16(b0, qr[d0], p0, 0, 0, 0);
        p1 = __builtin_amdgcn_mfma_f32_32x32x16_bf16(b1, qr[d0], p1, 0, 0, 0); }
}
template <int VB>
__device__ __forceinline__ void pv_tile(f32x16* o, int vb0, bf16x8 pa0, bf16x8 pa1, bf16x8 pa2, bf16x8 pa3) {
#define TRRD(dst, off) asm volatile("ds_read_b64_tr_b16 %0, %1 offset:%2" : "=&v"(dst) : "v"(vb0), "i"(off) : "memory")
#define PV_D0(d0) do { s16x4 l0, l1, l2, l3, h0, h1, h2, h3; constexpr int b_ = VB * SHM_V + v_rd_off(d0, 0, 0);   \
        TRRD(l0, b_); TRRD(h0, b_ + 2048); TRRD(l1, b_ + 4096); TRRD(h1, b_ + 6144); TRRD(l2, b_ + 8192); TRRD(h2, b_ + 10240); TRRD(l3, b_ + 12288); TRRD(h3, b_ + 14336); \
        asm volatile("s_waitcnt lgkmcnt(0)" ::: "memory"); SBAR();   \
        o[d0] = __builtin_amdgcn_mfma_f32_32x32x16_bf16(pa0, (bf16x8){l0[0], l0[1], l0[2], l0[3], h0[0], h0[1], h0[2], h0[3]}, o[d0], 0, 0, 0);   \
        o[d0] = __builtin_amdgcn_mfma_f32_32x32x16_bf16(pa1, (bf16x8){l1[0], l1[1], l1[2], l1[3], h1[0], h1[1], h1[2], h1[3]}, o[d0], 0, 0, 0);   \
        o[d0] = __builtin_amdgcn_mfma_f32_32x32x16_bf16(pa2, (bf16x8){l2[0], l2[1], l2[2], l2[3], h2[0], h2[1], h2[2], h2[3]}, o[d0], 0, 0, 0);   \
        o[d0] = __builtin_amdgcn_mfma_f32_32x32x16_bf16(pa3, (bf16x8){l3[0], l3[1], l3[2], l3[3], h3[0], h3[1], h3[2], h3[3]}, o[d0], 0, 0, 0); } while (0)
    PV_D0(0); PV_D0(1); PV_D0(2); PV_D0(3);
#undef PV_D0
#undef TRRD
}
struct BlockRef { const bf16* Q; const bf16* K; const bf16* V; bf16* O; const float* cb; int qs, kvs, os, P0, skv, jlo; };
struct Seam { bf16x8 qr[8]; bf16x8 st_v0, st_v1, st_k0, st_k1; };
#define ROW(p, k0, rr, st) ((p) + (int)((k0) * (st)) + (int)((rr) * (st) + sc))
#define VMW() asm volatile("s_waitcnt vmcnt(0)" ::: "memory")
#define VMWN(n) asm volatile("s_waitcnt vmcnt(%0)" :: "i"(n) : "memory")
#define SLOAD_H(B_, k0, bf) do { S.st_v0 = load8(ROW((B_).V, k0, sr, (B_).kvs)); S.st_v1 = load8(ROW((B_).V, k0, 32 + sr, (B_).kvs));              \
                         S.st_k0 = load8(ROW((B_).K, k0, sr, (B_).kvs)); S.st_k1 = load8(ROW((B_).K, k0, 32 + sr, (B_).kvs));                \
                         if (wid == 0) __builtin_amdgcn_global_load_lds((const unsigned*)((B_).cb + (k0) + bias_key(lane)), (LASP unsigned*)(B_lds + (bf) * 256), 4, 0, 0); } while (0)
#define SWRITE_HK(bf, cref_) do { *(bf16x8*)(K_lds + (bf) * SHM_K + kws) = S.st_k0; *(bf16x8*)(K_lds + (bf) * SHM_K + kws + 32 * 256) = S.st_k1; } while (0)
#define SWRITE_HV(bf) do { *(bf16x8*)(V_lds + (bf) * SHM_V + vst0) = S.st_v0; *(bf16x8*)(V_lds + (bf) * SHM_V + vst1) = S.st_v1; } while (0)
#define SWRITE_H(bf, cref_) do { SWRITE_HV(bf); SWRITE_HK(bf, cref_); } while (0)
__device__ __forceinline__ int bias_key(int L) { const int p = L >> 5, hi = (L >> 4) & 1, r = L & 15; return 32 * p + (r & 3) + 8 * (r >> 2) + 4 * hi; }
__device__ __forceinline__ void attn_prime(const BlockRef& cur, char* lds, Seam& S, const int wave_in) {
    const int tid = opaque_tid(wave_in), wid = wave_in, lane = tid & 63, r32 = lane & 31, hi = lane >> 5;
    const int sr = tid >> 4, sc = (tid & 15) * 8, kws = KSWZ(sr, sc * 2); char* K_lds = lds + 2 * SHM_V; char* B_lds = lds + BIAS_OFF;
    for (int d0 = 0; d0 < 8; ++d0) S.qr[d0] = load8(cur.Q + (int)((wid * QBLK + r32) * cur.qs + hi * 8) + d0 * 16);
    SLOAD_H(cur, cur.jlo * KVBLK, 0); VMW(); SWRITE_HK(0, 0);
    __syncthreads();
}
__device__ __forceinline__ void attn_block(const BlockRef& cur, const BlockRef& nxt, char* lds, Seam& S, const int wave_in) {
    const int tid = opaque_tid(wave_in), wid = wave_in, lane = tid & 63, r32 = lane & 31, hi = lane >> 5;
    constexpr int W = WBIG;
    int j_hi = (cur.P0 + QB - 1) / KVBLK + 1; if (j_hi > cur.skv / KVBLK) j_hi = cur.skv / KVBLK;
    const int j_lo = cur.jlo; const int NT = j_hi - j_lo;
    const int qlo = cur.P0 + wid * QBLK, qm = qlo + r32 - 4 * hi;
    char* V_lds = lds; char* K_lds = lds + 2 * SHM_V; char* B_lds = lds + BIAS_OFF;
    float* ws = (float*)(lds + 2 * SHM_V + 2 * SHM_K) + wid * 64; float* li_l = ws, * al_l = ws + 32;
    float m_reg = -1e30f, l_reg = 0; f32x16 o[4] = {};
    const int sr = tid >> 4, sc = (tid & 15) * 8, vst0 = v_st(sr, sc), vst1 = v_st(32 + sr, sc), kws = KSWZ(sr, sc * 2);
    const int vb0 = (int)(uintptr_t)V_lds + v_rd_base(lane);
#define RESC(a) do { if (__any((a) < 1.f)) { if (hi == 0) al_l[r32] = (a); asm volatile("s_waitcnt lgkmcnt(0)" ::: "memory");              \
                     for (int d_ = 0; d_ < 4; ++d_) for (int r = 0; r < 16; ++r) o[d_][r] *= al_l[crow(r, hi)]; } } while (0)
#define KBASE(t) ((j_lo + (t)) * KVBLK)
#define MASKT(P0_, P1_, t) do { const int kb_ = KBASE(t); if (kb_ + KVBLK - 1 > qlo) mask_tile(P0_, P1_, qm - kb_, (unsigned)W); } while (0)
    constexpr int NQL = 8;
#define SEAM_K0() do { VMWN(NQL); SWRITE_HK(0, 0); SBAR(); } while (0)
    f32x16 pA0, pA1, pB0, pB1; float mnA, mnB, alA, alB; bf16x8 pa0, pa1, pa2, pa3;
    SWRITE_HV(0); SBAR();
    if (NT > 1) { SLOAD_H(cur, KBASE(1), 1); }
    SBAR(); qkt<0>(pA0, pA1, K_lds, B_lds, r32, hi, S.qr);
    MASKT(pA0, pA1, 0); partialSM(pA0, pA1, m_reg, mnA, alA);
    if (NT > 1) { VMW(); SWRITE_H(1, 0); }
    __syncthreads();
#define HALF_STEP(PX0, PX1, mnX, alX, PY0, PY1, alY, t, KB, VB, SB) do {                                                      \
        SBAR(); qkt<KB>(PX0, PX1, K_lds, B_lds, r32, hi, S.qr);                                                               \
        finishSM(PY0, PY1, alY, l_reg, pa0, pa1, pa2, pa3); SBAR();                                                           \
        if ((t) + 1 < NT) { SLOAD_H(cur, KBASE((t) + 1), SB); SBAR(); }                                                           \
        pv_tile<VB>(o, vb0, pa0, pa1, pa2, pa3); MASKT(PX0, PX1, (t)); partialSM(PX0, PX1, m_reg, mnX, alX);                  \
        __syncthreads();                                                                                                      \
        if ((t) + 1 < NT) { VMW(); SWRITE_H(SB, 0); }                                                                      \
        RESC(alX); __syncthreads(); } while (0)
    for (int t = 1; t + 1 < NT; t += 2) {
        HALF_STEP(pB0, pB1, mnB, alB, pA0, pA1, alA, t, 1, 0, 0);
        HALF_STEP(pA0, pA1, mnA, alA, pB0, pB1, alB, t + 1, 0, 1, 1);
    }
    const bool even = (NT & 1) == 0;
    if (even) { SBAR(); qkt<1>(pB0, pB1, K_lds, B_lds, r32, hi, S.qr); SBAR(); }
    SLOAD_H(nxt, nxt.jlo * KVBLK, 0); SBAR();
#pragma unroll
    for (int d0 = 0; d0 < 8; ++d0) S.qr[d0] = load8(nxt.Q + (int)((wid * QBLK + r32) * nxt.qs + hi * 8) + d0 * 16);
    SBAR();
    finishSM(pA0, pA1, alA, l_reg, pa0, pa1, pa2, pa3); SBAR();
    pv_tile<0>(o, vb0, pa0, pa1, pa2, pa3);
    if (even) { MASKT(pB0, pB1, NT - 1); partialSM(pB0, pB1, m_reg, mnB, alB); __syncthreads(); RESC(alB);
        finishSM(pB0, pB1, alB, l_reg, pa0, pa1, pa2, pa3); SBAR(); pv_tile<1>(o, vb0, pa0, pa1, pa2, pa3); }
    SBAR(); SEAM_K0();
    if (hi == 0) li_l[r32] = l_reg; asm volatile("s_waitcnt lgkmcnt(0)" ::: "memory");
    bf16* Ow = cur.O + (int)(wid * QBLK * cur.os); const int ooff = 4 * hi * cur.os + r32;
#pragma unroll
    for (int r = 0; r < 16; ++r) { const int orc = (r & 3) + 8 * (r >> 2);
        const float rl = __builtin_amdgcn_rcpf(li_l[orc + 4 * hi]);
#pragma unroll
        for (int d0 = 0; d0 < 4; ++d0) { const float v = o[d0][r] * rl;
            const float vn = __builtin_bit_cast(float, __builtin_amdgcn_update_dpp(0, __builtin_bit_cast(int, v), 0xB1, 0xf, 0xf, false));
            if ((r32 & 1) == 0) *(unsigned*)(Ow + (orc * cur.os + d0 * 32) + ooff) = cvtpk(v, vn); } }
    __syncthreads();
#undef RESC
#undef KBASE
#undef MASKT
#undef SEAM_K0
#undef HALF_STEP
}
#undef ROW
#undef VMW
#undef VMWN
#undef SLOAD_H
#undef SWRITE_HK
#undef SWRITE_HV
#undef SWRITE_H
#undef KSWZ
#undef SBAR
}
constexpr int NWAVES = 8, NTHREADS = 512;
constexpr int DM = 2048, BATCH = 8, SEQ = 4096, MTOK = BATCH * SEQ, NMEM = 256, MMEM = BATCH * NMEM;
constexpr int GLA_H = 4, GLA_DK = 256, GLA_DV = 384, GLA_QK = 1024, GLA_V = 1536, GLA_IN_SRC = 5648, GLA_IN = 5632;
constexpr int FOX_H = 12, FOX_W = 1536, FOX_KV_SRC = 3084, MEM_H = 4, MEM_W = 512;
constexpr int FFH = 5632, FF2 = 11264, FFP = FFH + 64;
constexpr int ZQ = 0, ZK = 1024, ZV = 2048, ZOG = 3584, ZMQ = 5120;
constexpr float EPS = 1e-6f;
constexpr size_t al256(size_t x) { return (x + 255) & ~(size_t)255; }
constexpr size_t WS_CTL = 0, CTL_BYTES = 1u << 20;
constexpr size_t WS_SS    = WS_CTL + CTL_BYTES;
constexpr size_t WS_WMEM  = WS_SS + (size_t)10 * MTOK * 4;
constexpr size_t WS_WGIN  = WS_WMEM  + (size_t)4 * 1024 * DM * 2;
constexpr size_t WS_WGLR  = WS_WGIN  + (size_t)2 * GLA_IN * DM * 2;
constexpr size_t WS_WGOUT = WS_WGLR  + (size_t)2 * 16 * DM * 2;
constexpr size_t WS_WFKV  = WS_WGOUT + (size_t)2 * DM * DM * 2;
constexpr size_t WS_WFL   = WS_WFKV  + (size_t)3072 * DM * 2;
constexpr size_t WS_WFIN  = WS_WFL   + (size_t)16 * DM * 2;
constexpr size_t WS_WFOUT = WS_WFIN  + (size_t)2 * DM * DM * 2;
constexpr size_t WS_WUP   = WS_WFOUT + (size_t)2 * DM * DM * 2;
constexpr size_t WS_WDOWN = WS_WUP   + (size_t)4 * FF2 * DM * 2;
constexpr size_t WS_MEMN  = WS_WDOWN + (size_t)4 * DM * FFH * 2;
constexpr size_t WS_MKV   = WS_MEMN  + (size_t)MMEM * DM * 2;
constexpr size_t WS_H     = WS_MKV   + (size_t)MMEM * 4096 * 2;
#ifndef XBPAD
#define XBPAD 0
#endif
constexpr int XBP = RES_BF16 ? DM + XBPAD : DM;
constexpr size_t WS_Z     = WS_H     + (size_t)MTOK * XBP * 2;
constexpr size_t WS_MIX   = WS_Z     + (size_t)MTOK * FFP * 2;
constexpr size_t WS_U     = WS_MIX   + (size_t)MTOK * DM * 2;
constexpr size_t WS_KET   = WS_U;
constexpr size_t WS_VT    = WS_KET   + (size_t)2048 * 256 * 64 * 2;
constexpr size_t WS_UEND_A = WS_VT   + (size_t)2048 * 384 * 64 * 2;
constexpr size_t WS_KF    = WS_U;
constexpr size_t WS_VF    = WS_KF    + (size_t)MTOK * FOX_W * 2;
constexpr size_t WS_UEND_B = WS_VF   + (size_t)MTOK * FOX_W * 2;
constexpr size_t WS_UEND  = WS_UEND_A > WS_UEND_B ? WS_UEND_A : WS_UEND_B;
constexpr size_t WS_EL    = WS_UEND;
constexpr size_t WS_GLR   = WS_EL    + (size_t)2048 * 256 * 4;
constexpr size_t WS_CF    = WS_GLR   + (size_t)MTOK * 16 * 4;
constexpr size_t WS_HALO  = WS_CF    + (size_t)96 * SEQ * 4;
constexpr size_t WS_XH    = WS_HALO  + (size_t)128 * 4 * FF2 * 4;
constexpr size_t WS_END   = WS_XH    + (size_t)MTOK * DM * 2;
constexpr size_t WS_SSH   = WS_END;
constexpr size_t WS_NQ    = WS_SSH   + (size_t)MTOK * 4 * 24 * 4;
constexpr int CW_BAR = 4096;
constexpr int RING_BYTES = 131072, MISC_OFF = RING_BYTES, XTRA_OFF = RING_BYTES + 1024, LDS_BYTES = 163840;

#define GAS __attribute__((address_space(1)))
#define LAS __attribute__((address_space(3)))
typedef unsigned short bf16;
typedef unsigned v4u __attribute__((ext_vector_type(4)));
typedef unsigned v2u __attribute__((ext_vector_type(2)));
typedef float f32x4 __attribute__((ext_vector_type(4)));
typedef short bf16x8 __attribute__((ext_vector_type(8)));
#define LDS_WAIT() asm volatile("s_waitcnt lgkmcnt(0)" ::: "memory")
#define VM_WAIT() asm volatile("s_waitcnt vmcnt(0)" ::: "memory")
__device__ __forceinline__ unsigned f2bf(float f) { unsigned u = __builtin_bit_cast(unsigned, f); return (u + 0x7fffu + ((u >> 16) & 1u)) >> 16; }
__device__ __forceinline__ unsigned pk2(float lo, float hi) { return f2bf(lo) | (f2bf(hi) << 16); }
__device__ __forceinline__ float bf2f(unsigned short b) { return __builtin_bit_cast(float, (unsigned)b << 16); }
__device__ __forceinline__ float bflo(unsigned w) { return __builtin_bit_cast(float, w << 16); }
__device__ __forceinline__ float bfhi(unsigned w) { return __builtin_bit_cast(float, w & 0xffff0000u); }
__device__ __forceinline__ float dpp_shr_add(float v, const int n) {
    int r; const int iv = __builtin_bit_cast(int, v);
    if (n == 1) r = __builtin_amdgcn_update_dpp(0, iv, 0x111, 0xf, 0xf, true); else if (n == 2) r = __builtin_amdgcn_update_dpp(0, iv, 0x112, 0xf, 0xf, true);
    else if (n == 4) r = __builtin_amdgcn_update_dpp(0, iv, 0x114, 0xf, 0xf, true); else r = __builtin_amdgcn_update_dpp(0, iv, 0x118, 0xf, 0xf, true);
    return v + __builtin_bit_cast(float, r);
}
__device__ __forceinline__ float dpp_shr_max(float v, const int n) {
    int r; const int iv = __builtin_bit_cast(int, v);
    if (n == 1) r = __builtin_amdgcn_update_dpp(0, iv, 0x111, 0xf, 0xf, true); else if (n == 2) r = __builtin_amdgcn_update_dpp(0, iv, 0x112, 0xf, 0xf, true);
    else if (n == 4) r = __builtin_amdgcn_update_dpp(0, iv, 0x114, 0xf, 0xf, true); else r = __builtin_amdgcn_update_dpp(0, iv, 0x118, 0xf, 0xf, true);
    return fmaxf(v, __builtin_bit_cast(float, r));
}
__device__ __forceinline__ float wave_max(float v) {
    v = dpp_shr_max(v, 1); v = dpp_shr_max(v, 2); v = dpp_shr_max(v, 4); v = dpp_shr_max(v, 8);
    v = fmaxf(v, __builtin_bit_cast(float, __builtin_amdgcn_update_dpp(0, __builtin_bit_cast(int, v), 0x142, 0xa, 0xf, false)));
    v = fmaxf(v, __builtin_bit_cast(float, __builtin_amdgcn_update_dpp(0, __builtin_bit_cast(int, v), 0x143, 0xc, 0xf, false)));
    return __builtin_bit_cast(float, __builtin_amdgcn_readlane(__builtin_bit_cast(int, v), 63));
}
__device__ __forceinline__ float wave_sum(float v) {
    v = dpp_shr_add(v, 1); v = dpp_shr_add(v, 2); v = dpp_shr_add(v, 4); v = dpp_shr_add(v, 8);
    v += __builtin_bit_cast(float, __builtin_amdgcn_update_dpp(0, __builtin_bit_cast(int, v), 0x142, 0xa, 0xf, false));
    v += __builtin_bit_cast(float, __builtin_amdgcn_update_dpp(0, __builtin_bit_cast(int, v), 0x143, 0xc, 0xf, false));
    return __builtin_bit_cast(float, __builtin_amdgcn_readlane(__builtin_bit_cast(int, v), 63));
}
#define XB_TMO      128
#define XB_XCNT(j)  (256  + 64 * (j))
#define XB_XSUB(j)  (1280 + 64 * (j))
#define XB_XGEN(j)  (2304 + 64 * (j))
#define XB_TOP      3328
#define XB_TOPGEN   3392
#define XCD_BAR_WORDS 3456
#define XB_SPIN_CAP (1u << 18)

__device__ __forceinline__ unsigned xb_ld(unsigned* p)              { return __hip_atomic_load(p, __ATOMIC_RELAXED, __HIP_MEMORY_SCOPE_AGENT); }
__device__ __forceinline__ unsigned xb_add(unsigned* p, unsigned v) { return __hip_atomic_fetch_add(p, v, __ATOMIC_RELAXED, __HIP_MEMORY_SCOPE_AGENT); }
__device__ __forceinline__ unsigned xb_xcc_id() { return (unsigned)__builtin_amdgcn_s_getreg((3 << 11) | 20) & 0xFu; }
#define XB_SPIN(cond, bar) do { unsigned _sp = 0; while (cond) { __builtin_amdgcn_s_sleep(1); \
    if ((++_sp & 255u) == 0u) { if (xb_ld(&(bar)[XB_TMO])) break; if (_sp > XB_SPIN_CAP) { atomicAdd(&(bar)[XB_TMO], 1u); break; } } } } while (0)

struct XcdBarrier {
    unsigned* bar; unsigned x;
    volatile LAS unsigned* st;
};

__device__ __forceinline__ XcdBarrier xcd_barrier_post(unsigned* bar, volatile LAS unsigned* st, const int wave_in) {
    XcdBarrier b; b.bar = bar; b.x = xb_xcc_id(); b.st = st;
    if (opaque_tid(wave_in) == 0) (void)xb_add(&bar[XB_XCNT(b.x)], 1u);
    return b;
}
__device__ __forceinline__ void xcd_barrier_complete(unsigned* bar, unsigned x, unsigned& nloc, unsigned& nx) {
    const unsigned G = gridDim.x * gridDim.y * gridDim.z;
    unsigned sum, cnt, mine, sp = 0u;
    for (;;) {
        sum = 0u; cnt = 0u; mine = 0u;
#pragma unroll
        for (unsigned j = 0; j < 16; ++j) { const unsigned c = xb_ld(&bar[XB_XCNT(j)]); sum += c; cnt += (c > 0u) ? 1u : 0u; mine = (j == x) ? c : mine; }
        if (sum == G) break;
        __builtin_amdgcn_s_sleep(1);
        if ((++sp & 255u) == 0u) { if (xb_ld(&bar[XB_TMO])) break; if (sp > XB_SPIN_CAP) { atomicAdd(&bar[XB_TMO], 1u); break; } }
    }
    nloc = mine > 0u ? mine : 1u; nx = cnt > 0u ? cnt : 1u;
}

__device__ __forceinline__ void xcd_barrier(const XcdBarrier& b, const int wave_in) {
    asm volatile("s_waitcnt vmcnt(0)" ::: "memory");
    __syncthreads();
    if (opaque_tid(wave_in) == 0) {
        unsigned* bar = b.bar;
        __builtin_amdgcn_s_waitcnt(0);
        unsigned nloc = b.st[0], nx = b.st[1];
        if (nloc == 0u) { xcd_barrier_complete(bar, b.x, nloc, nx); b.st[0] = nloc; b.st[1] = nx; }
        const unsigned old = xb_add(&bar[XB_XSUB(b.x)], 1u);
        const unsigned gen = old / nloc;
        if (old + 1u == (gen + 1u) * nloc) {
            __builtin_amdgcn_fence(__ATOMIC_RELEASE, "agent");
            asm volatile("s_waitcnt vmcnt(0)" ::: "memory");
            const unsigned og = xb_add(&bar[XB_TOP], 1u);
            const unsigned tg = og / nx;
            if (og + 1u == (tg + 1u) * nx) xb_add(&bar[XB_TOPGEN], 1u);
            else XB_SPIN(xb_ld(&bar[XB_TOPGEN]) == tg, bar);
            __builtin_amdgcn_fence(__ATOMIC_ACQUIRE, "agent");
            xb_add(&bar[XB_XGEN(b.x)], 1u);
            asm volatile("s_waitcnt vmcnt(0)" ::: "memory");
        } else {
            XB_SPIN(xb_ld(&bar[XB_XGEN(b.x)]) == gen, bar);
            __builtin_amdgcn_fence(__ATOMIC_ACQUIRE, "agent");
            asm volatile("s_waitcnt vmcnt(0)" ::: "memory");
        }
    }
    __syncthreads();
}
struct Ctx {
    LAS unsigned char* lds;
    int tid, lane, wave, vcu, bx, G;
    const float* in[21]; float* out; unsigned char* ws;
};
template <class T> __device__ __forceinline__ T* wsp(const Ctx& C, size_t off) { return (T*)(C.ws + off); }

struct XpItem { const float* src; const float* gain; bf16* dst; int Nsrc, K; };
__device__ __forceinline__ void xp_load(const XpItem& X, f32x4 (&v)[8], float (&gk)[8]) {
#pragma unroll
    for (int i = 0; i < 8; ++i) { v[i] = *(const GAS f32x4*)(X.src + (size_t)(8 * i) * X.Nsrc); gk[i] = X.gain ? X.gain[8 * i] : 1.0f; }
}
__device__ __forceinline__ void xp_finish(const XpItem& X, const f32x4 (&v)[8], const float (&gk)[8], LAS float* scr, int lane) {
#pragma unroll
    for (int i = 0; i < 8; ++i) { const int kk = 8 * i + (lane >> 3); LAS float* d = scr + kk * 33 + (lane & 7) * 4; const f32x4 y = v[i] * gk[i]; d[0] = y.x; d[1] = y.y; d[2] = y.z; d[3] = y.w; }
    LDS_WAIT(); asm volatile("" ::: "memory");
    const int c = lane & 7;
#pragma unroll
    for (int j = 0; j < 4; ++j) { const int n = (lane >> 3) + 8 * j; const LAS float* s = scr + (8 * c) * 33 + n;
        v4u o; o.x = pk2(s[0 * 33], s[1 * 33]); o.y = pk2(s[2 * 33], s[3 * 33]); o.z = pk2(s[4 * 33], s[5 * 33]); o.w = pk2(s[6 * 33], s[7 * 33]);
        *(GAS v4u*)(X.dst + (size_t)(8 * j) * X.K) = o; }
    LDS_WAIT(); asm volatile("" ::: "memory");
}
__device__ __forceinline__ int colmap(int type, int g) {
    if (type == 1) return g < 112 ? 32 * g : 32 * g + 16;
    if (type == 2) { const int pn = g >> 3, gg = g & 7; return gg < 4 ? 128 * pn + 32 * gg : FFH + 128 * pn + 32 * (gg - 4); }
    return 32 * g;
}
__device__ __forceinline__ bool xpose_family(int& r, XpItem& X, int lane, const float* W, int K, int Nsrc, int Ndst, int l0, int nl, int type, bf16* WT, const float* gain = nullptr, int gstride = 0, int gmax = 1 << 30) {
    const int per = (K / 64) * (Ndst / 32), tot = per * nl;
    if (r >= tot) { r -= tot; return false; }
    const int l = l0 + r / per, q = r - (l - l0) * per, g = q / (K / 64), kb = q - g * (K / 64), k0 = 64 * kb;
    X.src = W + (size_t)l * K * Nsrc + (size_t)(k0 + (lane >> 3)) * Nsrc + colmap(type, g) + (lane & 7) * 4; X.Nsrc = Nsrc; X.K = K;
    X.gain = (gain && k0 < gmax) ? gain + (size_t)l * gstride + k0 + (lane >> 3) : nullptr;
    X.dst = WT + (size_t)l * Ndst * K + (size_t)(32 * g + (lane >> 3)) * K + k0 + 8 * (lane & 7);
    return true;
}
__device__ __forceinline__ void xp_resolve(const Ctx& C, int list, int it, XpItem& X) {
    int r = it; const int lane = C.lane;
    if (list == 0) {
        if (xpose_family(r, X, lane, C.in[7], DM, GLA_IN_SRC, GLA_IN, 0, 2, 1, wsp<bf16>(C, WS_WGIN), C.in[2], DM)) return;
        if (xpose_family(r, X, lane, C.in[6], DM, 1024, 1024, 0, 4, 0, wsp<bf16>(C, WS_WMEM))) return;
        if (xpose_family(r, X, lane, C.in[11], DM, DM, DM, 0, 2, 0, wsp<bf16>(C, WS_WGOUT), C.in[10], GLA_V, GLA_V)) return;
        if (xpose_family(r, X, lane, C.in[17], DM, FF2, FF2, 0, 2, 2, wsp<bf16>(C, WS_WUP), C.in[3], DM)) return;
        xpose_family(r, X, lane, C.in[20], FFH, DM, DM, 0, 2, 0, wsp<bf16>(C, WS_WDOWN));
    } else {
        if (xpose_family(r, X, lane, C.in[13], DM, FOX_KV_SRC, 3072, 0, 1, 0, wsp<bf16>(C, WS_WFKV), C.in[12], 0)) return;
        if (xpose_family(r, X, lane, C.in[15], DM, DM, DM, 0, 2, 0, wsp<bf16>(C, WS_WFIN), C.in[2] + 2 * DM, DM)) return;
        if (xpose_family(r, X, lane, C.in[16], DM, DM, DM, 0, 2, 0, wsp<bf16>(C, WS_WFOUT))) return;
        if (xpose_family(r, X, lane, C.in[17], DM, FF2, FF2, 2, 2, 2, wsp<bf16>(C, WS_WUP), C.in[3], DM)) return;
        xpose_family(r, X, lane, C.in[20], FFH, DM, DM, 2, 2, 0, wsp<bf16>(C, WS_WDOWN));
    }
}
constexpr int NX_EARLY = 4 * 32 * 32 + 2 * 32 * 176 + 2 * 32 * 64 + 2 * 32 * 352 + 2 * 88 * 64;
constexpr int NX_LATE = 32 * 96 + 2 * 32 * 64 + 2 * 32 * 64 + 2 * 32 * 352 + 2 * 88 * 64;
__device__ __forceinline__ void xp_run(const Ctx& C, int list, int first, int end, int stride) {
    LAS float* scr = (LAS float*)(C.lds + C.wave * 16384);
    XpItem Xa, Xb; f32x4 va[8], vb[8]; float ga[8], gb[8];
    int it = first; if (it < end) { xp_resolve(C, list, it, Xa); xp_load(Xa, va, ga); }
    while (it < end) {
        const int it1 = it + stride, it2 = it1 + stride;
        if (it1 < end) { xp_resolve(C, list, it1, Xb); xp_load(Xb, vb, gb); }
        xp_finish(Xa, va, ga, scr, C.lane);
        if (it2 < end) { xp_resolve(C, list, it2, Xa); xp_load(Xa, va, ga); }
        if (it1 < end) xp_finish(Xb, vb, gb, scr, C.lane);
        it = it2;
    }
}
__device__ __forceinline__ void rms_row(const Ctx& C, const float* xrow, const float* g1, bf16* o1, const float* g2, bf16* o2, float* of32) {
    const GAS f32x4* xr = (const GAS f32x4*)xrow + C.lane;
    f32x4 v[8]; float s = 0.f;
#pragma unroll
    for (int j = 0; j < 8; ++j) { v[j] = xr[64 * j]; s += (v[j].x * v[j].x + v[j].y * v[j].y) + (v[j].z * v[j].z + v[j].w * v[j].w); }
    const float rstd = 1.0f / sqrtf(wave_sum(s) * (1.f / DM) + EPS);
#pragma unroll
    for (int j = 0; j < 8; ++j) { const f32x4 g = ((const GAS f32x4*)g1)[C.lane + 64 * j]; const f32x4 y = v[j] * rstd * g;
        if (of32) ((GAS f32x4*)of32)[C.lane + 64 * j] = y;
        else ((GAS v2u*)o1)[C.lane + 64 * j] = (v2u){pk2(y.x, y.y), pk2(y.z, y.w)}; }
    if (o2) {
#pragma unroll
        for (int j = 0; j < 8; ++j) { const f32x4 g = ((const GAS f32x4*)g2)[C.lane + 64 * j]; const f32x4 y = v[j] * rstd * g;
            ((GAS v2u*)o2)[C.lane + 64 * j] = (v2u){pk2(y.x, y.y), pk2(y.z, y.w)}; }
    }
}
__device__ __forceinline__ void rms_phase(const Ctx& C, const float* x, int rows, const float* g1, bf16* o1, const float* g2, bf16* o2, float* of32) {
    const int gw = C.vcu * NWAVES + C.wave, NGW = C.G * NWAVES;
    for (int m = gw; m < rows; m += NGW) rms_row(C, x + (size_t)m * DM, g1, o1 ? o1 + (size_t)m * DM : nullptr, g2, o2 ? o2 + (size_t)m * DM : nullptr, of32 ? of32 + (size_t)m * DM : nullptr);
}
__device__ __forceinline__ void convert_late(const Ctx& C, int half, int widx, int nw) { xp_run(C, 1, half * (NX_LATE / 2) + widx, (half + 1) * (NX_LATE / 2), nw); }
__device__ __forceinline__ void rms_bf16_phase(const Ctx& C, const bf16* xb, const float* g, float* out) {
    const int gw = C.vcu * NWAVES + C.wave, NGW = C.G * NWAVES;
    for (int m = gw; m < MTOK; m += NGW) { f32x4 v[8]; float s = 0.f;
#pragma unroll
        for (int j = 0; j < 8; ++j) { const v2u w = ((const GAS v2u*)(xb + (size_t)m * XBP))[C.lane + 64 * j]; v[j] = RES_BF16 ? (f32x4){bflo(w.x), bfhi(w.x), bflo(w.y), bfhi(w.y)} : (f32x4){pg8::h2lo(w.x), pg8::h2hi(w.x), pg8::h2lo(w.y), pg8::h2hi(w.y)}; s += (v[j].x * v[j].x + v[j].y * v[j].y) + (v[j].z * v[j].z + v[j].w * v[j].w); }
        const float rstd = 1.0f / sqrtf(wave_sum(s) * (1.f / DM) + EPS);
#pragma unroll
        for (int j = 0; j < 8; ++j) { const f32x4 gg = ((const GAS f32x4*)g)[C.lane + 64 * j]; ((GAS f32x4*)(out + (size_t)m * DM))[C.lane + 64 * j] = v[j] * rstd * gg; } }
}
__device__ __forceinline__ void p0_prologue(const Ctx& C) {
    const int gw = C.vcu * NWAVES + C.wave, NGW = C.G * NWAVES;
    xp_run(C, 0, gw, NX_EARLY, NGW);
    { const int gt = C.vcu * NTHREADS + C.tid, NT = C.G * NTHREADS;
      for (int i = gt; i < 3 * 16 * DM; i += NT) { const int l = i / (16 * DM), n = (i / DM) & 15, k = i % DM;
          if (l < 2) wsp<bf16>(C, WS_WGLR)[i] = (bf16)f2bf(C.in[7][((size_t)l * DM + k) * GLA_IN_SRC + 3584 + n] * C.in[2][l * DM + k]);
          else wsp<bf16>(C, WS_WFL)[i - 2 * 16 * DM] = (bf16)(n < 12 ? f2bf(C.in[13][(size_t)k * FOX_KV_SRC + 3072 + n] * C.in[12][k]) : 0u); } }
    rms_phase(C, C.in[1], MMEM, C.in[4], wsp<bf16>(C, WS_MEMN), nullptr, nullptr, nullptr);
    { unsigned* SS = wsp<unsigned>(C, WS_SS); bf16* XB = wsp<bf16>(C, WS_H);
      for (int m = gw; m < MTOK; m += NGW) { const GAS f32x4* xr = (const GAS f32x4*)(C.in[0] + (size_t)m * DM) + C.lane; f32x4 v[8]; float s = 0.f;
#pragma unroll
          for (int j = 0; j < 8; ++j) { v[j] = xr[64 * j]; s += (v[j].x * v[j].x + v[j].y * v[j].y) + (v[j].z * v[j].z + v[j].w * v[j].w); }
          const float rstd = 1.0f / sqrtf(wave_sum(s) * (1.f / DM) + EPS);
#pragma unroll
          for (int j = 0; j < 8; ++j) { const f32x4 y = v[j] * rstd; ((GAS v2u*)(XB + (size_t)m * XBP))[C.lane + 64 * j] = (v2u){pk2(y.x, y.y), pk2(y.z, y.w)}; }
          if (C.lane == 0) SS[m] = (unsigned)(2048.0f * (1.0f - 1e-6f) * pg8::SS_SCALE); }
    }
}
__device__ __forceinline__ void skinny16_phase(const Ctx& C, const bf16* A, const bf16* Wt, float* out, const unsigned* ss, int gw = -1, int NGW = 0) {
    if (gw < 0) { gw = C.vcu * NWAVES + C.wave; NGW = C.G * NWAVES; }
    const int fr = C.lane & 15, fq = C.lane >> 4;
    for (int t = gw; t < MTOK / 16; t += NGW) {
        const bf16* ap = A + (size_t)(t * 16 + fr) * XBP + fq * 8; const bf16* bp = Wt + (size_t)fr * DM + fq * 8;
        f32x4 acc[4] = {};
#pragma unroll 4
        for (int ks = 0; ks < 64; ks += 4) {
#pragma unroll
            for (int u = 0; u < 4; ++u) { const bf16x8 a = *(const bf16x8*)(ap + (ks + u) * 32), b = *(const bf16x8*)(bp + (ks + u) * 32);
                acc[u] = pg8::mfma16<false>(a, b, acc[u]); }
        }
        const f32x4 r = (acc[0] + acc[1]) + (acc[2] + acc[3]);
#pragma unroll
        for (int j = 0; j < 4; ++j) out[(size_t)(t * 16 + 4 * fq + j) * 16 + fr] = r[j] * __builtin_amdgcn_rsqf((float)ss[t * 16 + 4 * fq + j] * (1.0f / (pg8::SS_SCALE * DM)) + EPS);
    }
}

__device__ __forceinline__ void gla_prep_phase(const Ctx& C, int layer) {
    bf16* Z = wsp<bf16>(C, WS_Z); const float* GLR = wsp<float>(C, WS_GLR);
    const float* Wg = C.in[8] + (size_t)layer * 16 * GLA_QK; const float* bg = C.in[9] + (size_t)layer * GLA_QK;
    LAS float* GL = (LAS float*)C.lds; LAS float* WG = (LAS float*)(C.lds + 4096); LAS float* TOT = (LAS float*)(C.lds + 20480);
    const int tid = C.tid, cg = tid & 31, rg = tid >> 5;
    int hprev = -1; f32x4 glnext = (f32x4){0.f, 0.f, 0.f, 0.f};
    if (C.vcu < 2048 && tid < 256) { const int ch0 = (C.vcu >> 2) & 63, b0_ = C.vcu >> 8; glnext = ((const GAS f32x4*)(GLR + ((size_t)b0_ * SEQ + ch0 * 64) * 16))[tid]; }
    f32x4 b0 = (f32x4){0.f, 0.f, 0.f, 0.f}, b1 = b0;
    for (int it0 = C.vcu; it0 < 2048; it0 += C.G) {
        const int h = it0 & 3, ch = (it0 >> 2) & 63, b = it0 >> 8, bh = b * 4 + h, item = bh * 64 + ch; const size_t r0 = (size_t)b * SEQ + ch * 64;
        if (tid < 256) ((LAS f32x4*)GL)[tid] = glnext;
        if (h != hprev) {
#pragma unroll
            for (int i = 0; i < 2; ++i) { const int q = tid + NTHREADS * i, j = q >> 6, c4 = q & 63; ((LAS f32x4*)WG)[q] = *(const GAS f32x4*)(Wg + j * GLA_QK + h * GLA_DK + c4 * 4); }
            b0 = *(const GAS f32x4*)(bg + h * GLA_DK + 8 * cg); b1 = *(const GAS f32x4*)(bg + h * GLA_DK + 8 * cg + 4); hprev = h; }
        { const int itn = it0 + C.G; if (itn < 2048 && tid < 256) { const int chn = (itn >> 2) & 63, bn = itn >> 8; glnext = ((const GAS f32x4*)(GLR + ((size_t)bn * SEQ + chn * 64) * 16))[tid]; } }
        v4u qv[4], kv[4];
        bf16* qp = Z + (r0 + 4 * rg) * GLA_IN + ZQ + h * GLA_DK + 8 * cg; bf16* kp = qp + ZK;
#pragma unroll
        for (int r = 0; r < 4; ++r) { qv[r] = *(const GAS v4u*)(qp + (size_t)r * GLA_IN); kv[r] = *(const GAS v4u*)(kp + (size_t)r * GLA_IN); }
        __syncthreads();
        float x[4][8];
#pragma unroll
        for (int r = 0; r < 4; ++r) { x[r][0] = b0[0]; x[r][1] = b0[1]; x[r][2] = b0[2]; x[r][3] = b0[3]; x[r][4] = b1[0]; x[r][5] = b1[1]; x[r][6] = b1[2]; x[r][7] = b1[3]; }
#pragma unroll
        for (int j4 = 0; j4 < 4; ++j4) {
            f32x4 g[4];
#pragma unroll
            for (int r = 0; r < 4; ++r) g[r] = ((const LAS f32x4*)(GL + (4 * rg + r) * 16))[j4];
#pragma unroll
            for (int jj = 0; jj < 4; ++jj) { const int j = 4 * j4 + jj; const f32x4 w0 = ((const LAS f32x4*)(WG + j * 256 + 8 * cg))[0], w1 = ((const LAS f32x4*)(WG + j * 256 + 8 * cg))[1];
#pragma unroll
                for (int r = 0; r < 4; ++r) { const float gv = g[r][jj];
                    x[r][0] += gv * w0[0]; x[r][1] += gv * w0[1]; x[r][2] += gv * w0[2]; x[r][3] += gv * w0[3]; x[r][4] += gv * w1[0]; x[r][5] += gv * w1[1]; x[r][6] += gv * w1[2]; x[r][7] += gv * w1[3]; } }
        }
#pragma unroll
        for (int c = 0; c < 8; ++c) { float cum = 0.f;
#pragma unroll
            for (int r = 0; r < 4; ++r) { const float v = x[r][c]; const float ls = fminf(v, 0.f) - 0.6931471805599453f * __builtin_amdgcn_logf(1.0f + __builtin_amdgcn_exp2f(-1.4426950408889634f * fabsf(v)));
                cum += ls * 0.0625f; x[r][c] = cum; } }
        ((LAS f32x4*)(TOT + rg * 256 + 8 * cg))[0] = (f32x4){x[3][0], x[3][1], x[3][2], x[3][3]}; ((LAS f32x4*)(TOT + rg * 256 + 8 * cg))[1] = (f32x4){x[3][4], x[3][5], x[3][6], x[3][7]};
        __syncthreads();
        { f32x4 o0 = (f32x4){0.f, 0.f, 0.f, 0.f}, o1 = o0;
#pragma unroll
          for (int q = 0; q < 15; ++q) { const float msk = q < rg ? 1.0f : 0.0f; o0 += ((const LAS f32x4*)(TOT + q * 256 + 8 * cg))[0] * msk; o1 += ((const LAS f32x4*)(TOT + q * 256 + 8 * cg))[1] * msk; }
#pragma unroll
          for (int r = 0; r < 4; ++r) { x[r][0] += o0[0]; x[r][1] += o0[1]; x[r][2] += o0[2]; x[r][3] += o0[3]; x[r][4] += o1[0]; x[r][5] += o1[1]; x[r][6] += o1[2]; x[r][7] += o1[3]; } }
        if (rg == 15) { float* el = wsp<float>(C, WS_EL) + (size_t)item * 256 + 8 * cg;
            f32x4 e0, e1;
#pragma unroll
            for (int c = 0; c < 4; ++c) { e0[c] = __builtin_amdgcn_exp2f(1.4426950408889634f * x[3][c]); e1[c] = __builtin_amdgcn_exp2f(1.4426950408889634f * x[3][4 + c]); }
            *(GAS f32x4*)el = e0; *(GAS f32x4*)(el + 4) = e1; }
        const int pb = ((8 * cg) & ~31) + 16 * (cg & 1) + 4 * ((cg >> 1) & 1);
        unsigned ket[8][2];
#pragma unroll
        for (int r = 0; r < 4; ++r) { unsigned qo[4], ko[4];
#pragma unroll
            for (int c2 = 0; c2 < 4; ++c2) {
                const float e0 = __builtin_amdgcn_exp2f(1.4426950408889634f * x[r][2 * c2]), e1 = __builtin_amdgcn_exp2f(1.4426950408889634f * x[r][2 * c2 + 1]);
                const float q0 = bflo(qv[r][c2]) * 0.0625f * e0, q1 = bfhi(qv[r][c2]) * 0.0625f * e1;
                const unsigned k0 = f2bf(bflo(kv[r][c2]) * __builtin_amdgcn_rcpf(e0)), k1 = f2bf(bfhi(kv[r][c2]) * __builtin_amdgcn_rcpf(e1));
                qo[c2] = pk2(q0, q1); ko[c2] = k0 | (k1 << 16);
                if (r & 1) { ket[2 * c2][r >> 1] |= k0 << 16; ket[2 * c2 + 1][r >> 1] |= k1 << 16; } else { ket[2 * c2][r >> 1] = k0; ket[2 * c2 + 1][r >> 1] = k1; } }
            bf16* qr = Z + (r0 + 4 * rg + r) * GLA_IN + ZQ + h * GLA_DK; bf16* kr = qr + ZK;
            *(GAS v2u*)(qr + pb) = (v2u){qo[0], qo[1]}; *(GAS v2u*)(qr + pb + 8) = (v2u){qo[2], qo[3]};
            *(GAS v2u*)(kr + pb) = (v2u){ko[0], ko[1]}; *(GAS v2u*)(kr + pb + 8) = (v2u){ko[2], ko[3]}; }
        { bf16* ketp = wsp<bf16>(C, WS_KET) + (size_t)item * 256 * 64 + (size_t)(8 * cg) * 64 + 4 * rg;
#pragma unroll
          for (int c = 0; c < 8; ++c) *(GAS v2u*)(ketp + c * 64) = (v2u){ket[c][0], ket[c][1]}; }
        __syncthreads();
    }
}

__device__ __forceinline__ int sw512(int row, int ch) { return row * 512 + ((ch ^ (row & 15)) << 4); }
__device__ __forceinline__ int sw128(int row, int ch) { return row * 128 + ((ch ^ ((row >> 1) & 7)) << 4); }
__device__ __forceinline__ void gla_scan_phase(const Ctx& C) {
    constexpr int SQE = 0, SKE = 32768, SKET = 65536, SVT = 98304, SATT = 106496, SEL = 114688, SPART = XTRA_OFF;
    const bf16* Z = wsp<bf16>(C, WS_Z); const bf16* KETg = wsp<bf16>(C, WS_KET); const float* ELg = wsp<float>(C, WS_EL);
    bf16* Og = wsp<bf16>(C, WS_MIX);
    LAS unsigned char* L = C.lds;
    const int tid = C.tid, lane = C.lane, w = C.wave, dh = w >> 2, nt = w & 3, fr = lane & 15, fq = lane >> 4;
    if (C.vcu < 192) { const int it = C.vcu;
        const int bh = it / 6, slice = it - bh * 6, b = bh >> 2, h = bh & 3;
        v4u rq[4], rk[4], rt[4], rv, re;
#define SCAN_LOAD_A(c_) do { const size_t r0_ = (size_t)b * SEQ + (size_t)(c_) * 64;                                                                           \
        _Pragma("unroll") for (int j_ = 0; j_ < 4; ++j_) { const int i_ = tid + NTHREADS * j_;                                                                \
            rq[j_] = *(const GAS v4u*)(Z + (r0_ + (i_ >> 5)) * GLA_IN + ZQ + h * GLA_DK + (i_ & 31) * 8);                                                     \
            rk[j_] = *(const GAS v4u*)(Z + (r0_ + (i_ >> 5)) * GLA_IN + ZK + h * GLA_DK + (i_ & 31) * 8); } } while (0)
#define SCAN_LOAD_B(c_) do { const size_t ci_ = (size_t)bh * 64 + (c_);                                                                                       \
        _Pragma("unroll") for (int j_ = 0; j_ < 4; ++j_) { const int i_ = tid + NTHREADS * j_; rt[j_] = *(const GAS v4u*)(KETg + ci_ * 16384 + (size_t)i_ * 8); } \
        rv = *(const GAS v4u*)(Z + ((size_t)b * SEQ + (size_t)(c_) * 64 + (tid >> 3)) * GLA_IN + ZV + h * GLA_DV + slice * 64 + (tid & 7) * 8);     \
        if (tid < 64) re = *(const GAS v4u*)(ELg + ci_ * 256 + tid * 4); } while (0)
#define SCAN_WRITE() do {                                                                                                                                      \
        _Pragma("unroll") for (int j_ = 0; j_ < 4; ++j_) { const int i_ = tid + NTHREADS * j_;                                                                \
            *(LAS v4u*)(L + SQE + sw512(i_ >> 5, i_ & 31)) = rq[j_]; *(LAS v4u*)(L + SKE + sw512(i_ >> 5, i_ & 31)) = rk[j_];                                 \
            *(LAS v4u*)(L + SKET + sw128(i_ >> 3, i_ & 7)) = rt[j_]; }                                                                                         \
        _Pragma("unroll") for (int e_ = 0; e_ < 8; ++e_) {                \
            *(LAS unsigned short*)(L + SVT + sw128(8 * (tid & 7) + e_, tid >> 6) + ((tid >> 3) & 7) * 2) = (unsigned short)(rv[e_ >> 1] >> (16 * (e_ & 1))); }                    \
        if (tid < 64) *(LAS v4u*)(L + SEL + tid * 16) = re; } while (0)
        SCAN_LOAD_A(0); SCAN_LOAD_B(0);
        for (int i = tid; i < 512; i += NTHREADS) *(LAS v4u*)(L + SATT + i * 16) = (v4u){0u, 0u, 0u, 0u};
        VM_WAIT(); SCAN_WRITE();
        f32x4 S[8];
#pragma unroll
        for (int i = 0; i < 8; ++i) S[i] = (f32x4){0.f, 0.f, 0.f, 0.f};
        __syncthreads();
        float* SSHg = wsp<float>(C, WS_SSH);
        for (int c = 0; c < 64; ++c) {
            if (c + 1 < 64) { SCAN_LOAD_A(c + 1); SCAN_LOAD_B(c + 1); }
            unsigned short ogv[8];
            { const bf16* ogp = Z + ((size_t)b * SEQ + (size_t)c * 64 + 32 * dh + 4 * fq) * GLA_IN + ZOG + h * GLA_DV + slice * 64 + 16 * nt + fr;
#pragma unroll
              for (int i = 0; i < 2; ++i)
#pragma unroll
                  for (int j = 0; j < 4; ++j) ogv[i * 4 + j] = ogp[(size_t)(16 * i + j) * GLA_IN]; }
#pragma unroll
            for (int rep = 0; rep < 2; ++rep) {
                const int id = w + 8 * rep;
                if (id < 10) {
                    int mt = 0; if (id >= 1) mt = 1; if (id >= 3) mt = 2; if (id >= 6) mt = 3; const int nn = id - (mt * (mt + 1)) / 2;
                    f32x4 a = (f32x4){0.f, 0.f, 0.f, 0.f};
#pragma unroll
                    for (int ks = 0; ks < 8; ++ks) {
                        const bf16x8 af = *(const LAS bf16x8*)(L + SQE + sw512(16 * mt + fr, 4 * ks + fq)), bfm = *(const LAS bf16x8*)(L + SKE + sw512(16 * nn + fr, 4 * ks + fq));
                        a = __builtin_amdgcn_mfma_f32_16x16x32_bf16(af, bfm, a, 0, 0, 0); }
#pragma unroll
                    for (int j = 0; j < 4; ++j) { const int t = 16 * mt + 4 * fq + j, s = 16 * nn + fr; const float v = (s <= t) ? a[j] : 0.f;
                        *(LAS unsigned short*)(L + SATT + sw128(t, s >> 3) + (s & 7) * 2) = (unsigned short)f2bf(v); }
                }
            }
            f32x4 ao[4];
            { bf16x8 sf[4];
#pragma unroll
              for (int k2 = 0; k2 < 4; ++k2) { v4u p; p.x = pg8::cvt_pk_bf16(S[2 * k2][0], S[2 * k2][1]); p.y = pg8::cvt_pk_bf16(S[2 * k2][2], S[2 * k2][3]);
                  p.z = pg8::cvt_pk_bf16(S[2 * k2 + 1][0], S[2 * k2 + 1][1]); p.w = pg8::cvt_pk_bf16(S[2 * k2 + 1][2], S[2 * k2 + 1][3]); sf[k2] = __builtin_bit_cast(bf16x8, p); }
#pragma unroll
              for (int mt = 0; mt < 4; ++mt) { f32x4 a = (f32x4){0.f, 0.f, 0.f, 0.f};
#pragma unroll
                  for (int k2 = 0; k2 < 4; ++k2) { const bf16x8 af = *(const LAS bf16x8*)(L + SQE + sw512(16 * mt + fr, 4 * (4 * dh + k2) + fq));
                      a = __builtin_amdgcn_mfma_f32_16x16x32_bf16(af, sf[k2], a, 0, 0, 0); }
                  ao[mt] = a; } }
            { const f32x4 e0 = dh ? ao[0] : ao[2], e1 = dh ? ao[1] : ao[3];
              *(LAS f32x4*)(L + SPART + ((w * 2 + 0) * 64 + lane) * 16) = e0; *(LAS f32x4*)(L + SPART + ((w * 2 + 1) * 64 + lane) * 16) = e1; }
            { const bf16x8 v0 = *(const LAS bf16x8*)(L + SVT + sw128(16 * nt + fr, fq)), v1 = *(const LAS bf16x8*)(L + SVT + sw128(16 * nt + fr, 4 + fq));
#pragma unroll
              for (int i = 0; i < 8; ++i) { const int row = 128 * dh + 16 * i + fr;
                  const bf16x8 a0 = *(const LAS bf16x8*)(L + SKET + sw128(row, fq)), a1 = *(const LAS bf16x8*)(L + SKET + sw128(row, 4 + fq));
                  S[i] = __builtin_amdgcn_mfma_f32_16x16x32_bf16(a0, v0, S[i], 0, 0, 0); S[i] = __builtin_amdgcn_mfma_f32_16x16x32_bf16(a1, v1, S[i], 0, 0, 0);
                  const f32x4 el = *(const LAS f32x4*)(L + SEL + (128 * dh + 16 * i + 4 * fq) * 4); S[i] = S[i] * el; } }
            LDS_WAIT(); __syncthreads();
            { const int wo = (1 - dh) * 4 + nt;
              const bf16x8 v0 = *(const LAS bf16x8*)(L + SVT + sw128(16 * nt + fr, fq)), v1 = *(const LAS bf16x8*)(L + SVT + sw128(16 * nt + fr, 4 + fq));
#pragma unroll
              for (int i = 0; i < 2; ++i) { const int mt = 2 * dh + i;
                  f32x4 a = (i == 0 ? (dh ? ao[2] : ao[0]) : (dh ? ao[3] : ao[1])) + *(const LAS f32x4*)(L + SPART + ((wo * 2 + i) * 64 + lane) * 16);
                  const bf16x8 t0 = *(const LAS bf16x8*)(L + SATT + sw128(16 * mt + fr, fq)); a = __builtin_amdgcn_mfma_f32_16x16x32_bf16(t0, v0, a, 0, 0, 0);
                  if (dh) { const bf16x8 t1 = *(const LAS bf16x8*)(L + SATT + sw128(16 * mt + fr, 4 + fq)); a = __builtin_amdgcn_mfma_f32_16x16x32_bf16(t1, v1, a, 0, 0, 0); }
                  const size_t grow = (size_t)b * SEQ + (size_t)c * 64 + 16 * mt + 4 * fq;
                  bf16* op = Og + grow * DM + h * GLA_DV + slice * 64 + 16 * nt + fr;
#pragma unroll
                  for (int j = 0; j < 4; ++j) { float s2 = a[j] * a[j]; s2 = dpp_shr_add(s2, 1); s2 = dpp_shr_add(s2, 2); s2 = dpp_shr_add(s2, 4); s2 = dpp_shr_add(s2, 8);
                      if (fr == 15) SSHg[((grow + j) * 4 + h) * 24 + slice * 4 + nt] = s2;
                      op[(size_t)j * DM] = (bf16)f2bf(a[j] * pg8::silu_f(bf2f(ogv[i * 4 + j]))); } } }
            __syncthreads();
            if (c + 1 < 64) { VM_WAIT(); SCAN_WRITE(); }
            LDS_WAIT(); __syncthreads();
        }
#undef SCAN_LOAD_A
#undef SCAN_LOAD_B
#undef SCAN_WRITE
    }
}

__device__ __forceinline__ void gla_onorm_phase(const Ctx& C, int layer) {
    const bf16* Z = wsp<bf16>(C, WS_Z); bf16* MIX = wsp<bf16>(C, WS_MIX); const float* gain = C.in[10] + (size_t)layer * GLA_V;
    const int gw = C.vcu * NWAVES + C.wave, NGW = C.G * NWAVES, lane = C.lane;
    for (int m = gw; m < MTOK; m += NGW) {
#pragma unroll
        for (int h = 0; h < 4; ++h) {
            float o[8], g[8]; float ss = 0.f;
            if (lane < 48) { const v4u ov = *(const GAS v4u*)(MIX + (size_t)m * DM + h * GLA_DV + lane * 8), gv = *(const GAS v4u*)(Z + (size_t)m * GLA_IN + ZOG + h * GLA_DV + lane * 8);
#pragma unroll
                for (int j = 0; j < 4; ++j) { o[2 * j] = bflo(ov[j]); o[2 * j + 1] = bfhi(ov[j]); g[2 * j] = bflo(gv[j]); g[2 * j + 1] = bfhi(gv[j]); }
#pragma unroll
                for (int j = 0; j < 8; ++j) ss += o[j] * o[j]; }
            const float rstd = 1.0f / sqrtf(wave_sum(ss) * (1.f / GLA_DV) + EPS);
            if (lane < 48) { const f32x4 ga = *(const GAS f32x4*)(gain + h * GLA_DV + lane * 8), gb = *(const GAS f32x4*)(gain + h * GLA_DV + lane * 8 + 4);
                float y[8];
#pragma unroll
                for (int j = 0; j < 8; ++j) { const float gn = j < 4 ? ga[j] : gb[j - 4]; y[j] = o[j] * rstd * gn * pg8::silu_f(g[j]); }
                *(GAS v4u*)(MIX + (size_t)m * DM + h * GLA_DV + lane * 8) = (v4u){pk2(y[0], y[1]), pk2(y[2], y[3]), pk2(y[4], y[5]), pk2(y[6], y[7])}; }
        }
    }
}

__device__ __forceinline__ void fox_cumsum_phase(const Ctx& C) {
    const float* FL = wsp<float>(C, WS_GLR); float* CF = wsp<float>(C, WS_CF); const float* bfp = C.in[14];
    const int gw = C.vcu * NWAVES + C.wave, NGW = C.G * NWAVES, lane = C.lane;
    for (int q = gw; q < BATCH * FOX_H; q += NGW) { const int b = q / FOX_H, h = q - b * FOX_H; const float bias = bfp[h];
        float v[64]; float run = 0.f;
#pragma unroll
        for (int i = 0; i < 64; ++i) { const float x = FL[((size_t)b * SEQ + lane * 64 + i) * 16 + h] + bias; run += fminf(x, 0.f) - 0.6931471805599453f * __builtin_amdgcn_logf(1.0f + __builtin_amdgcn_exp2f(-1.4426950408889634f * fabsf(x))); v[i] = run; }
        LAS float* tot = (LAS float*)(C.lds + C.wave * 256);
        tot[lane] = run; LDS_WAIT(); asm volatile("" ::: "memory");
        float excl = 0.f;
        for (int j = 0; j < 64; ++j) { const float t = tot[j]; excl += (j < lane) ? t : 0.f; }
        LDS_WAIT(); asm volatile("" ::: "memory");
#pragma unroll
        for (int i = 0; i < 64; i += 4) *(GAS f32x4*)(CF + (size_t)q * SEQ + lane * 64 + i) = (f32x4){v[i] + excl, v[i + 1] + excl, v[i + 2] + excl, v[i + 3] + excl} * (-att::INV_SCALE);
    }
}

__device__ __forceinline__ void conv_fix_phase(const Ctx& C, int layer) {
    const float* HALO = wsp<float>(C, WS_HALO); bf16* G = wsp<bf16>(C, WS_Z); const float* cw = C.in[18] + (size_t)layer * 3 * FF2; const float* cb = C.in[19] + (size_t)layer * FF2;
    const int gt = C.vcu * NTHREADS + C.tid, NT = C.G * NTHREADS;
    for (int i = gt; i < 128 * (FFH / 4); i += NT) { const int pm = i / (FFH / 4), c = 4 * (i - pm * (FFH / 4)), pn = c >> 7, cc = c & 127;
        const int ca = pn * 256 + cc, cv = ca + 128;
        const float* h0 = HALO + (size_t)pm * 4 * FF2; const bool first = (pm & 15) == 0; const float* hp = HALO + (size_t)(first ? pm : pm - 1) * 4 * FF2;
        const f32x4 z4 = (f32x4){0.f, 0.f, 0.f, 0.f};
        const f32x4 a0 = *(const GAS f32x4*)(h0 + ca), a1 = *(const GAS f32x4*)(h0 + FF2 + ca), v0 = *(const GAS f32x4*)(h0 + cv), v1 = *(const GAS f32x4*)(h0 + FF2 + cv);
        f32x4 am2 = *(const GAS f32x4*)(hp + 2 * FF2 + ca), am1 = *(const GAS f32x4*)(hp + 3 * FF2 + ca), vm2 = *(const GAS f32x4*)(hp + 2 * FF2 + cv), vm1 = *(const GAS f32x4*)(hp + 3 * FF2 + cv);
        if (first) { am2 = z4; am1 = z4; vm2 = z4; vm1 = z4; }
        const f32x4 wa0 = *(const GAS f32x4*)(cw + c), wa1 = *(const GAS f32x4*)(cw + FF2 + c), wa2 = *(const GAS f32x4*)(cw + 2 * FF2 + c), ba = *(const GAS f32x4*)(cb + c);
        const f32x4 wv0 = *(const GAS f32x4*)(cw + FFH + c), wv1 = *(const GAS f32x4*)(cw + FF2 + FFH + c), wv2 = *(const GAS f32x4*)(cw + 2 * FF2 + FFH + c), bv = *(const GAS f32x4*)(cb + FFH + c);
        const f32x4 ya0 = wa0 * am2 + wa1 * am1 + wa2 * a0 + ba, yv0 = wv0 * vm2 + wv1 * vm1 + wv2 * v0 + bv;
        const f32x4 ya1 = wa0 * am1 + wa1 * a0 + wa2 * a1 + ba, yv1 = wv0 * vm1 + wv1 * v0 + wv2 * v1 + bv;
        float g0[4], g1[4];
#pragma unroll
        for (int j = 0; j < 4; ++j) { g0[j] = pg8::silu_f(ya0[j]) * yv0[j]; g1[j] = pg8::silu_f(ya1[j]) * yv1[j]; }
        *(GAS v2u*)(G + (size_t)(pm * 256) * FFP + c) = (v2u){pk2(g0[0], g0[1]), pk2(g0[2], g0[3])}; *(GAS v2u*)(G + (size_t)(pm * 256 + 1) * FFP + c) = (v2u){pk2(g1[0], g1[1]), pk2(g1[2], g1[3])};
    }
}

struct AttnPlan { int fox; const bf16* Q; int qs; int mqcol; const bf16* MKV; int idx, stride; };
__device__ __forceinline__ att::BlockRef attn_decode(const Ctx& C, const AttnPlan& P, int i, int nfox) {
    att::BlockRef r;
    bf16* MIX = wsp<bf16>(C, WS_MIX);
    if (i < nfox) {
        const int L = P.idx + P.stride * (i >> 1), pass = i & 1;
        const int xcd = L & 7, k = L >> 3, bh = xcd * 12 + (k >> 3), x = k & 7, qb = pass ? 15 - x : x, b = bh / FOX_H, h = bh - b * FOX_H;
        const size_t row0 = (size_t)b * SEQ + (size_t)qb * 256;
        r.Q = P.Q + row0 * P.qs + h * 128; r.qs = P.qs;
        r.K = wsp<bf16>(C, WS_KF) + (size_t)b * SEQ * FOX_W + h * 128; r.V = wsp<bf16>(C, WS_VF) + (size_t)b * SEQ * FOX_W + h * 128; r.kvs = FOX_W;
        r.O = MIX + row0 * DM + h * 128; r.os = DM; r.cb = wsp<float>(C, WS_CF) + (size_t)bh * SEQ; r.P0 = qb * 256; r.skv = SEQ; r.jlo = 0;
    } else {
        const int L = P.idx + P.stride * (i - nfox);
        const int bmh = L >> 4, qb = L & 15, b = bmh >> 2, mh = bmh & 3; const size_t row0 = (size_t)b * SEQ + (size_t)qb * 256;
        r.Q = P.Q + row0 * P.qs + P.mqcol + mh * 128; r.qs = P.qs;
        r.K = P.MKV + (size_t)b * NMEM * 4096 + mh * 128; r.V = r.K + 512; r.kvs = 4096;
        r.O = MIX + row0 * DM + FOX_W + mh * 128; r.os = DM; r.cb = wsp<float>(C, WS_CTL); r.P0 = NMEM; r.skv = NMEM; r.jlo = 0;
    }
    return r;
}
__device__ __forceinline__ void attn_phase(const Ctx& C, const AttnPlan& P) {
    int nfox = 0; if (P.fox) { for (int L = P.idx; L < 768; L += P.stride) nfox += 2; }
    int nmem = 0; for (int L = P.idx; L < 512; L += P.stride) nmem += 1;
    const int n = nfox + nmem; if (n == 0) return;
    att::Seam S; att::BlockRef cur = attn_decode(C, P, 0, nfox);
    att::attn_prime(cur, (char*)C.lds, S, C.wave);
    for (int i = 0; i < n; ++i) {
        const att::BlockRef nxt = (i + 1 < n) ? attn_decode(C, P, i + 1, nfox) : cur;
        att::attn_block(cur, nxt, (char*)C.lds, S, C.wave);
        cur = nxt;
    }
}

#ifndef FOX_BLOCK_QMAX
#define FOX_BLOCK_QMAX 0
#endif
constexpr int CW_NQB = 32768;
constexpr int CW_NK2 = 16384, CW_NQ2 = 16640  , CW_QHEAD = 17408  ;
__device__ __forceinline__ void head_norms_phase(const Ctx& C, const bf16* src, int stride, unsigned* out2, const bool per_block = false) {
    const int gw = C.vcu * NWAVES + C.wave, NGW = C.G * NWAVES, lane = C.lane;
    for (int task = gw; task < BATCH * FOX_H * 16; task += NGW) { const int bh = task >> 4, rb = task & 15, b = bh / FOX_H, h = bh - b * FOX_H;
        const bf16* p = src + ((size_t)b * SEQ + (size_t)rb * 256 + (lane >> 4)) * stride + h * 128 + (lane & 15) * 8; float mx = 0.f;
#pragma unroll 8
        for (int i = 0; i < 64; ++i) { const v4u w = *(const GAS v4u*)(p + (size_t)(4 * i) * stride); float s = 0.f;
#pragma unroll
            for (int j = 0; j < 4; ++j) { const float lo = bflo(w[j]), hi = bfhi(w[j]); s += lo * lo + hi * hi; }
            s = dpp_shr_add(s, 1); s = dpp_shr_add(s, 2); s = dpp_shr_add(s, 4); s = dpp_shr_add(s, 8);
            mx = fmaxf(mx, s); }
        float m0 = __builtin_bit_cast(float, __builtin_amdgcn_readlane(__builtin_bit_cast(int, mx), 15)), m1 = __builtin_bit_cast(float, __builtin_amdgcn_readlane(__builtin_bit_cast(int, mx), 31));
        float m2 = __builtin_bit_cast(float, __builtin_amdgcn_readlane(__builtin_bit_cast(int, mx), 47)), m3 = __builtin_bit_cast(float, __builtin_amdgcn_readlane(__builtin_bit_cast(int, mx), 63));
        const float m = fmaxf(fmaxf(m0, m1), fmaxf(m2, m3));
        if (lane == 0) { if (per_block) out2[task] = __builtin_bit_cast(unsigned, m); else atomicMax(out2 + bh, __builtin_bit_cast(unsigned, m)); } }
}
__device__ __forceinline__ int fox_jlo(const float* cb, int P0, float thr, int lane) {
    const int last = 64 * lane + 63; const bool cand = last < P0;
    const float d = cand ? cb[last] - cb[P0] : 0.f;
    const unsigned long long m = __ballot(cand && d < thr);
    return __builtin_amdgcn_readfirstlane((int)__builtin_ctzll(~m));
}
__device__ __forceinline__ att::BlockRef fox_decode(const Ctx& C, int layer, int code, int lane) {
    att::BlockRef r; bf16* MIX = wsp<bf16>(C, WS_MIX); const bf16* Qz = wsp<bf16>(C, WS_Z);
    const int x = code >> 8, v = code & 255;
    if (v < 192) { const int hl = v % 12, qb = 15 - v / 12, bh = x * 12 + hl, b = bh / FOX_H, h = bh - b * FOX_H; const size_t row0 = (size_t)b * SEQ + (size_t)qb * 256;
        r.Q = Qz + row0 * DM + h * 128; r.qs = DM;
        r.K = wsp<bf16>(C, WS_KF) + (size_t)b * SEQ * FOX_W + h * 128; r.V = wsp<bf16>(C, WS_VF) + (size_t)b * SEQ * FOX_W + h * 128; r.kvs = FOX_W;
        r.O = MIX + row0 * DM + h * 128; r.os = DM; r.cb = wsp<float>(C, WS_CF) + (size_t)bh * SEQ; r.P0 = qb * 256; r.skv = SEQ;
        const unsigned* ctl = (const unsigned*)(C.ws + WS_CTL);
#if FOX_BLOCK_QMAX
        float qn2;
        { float s = 0.f; if (C.tid < 256) s = (float)wsp<unsigned>(C, WS_NQ)[(size_t)(layer - 2) * MTOK * 12 + (row0 + C.tid) * 12 + h];
          const float m = wave_max(s);
          volatile LAS float* mx = (volatile LAS float*)(C.lds + MISC_OFF + 256);
          if (lane == 0) mx[C.wave] = m;
          __syncthreads();
          qn2 = fmaxf(fmaxf(fmaxf(mx[0], mx[1]), fmaxf(mx[2], mx[3])), fmaxf(fmaxf(mx[4], mx[5]), fmaxf(mx[6], mx[7]))) * (1.0f / 256.0f);
          __syncthreads(); }
        const float kn2 = __builtin_bit_cast(float, ctl[CW_NK2 + bh]);
#else
        const float qn2 = __builtin_bit_cast(float, ctl[CW_NQB + 2048 * (layer - 2) + bh * 16 + qb]), kn2 = __builtin_bit_cast(float, ctl[CW_NK2 + bh]);
#endif
        r.jlo = fox_jlo(r.cb, r.P0, -(45.0f * att::INV_SCALE + 2.0f * sqrtf(qn2 * kn2) * 1.01f), lane);
    } else { const int id = x * 64 + (v - 192), bmh = id >> 4, qb = id & 15, b = bmh >> 2, mh = bmh & 3; const size_t row0 = (size_t)b * SEQ + (size_t)qb * 256;
        r.Q = Qz + row0 * DM + FOX_W + mh * 128; r.qs = DM;
        r.K = wsp<bf16>(C, WS_MKV) + 1024 * layer + (size_t)b * NMEM * 4096 + mh * 128; r.V = r.K + 512; r.kvs = 4096;
        r.O = MIX + row0 * DM + FOX_W + mh * 128; r.os = DM; r.cb = wsp<float>(C, WS_CTL); r.P0 = NMEM; r.skv = NMEM; r.jlo = 0; }
    return r;
}
__device__ __forceinline__ int fox_grab(const Ctx& C, int layer) {
    volatile LAS int* box = (volatile LAS int*)(C.lds + MISC_OFF + 128);
    if (C.tid == 0) { unsigned* heads = (unsigned*)(C.ws + WS_CTL) + CW_QHEAD + 64 * 8 * (layer - 2); int code = -1;
        for (int i = 0; i < 8 && code < 0; ++i) { const int q = (C.bx + i) & 7; const unsigned v = __hip_atomic_fetch_add(heads + 64 * q, 1u, __ATOMIC_RELAXED, __HIP_MEMORY_SCOPE_AGENT); if (v < 256u) code = q * 256 + (int)v; }
        box[0] = code; }
    __syncthreads();
    const int code = box[0];
    __syncthreads();
    return code;
}
__device__ __forceinline__ void fox_attn_phase(const Ctx& C, int layer) {
    int code = fox_grab(C, layer); if (code < 0) return;
    att::Seam S; att::BlockRef cur = fox_decode(C, layer, code, C.lane);
    att::attn_prime(cur, (char*)C.lds, S, C.wave);
    for (;;) {
        const int nc = fox_grab(C, layer);
        const att::BlockRef nxt = nc >= 0 ? fox_decode(C, layer, nc, C.lane) : cur;
        att::attn_block(cur, nxt, (char*)C.lds, S, C.wave);
        if (nc < 0) break;
        cur = nxt;
    }
}
enum Kind { K_PROLOGUE = 0, K_MEMKV, K_IN, K_MIX1, K_PREP, K_SCAN, K_ONORM, K_OUT, K_RMSF, K_UP, K_FIX, K_DOWN, K_NORMN, K_KV, K_CUM, K_QN, K_DRYUP, K_DRYDOWN, K_COUNT };
#ifndef KEEP_ONORM
#define KEEP_ONORM 0
#endif
#ifndef QN_IN_EPI
#define QN_IN_EPI 0
#endif
#ifndef IN_WGM
#define IN_WGM 8
#endif
#ifndef MEMKV_FILL
#define MEMKV_FILL 1
#endif
#ifndef QK_TEMPORAL_TILES
#define QK_TEMPORAL_TILES 0
#endif
#ifndef DOWN_WGM
#define DOWN_WGM 4
#endif
#ifndef SKINNY_STAGGER
#define SKINNY_STAGGER 0
#endif
#ifndef PROBE_DUP_IN
#define PROBE_DUP_IN 0
#endif
#ifndef PROBE_DUP_UP
#define PROBE_DUP_UP 0
#endif
#ifndef PROBE_DRY_UP
#define PROBE_DRY_UP 0
#endif
#ifndef PROBE_DRY_DOWN
#define PROBE_DRY_DOWN 0
#endif
__device__ __forceinline__ unsigned* ss_arr(const Ctx& C, int id) { return wsp<unsigned>(C, WS_SS) + (size_t)id * MTOK; }
struct Args { const float* in[21]; float* out; unsigned char* ws; int layer, fused, ph_lo, ph_hi; };
__device__ __forceinline__ void make_ctx(Ctx& C, const Args& args, unsigned char* lds_raw, int wave) {
    int bx = blockIdx.x; asm volatile("" : "+s"(bx));
    int G = gridDim.x; asm volatile("" : "+s"(G));
    unsigned long long z = 0; asm volatile("" : "+s"(z));
    const Args* ap = (const Args*)((const char*)&args + z);
    C.lds = (LAS unsigned char*)lds_raw;
    C.wave = wave; C.tid = opaque_tid(wave); C.lane = C.tid & 63;
    C.G = G; C.bx = bx; C.vcu = (C.G % 8 == 0) ? (C.bx % 8) * (C.G / 8) + C.bx / 8 : C.bx;
#pragma unroll
    for (int i = 0; i < 21; ++i) C.in[i] = ap->in[i];
    C.out = ap->out; C.ws = ap->ws;
}
__device__ __forceinline__ int wave_index() { int w = __builtin_amdgcn_readfirstlane((int)threadIdx.x >> 6); asm volatile("" : "+s"(w)); return w; }
template <int KIND> __device__ __forceinline__ void run_phase(const Ctx& C, int layer) {
    LAS unsigned char* ring = C.lds;
    const bool gla = layer < 2; const int lj = gla ? layer : layer - 2;
    if constexpr (KIND == K_PROLOGUE) { p0_prologue(C); }
    if constexpr (KIND == K_MEMKV) {
        pg8::Gemm g{wsp<bf16>(C, WS_MEMN), wsp<bf16>(C, WS_WMEM), MMEM, 4096, DM}; pg8::StaticOrder S; S.init(MMEM, 4096, C.G, C.bx);
        pg8::EpiBf16 E{wsp<bf16>(C, WS_MKV), 4096, nullptr, nullptr, C.lds + XTRA_OFF};
        pg8::gemm_phase<pg8::EpiBf16, pg8::StaticOrder, true, true>(ring, g, S, E, C.wave);
        if (MEMKV_FILL && C.G > 128 && C.bx >= 128)
            skinny16_phase(C, wsp<bf16>(C, WS_H), wsp<bf16>(C, WS_WGLR), wsp<float>(C, WS_GLR), ss_arr(C, 0), (C.bx - 128) * NWAVES + C.wave, (C.G - 128) * NWAVES);
    }
    if constexpr (KIND == K_IN) {
        const int N = gla ? GLA_IN : DM;
        const bf16* Bt = gla ? wsp<bf16>(C, WS_WGIN) + (size_t)lj * GLA_IN * DM : wsp<bf16>(C, WS_WFIN) + (size_t)lj * DM * DM;
        const bf16* Aop = wsp<bf16>(C, WS_H); const unsigned* ssp = ss_arr(C, 2 * layer);
        pg8::Gemm g{Aop, Bt, MTOK, N, DM, XBP}; pg8::StaticOrder S; S.init(MTOK, N, C.G, C.bx, IN_WGM);
        pg8::EpiBf16H E{wsp<bf16>(C, WS_Z), N, ssp, (QN_IN_EPI && !gla) ? (unsigned*)(C.ws + WS_CTL) + CW_NQB + 2048 * lj : nullptr, C.lds + XTRA_OFF, gla ? QK_TEMPORAL_TILES : 0};
        const bool early = SKINNY_STAGGER && ((C.bx >> 3) & 1) != 0;
        if (gla && early) skinny16_phase(C, Aop, wsp<bf16>(C, WS_WGLR) + (size_t)lj * 16 * DM, wsp<float>(C, WS_GLR), ssp);
        pg8::gemm_phase<pg8::EpiBf16H, pg8::StaticOrder, true, true>(ring, g, S, E, C.wave);
        if (gla && !early && !(MEMKV_FILL && layer == 0 && C.G > 128)) skinny16_phase(C, Aop, wsp<bf16>(C, WS_WGLR) + (size_t)lj * 16 * DM, wsp<float>(C, WS_GLR), ssp);
    }
    if constexpr (KIND == K_MIX1) { fox_attn_phase(C, layer); }
    if constexpr (KIND == K_QN) { head_norms_phase(C, wsp<bf16>(C, WS_Z), DM, (unsigned*)(C.ws + WS_CTL) + CW_NQB + 2048 * (layer - 2), true); }
    if constexpr (KIND == K_PREP) { gla_prep_phase(C, lj); }
    if constexpr (KIND == K_SCAN) {
        if (C.vcu < 192) gla_scan_phase(C);
        else { AttnPlan P; P.fox = 0; P.Q = wsp<bf16>(C, WS_Z); P.qs = GLA_IN; P.mqcol = ZMQ; P.MKV = wsp<bf16>(C, WS_MKV) + 1024 * layer; P.idx = C.vcu - 192; P.stride = C.G - 192;
            attn_phase(C, P); __syncthreads(); convert_late(C, layer, (C.vcu - 192) * NWAVES + C.wave, (C.G - 192) * NWAVES); }
    }
    if constexpr (KIND == K_ONORM) { gla_onorm_phase(C, lj); }
    if constexpr (KIND == K_OUT) {
        const float* xin = (layer == 0) ? C.in[0] : nullptr;
        const bf16* Bt = gla ? wsp<bf16>(C, WS_WGOUT) + (size_t)lj * DM * DM : wsp<bf16>(C, WS_WFOUT) + (size_t)lj * DM * DM;
        pg8::Gemm g{wsp<bf16>(C, WS_MIX), Bt, MTOK, DM, DM}; pg8::StaticOrder S; S.init(MTOK, DM, C.G, C.bx, DOWN_WGM);
        if (gla) { pg8::EpiResK E{xin, wsp<bf16>(C, WS_XH), wsp<bf16>(C, WS_H), ss_arr(C, 1 + 2 * layer), XBP, wsp<float>(C, WS_SSH), C.lds + XTRA_OFF};
            pg8::gemm_phase<pg8::EpiResK, pg8::StaticOrder, true, true>(ring, g, S, E, C.wave); }
        else { pg8::EpiRes E{xin, wsp<bf16>(C, WS_XH), wsp<bf16>(C, WS_H), ss_arr(C, 1 + 2 * layer), XBP, nullptr, C.lds + XTRA_OFF};
            pg8::gemm_phase<pg8::EpiRes, pg8::StaticOrder, true, true>(ring, g, S, E, C.wave); }
    }
    if constexpr (KIND == K_UP) {
        const bf16* Aop = wsp<bf16>(C, WS_H); const unsigned* ssp = ss_arr(C, 1 + 2 * layer);
        pg8::Gemm g{Aop, wsp<bf16>(C, WS_WUP) + (size_t)layer * FF2 * DM, MTOK, FF2, DM, XBP}; pg8::StaticOrder S; S.init(MTOK, FF2, C.G, C.bx);
        pg8::EpiConv E{wsp<bf16>(C, WS_Z), wsp<float>(C, WS_HALO), C.in[18] + (size_t)layer * 3 * FF2, C.in[19] + (size_t)layer * FF2, C.lds + XTRA_OFF, ssp, FFP};
        pg8::gemm_phase<pg8::EpiConv, pg8::StaticOrder, true, true>(ring, g, S, E, C.wave);
    }
#if defined(PROBE_DRY)
    if constexpr (KIND == K_DRYUP) {
        pg8::Gemm g{wsp<bf16>(C, WS_H), wsp<bf16>(C, WS_WUP) + (size_t)layer * FF2 * DM, MTOK, FF2, DM, XBP}; pg8::StaticOrder S; S.init(MTOK, FF2, C.G, C.bx);
        pg8::EpiDry E{wsp<float>(C, WS_HALO)};
        pg8::gemm_phase<pg8::EpiDry, pg8::StaticOrder, true, true>(ring, g, S, E, C.wave);
    }
    if constexpr (KIND == K_DRYDOWN) {
        pg8::Gemm g{wsp<bf16>(C, WS_Z), wsp<bf16>(C, WS_WDOWN) + (size_t)layer * DM * FFH, MTOK, DM, FFH}; pg8::StaticOrder S; S.init(MTOK, DM, C.G, C.bx);
        pg8::EpiDry E{wsp<float>(C, WS_HALO)};
        pg8::gemm_phase<pg8::EpiDry, pg8::StaticOrder, true, true>(ring, g, S, E, C.wave);
    }
#endif
    if constexpr (KIND == K_FIX) { conv_fix_phase(C, layer); }
    if constexpr (KIND == K_DOWN) {
        pg8::Gemm g{wsp<bf16>(C, WS_Z), wsp<bf16>(C, WS_WDOWN) + (size_t)layer * DM * FFH, MTOK, DM, FFH, FFP}; pg8::StaticOrder S; S.init(MTOK, DM, C.G, C.bx, DOWN_WGM);
        pg8::EpiRes E{nullptr, wsp<bf16>(C, WS_XH), (RES_BF16 || layer < 3) ? wsp<bf16>(C, WS_H) : nullptr, layer < 3 ? ss_arr(C, 2 + 2 * layer) : nullptr, XBP, nullptr, C.lds + XTRA_OFF};
        pg8::gemm_phase<pg8::EpiRes, pg8::StaticOrder, true, true>(ring, g, S, E, C.wave);
    }
    if constexpr (KIND == K_NORMN) { rms_bf16_phase(C, wsp<bf16>(C, RES_BF16 ? WS_H : WS_XH), C.in[5], C.out); }
    if constexpr (KIND == K_KV) {
        const bf16* Aop = wsp<bf16>(C, WS_H); const unsigned* ssp = ss_arr(C, 4);
        pg8::Gemm g{Aop, wsp<bf16>(C, WS_WFKV), MTOK, 3072, DM, XBP}; pg8::StaticOrder S; S.init(MTOK, 3072, C.G, C.bx);
        pg8::EpiSplit2 E{wsp<bf16>(C, WS_KF), wsp<bf16>(C, WS_VF), FOX_W, ssp};
        const bool early = SKINNY_STAGGER && ((C.bx >> 3) & 1) != 0;
        if (early) skinny16_phase(C, Aop, wsp<bf16>(C, WS_WFL), wsp<float>(C, WS_GLR), ssp);
        pg8::gemm_phase<pg8::EpiSplit2, pg8::StaticOrder, true, true>(ring, g, S, E, C.wave);
        if (!early) skinny16_phase(C, Aop, wsp<bf16>(C, WS_WFL), wsp<float>(C, WS_GLR), ssp);
    }
    if constexpr (KIND == K_CUM) { fox_cumsum_phase(C); head_norms_phase(C, wsp<bf16>(C, WS_KF), FOX_W, (unsigned*)(C.ws + WS_CTL) + CW_NK2); }
}
template <int KIND> __global__ void __launch_bounds__(NTHREADS, 2) phase_kernel(Args args) {
    extern __shared__ __attribute__((aligned(16))) unsigned char lds_raw[];
    Ctx C; make_ctx(C, args, lds_raw, wave_index());
    run_phase<KIND>(C, args.layer);
}
__global__ void __launch_bounds__(NTHREADS, 2) hybrid_fwd(Args args) {
    extern __shared__ __attribute__((aligned(16))) unsigned char lds_raw[];
    const int wave = wave_index();
    volatile LAS unsigned* MISC = (volatile LAS unsigned*)((LAS unsigned char*)lds_raw + MISC_OFF);
    { const int t = opaque_tid(wave); if (t < 64) MISC[t] = 0u; }
    __syncthreads();
    XcdBarrier bar = xcd_barrier_post((unsigned*)(args.ws + WS_CTL) + CW_BAR, MISC + 8, wave);
#define PHASE(KIND, L) do { Ctx C; make_ctx(C, args, lds_raw, wave); run_phase<KIND>(C, (L)); } while (0)
#define SEAM() do { XcdBarrier b_ = bar; asm volatile("" : "+s"(b_.bar)); xcd_barrier(b_, wave); } while (0)
    PHASE(K_PROLOGUE, 0); SEAM();
    PHASE(K_MEMKV, 0);
#define LAYER(layer) do {                                                                                   \
        if (PROBE_DUP_IN && (layer) == 0) { PHASE(K_IN, layer); SEAM(); }                                   \
        PHASE(K_IN, layer); SEAM();                                                                         \
        if ((layer) == 2) { PHASE(K_CUM, layer); if (FOX_BLOCK_QMAX || QN_IN_EPI) SEAM(); }     \
        if (!FOX_BLOCK_QMAX && !QN_IN_EPI && (layer) >= 2) { PHASE(K_QN, layer); SEAM(); }                                \
        if ((layer) < 2) { PHASE(K_PREP, layer); } else { PHASE(K_MIX1, layer); } SEAM();                   \
        if ((layer) < 2) { PHASE(K_SCAN, layer); SEAM(); if (KEEP_ONORM) { PHASE(K_ONORM, layer); SEAM(); } }  \
        PHASE(K_OUT, layer); SEAM();                                                \
        if (PROBE_DRY_UP && (layer) == 2) { PHASE(K_DRYUP, layer); SEAM(); }                                \
        if (PROBE_DUP_UP && (layer) == 2) { PHASE(K_UP, layer); SEAM(); }                                   \
        PHASE(K_UP, layer); SEAM();                                                               \
        PHASE(K_FIX, layer); SEAM();                                                                        \
        if (PROBE_DRY_DOWN && (layer) == 2) { PHASE(K_DRYDOWN, layer); SEAM(); }                            \
        PHASE(K_DOWN, layer); SEAM();                                               \
        if ((layer) == 3) { PHASE(K_NORMN, layer); }                                                        \
        if ((layer) == 1) { PHASE(K_KV, layer); } } while (0)
    LAYER(0); LAYER(1); LAYER(2); LAYER(3);
#undef LAYER
#undef PHASE
#undef SEAM
}
template <int KIND> static void launch_phase(Args& a, int layer, int grid, hipStream_t stream) {
    static bool attr = false;
    if (!attr) { (void)hipFuncSetAttribute((const void*)phase_kernel<KIND>, hipFuncAttributeMaxDynamicSharedMemorySize, LDS_BYTES); attr = true; }
    a.layer = layer;
    hipLaunchKernelGGL(phase_kernel<KIND>, dim3(grid), dim3(NTHREADS), LDS_BYTES, stream, a);
}

constexpr size_t WS_NEED = WS_NQ + (size_t)2 * MTOK * 12 * 4;
extern "C" void kernel_launch(void* const* d_in, const int* in_sizes, int n_in, void* d_out, int out_size, void* d_ws, size_t ws_size, hipStream_t stream) {
    static int grid = 0;
    if (grid == 0) {
        if (n_in != 21 || in_sizes[0] != MTOK * DM || out_size != MTOK * DM || ws_size < WS_NEED) {
            fprintf(stderr, "kernel_launch: unexpected shapes / workspace (n_in %d, in0 %d, out %d, ws %zu < %zu); nothing launched\n", n_in, n_in > 0 ? in_sizes[0] : -1, out_size, ws_size, (size_t)WS_END); grid = -1; return; }
        int dev = 0, cus = 0;
        if (hipGetDevice(&dev) != hipSuccess || hipDeviceGetAttribute(&cus, hipDeviceAttributeMultiprocessorCount, dev) != hipSuccess) { grid = -1; return; }
        if (cus < 192) { fprintf(stderr, "kernel_launch: needs >= 192 CUs\n"); grid = -1; return; }
        grid = cus;
    }
    if (grid < 0) return;
    if (hipMemsetAsync((char*)d_ws + WS_CTL, 0, CTL_BYTES + (size_t)9 * MTOK * 4, stream) != hipSuccess) return;
    Args a{};
    for (int i = 0; i < 21; ++i) a.in[i] = (const float*)d_in[i];
    a.out = (float*)d_out; a.ws = (unsigned char*)d_ws;
#if MK_FUSED
    static bool attr = false;
    if (!attr) { if (hipFuncSetAttribute((const void*)hybrid_fwd, hipFuncAttributeMaxDynamicSharedMemorySize, LDS_BYTES) != hipSuccess) { fprintf(stderr, "kernel_launch: hipFuncSetAttribute failed\n"); return; } attr = true; }
    a.fused = 1;
    hipLaunchKernelGGL(hybrid_fwd, dim3(grid), dim3(NTHREADS), LDS_BYTES, stream, a);
#else
    launch_phase<K_PROLOGUE>(a, 0, grid, stream);
    launch_phase<K_MEMKV>(a, 0, grid, stream);
    for (int layer = 0; layer < 4; ++layer) {
        launch_phase<K_IN>(a, layer, grid, stream);
        if (layer < 2) launch_phase<K_PREP>(a, layer, grid, stream); else { launch_phase<K_QN>(a, layer, grid, stream); launch_phase<K_MIX1>(a, layer, grid, stream); }
        if (layer < 2) { launch_phase<K_SCAN>(a, layer, grid, stream); launch_phase<K_ONORM>(a, layer, grid, stream); }
        launch_phase<K_OUT>(a, layer, grid, stream);
        launch_phase<K_UP>(a, layer, grid, stream);
        launch_phase<K_FIX>(a, layer, grid, stream);
        launch_phase<K_DOWN>(a, layer, grid, stream);
        if (layer == 3) launch_phase<K_NORMN>(a, layer, grid, stream);
        if (layer == 1) { launch_phase<K_KV>(a, layer, grid, stream); launch_phase<K_CUM>(a, layer, grid, stream); }
    }
#endif
}
```

```cpp
#include <hip/hip_runtime.h>
#include <cstdio>
#include <cstdint>
#ifndef MK_FUSED
#define MK_FUSED 1
#endif
__device__ __forceinline__ int opaque_tid(int wave) { int l; asm volatile("v_mbcnt_lo_u32_b32 %0, -1, 0\n\tv_mbcnt_hi_u32_b32 %0, -1, %0" : "=v"(l)); return wave * 64 + l; }
namespace pg8 {
#define PG8_LAS __attribute__((address_space(3)))
typedef unsigned short bf16_t;
typedef short bf16x8 __attribute__((ext_vector_type(8)));
typedef float f32x4 __attribute__((ext_vector_type(4)));
typedef unsigned u32x4 __attribute__((ext_vector_type(4)));
typedef unsigned u32x2 __attribute__((ext_vector_type(2)));
constexpr int BM = 256, BK = 64, HALF = 128, HTB = HALF * BK * 2  , STAGE_BYTES = 8 * HTB, NXCD = 8, WGM = 8;

__host__ __device__ __forceinline__ int lds_byte(int r, int c) { const int st = (r >> 4) * 2 + (c >> 5), rr = r & 15, cc = c & 31, ob = rr * 64 + cc * 2; return st * 1024 + (ob ^ (((ob >> 9) & 1) << 5)); }
__host__ __device__ __forceinline__ void stage_rc(int b, int& R, int& C) { const int st = b / 1024, sb = b % 1024, swz = sb ^ (((sb >> 9) & 1) << 5); R = (st >> 1) * 16 + swz / 64; C = (st & 1) * 32 + (swz % 64) / 2; }
__host__ __device__ __forceinline__ int perm32(int rho) { const int n = rho >> 4, i = rho & 15; return 8 * (i >> 2) + 4 * n + (i & 3); }

typedef _Float16 h16x8 __attribute__((ext_vector_type(8)));
typedef _Float16 h16x2 __attribute__((ext_vector_type(2)));
template <bool F16> __device__ __forceinline__ f32x4 mfma16(bf16x8 a, bf16x8 b, f32x4 c) {
    if constexpr (F16) return __builtin_amdgcn_mfma_f32_16x16x32_f16(__builtin_bit_cast(h16x8, a), __builtin_bit_cast(h16x8, b), c, 0, 0, 0);
    else return __builtin_amdgcn_mfma_f32_16x16x32_bf16(a, b, c, 0, 0, 0);
}
__device__ __forceinline__ unsigned pkh2(float lo, float hi) { h16x2 v; v.x = (_Float16)lo; v.y = (_Float16)hi; return __builtin_bit_cast(unsigned, v); }
__device__ __forceinline__ float h2lo(unsigned w) { return (float)__builtin_bit_cast(h16x2, w).x; }
__device__ __forceinline__ float h2hi(unsigned w) { return (float)__builtin_bit_cast(h16x2, w).y; }
struct Unit { int pm, pn; };
struct Gemm { const bf16_t* A; const bf16_t* Bt; int M, N, K; int lda = 0; };

struct StaticOrder {
    int nM, nN, nwg, G, c, wgm;
    __host__ __device__ void init(int M, int N, int G_, int c_, int wgm_ = WGM) { nM = M / BM; nN = N / BM; nwg = nM * nN; G = G_; c = c_; wgm = wgm_; }
    __host__ __device__ bool next(int i, Unit& u) const {
        const long L = (long)i * G + c; if (L >= nwg) return false;
        int wgid = (int)L; { const int q = nwg / NXCD, r = nwg % NXCD, xcd = wgid % NXCD, off = wgid / NXCD; wgid = (xcd < r ? xcd * (q + 1) : r * (q + 1) + (xcd - r) * q) + off; }
        const int nig = wgm * nN, gid = wgid / nig, fm = gid * wgm, gsz = (nM - fm) < wgm ? (nM - fm) : wgm;
        u.pm = fm + ((wgid % nig) % gsz); u.pn = (wgid % nig) / gsz; return true;
    }
    __device__ __forceinline__ void a_ready(const Unit&) const {}
    __device__ __forceinline__ void done(const Unit&) const {}
};

__device__ __forceinline__ unsigned cvt_pk_bf16(float lo, float hi) { unsigned r; asm volatile("v_cvt_pk_bf16_f32 %0, %1, %2" : "=v"(r) : "v"(lo), "v"(hi)); return r; }

__device__ __forceinline__ float sum_fq(float s) {
    s += __builtin_bit_cast(float, __builtin_amdgcn_ds_swizzle(__builtin_bit_cast(int, s), 0x401F));
    float a = s, b = s; asm volatile("s_nop 1\n\tv_permlane32_swap_b32 %0, %1\n\ts_nop 1" : "+v"(a), "+v"(b));
    return a + b;
}
constexpr float SS_SCALE = 1024.0f;
__device__ __forceinline__ void row_rstd(const unsigned* ss, int row0, int fq, float (&rs)[2][4]) {
#pragma unroll
    for (int ai = 0; ai < 2; ++ai)
#pragma unroll
        for (int m = 0; m < 4; ++m) rs[ai][m] = ss ? __builtin_amdgcn_rsqf((float)ss[row0 + ai * HALF + m * 16] * (1.0f / (SS_SCALE * 2048.0f)) + 1e-6f) : 1.0f;
}
__device__ __forceinline__ u32x4 bperm4(int a, u32x4 w) { u32x4 r; r.x = (unsigned)__builtin_amdgcn_ds_bpermute(a, (int)w.x); r.y = (unsigned)__builtin_amdgcn_ds_bpermute(a, (int)w.y); r.z = (unsigned)__builtin_amdgcn_ds_bpermute(a, (int)w.z); r.w = (unsigned)__builtin_amdgcn_ds_bpermute(a, (int)w.w); return r; }
#define PG8_STORE_PERM const int lane_ = fq * 16 + fr, pq = lane_ & 3, pr = 4 * ((lane_ >> 2) & 3) + (lane_ >> 4), bpa = 4 * (16 * pq + pr)
__device__ __forceinline__ void ss_load_rows(const unsigned* ss, int row0, unsigned (&raw)[8]) {
#pragma unroll
    for (int ai = 0; ai < 2; ++ai)
#pragma unroll
        for (int m = 0; m < 4; ++m) raw[ai * 4 + m] = ss ? ss[row0 + ai * HALF + m * 16] : 0u;
}
__device__ __forceinline__ void rs_from_raw(const unsigned* ss, const unsigned (&raw)[8], float (&rs)[2][4]) {
#pragma unroll
    for (int ai = 0; ai < 2; ++ai)
#pragma unroll
        for (int m = 0; m < 4; ++m) rs[ai][m] = ss ? __builtin_amdgcn_rsqf((float)raw[ai * 4 + m] * (1.0f / (SS_SCALE * 2048.0f)) + 1e-6f) : 1.0f;
}
__device__ __forceinline__ float wave_max_nn(float v) {
    v = fmaxf(v, __builtin_bit_cast(float, __builtin_amdgcn_update_dpp(0, __builtin_bit_cast(int, v), 0x111, 0xf, 0xf, true)));
    v = fmaxf(v, __builtin_bit_cast(float, __builtin_amdgcn_update_dpp(0, __builtin_bit_cast(int, v), 0x112, 0xf, 0xf, true)));
    v = fmaxf(v, __builtin_bit_cast(float, __builtin_amdgcn_update_dpp(0, __builtin_bit_cast(int, v), 0x114, 0xf, 0xf, true)));
    v = fmaxf(v, __builtin_bit_cast(float, __builtin_amdgcn_update_dpp(0, __builtin_bit_cast(int, v), 0x118, 0xf, 0xf, true)));
    v = fmaxf(v, __builtin_bit_cast(float, __builtin_amdgcn_update_dpp(0, __builtin_bit_cast(int, v), 0x142, 0xa, 0xf, false)));
    v = fmaxf(v, __builtin_bit_cast(float, __builtin_amdgcn_update_dpp(0, __builtin_bit_cast(int, v), 0x143, 0xc, 0xf, false)));
    return __builtin_bit_cast(float, __builtin_amdgcn_readlane(__builtin_bit_cast(int, v), 63));
}
template <bool F16_> struct EpiBf16T {
    static constexpr bool PERM = true, AFTER_DRAIN = false, APERM = false, F16 = F16_, KSCALE = false;
    bf16_t* O; int ldc; const unsigned* ss; unsigned* qn; PG8_LAS unsigned char* xl; int tpn = 0;
    static constexpr bool SS_PRE = true;
    __device__ __forceinline__ void ss_load(const Unit& u, int wr, int fr, unsigned (&raw)[8]) const { ss_load_rows(ss, u.pm * BM + wr * 64 + fr, raw); }
    __device__ __forceinline__ void operator()(const f32x4 (&acc)[2][2][4][2], const Unit& u, int wr, int wc, int fr, int fq, const unsigned (&raw)[8]) const {
        const int row0 = u.pm * BM + wr * 64 + fr; const int col0 = u.pn * BM + wc * 32 + 8 * fq;
        float rs[2][4]; rs_from_raw(ss, raw, rs);
#pragma unroll
        for (int ai = 0; ai < 2; ++ai)
#pragma unroll
            for (int m = 0; m < 4; ++m) { bf16_t* rowp = O + (size_t)(row0 + ai * HALF + m * 16) * ldc + col0;
#pragma unroll
                for (int bj = 0; bj < 2; ++bj) { const f32x4 v0 = acc[ai][bj][m][0] * rs[ai][m], v1 = acc[ai][bj][m][1] * rs[ai][m];
                    u32x4 w; w.x = cvt_pk_bf16(v0[0], v0[1]); w.y = cvt_pk_bf16(v0[2], v0[3]); w.z = cvt_pk_bf16(v1[0], v1[1]); w.w = cvt_pk_bf16(v1[2], v1[3]);
                    if (u.pn < tpn) *(u32x4*)(rowp + bj * HALF) = w;
                    else __builtin_nontemporal_store(w, (u32x4*)(rowp + bj * HALF));
                    if (qn != nullptr && u.pn < 6) {
                        float s = ((v0[0] * v0[0] + v0[1] * v0[1]) + (v0[2] * v0[2] + v0[3] * v0[3])) + ((v1[0] * v1[0] + v1[1] * v1[1]) + (v1[2] * v1[2] + v1[3] * v1[3]));
                        s = sum_fq(s);
                        if (fq == 0) *(PG8_LAS float*)(xl + (((bj * BM + ai * HALF + wr * 64 + m * 16 + fr) * 4 + wc) * 4)) = s; } } }
        if (qn != nullptr && u.pn < 6) {
            asm volatile("s_waitcnt lgkmcnt(0)" ::: "memory"); __builtin_amdgcn_s_barrier(); asm volatile("" ::: "memory");
            const int lane_ = fq * 16 + fr, tid_ = (wr * 4 + wc) * 64 + lane_, bj2 = tid_ >> 8, row = tid_ & 255;
            const f32x4 pp = *(const PG8_LAS f32x4*)(xl + ((bj2 * BM + row) * 4) * 4);
            float t = (pp[0] + pp[1]) + (pp[2] + pp[3]);
            t = wave_max_nn(t);
            if (lane_ == 0) atomicMax(qn + ((u.pm >> 4) * 12 + 2 * u.pn + bj2) * 16 + (u.pm & 15), __builtin_bit_cast(unsigned, t));
        }
    }
};
typedef EpiBf16T<false> EpiBf16; typedef EpiBf16T<false> EpiBf16H;
#if defined(PROBE_DRY)
struct EpiDry {
    static constexpr bool PERM = true, AFTER_DRAIN = false, APERM = false, F16 = false, KSCALE = false;
    float* sink;
    static constexpr bool SS_PRE = false;
    __device__ __forceinline__ void operator()(const f32x4 (&acc)[2][2][4][2], const Unit& u, int wr, int wc, int fr, int fq, const unsigned (&raw)[8]) const {
        int never = 0x7ffffff; asm volatile("" : "+s"(never));
        if (u.pm == never) { f32x4 s = (f32x4){0.f, 0.f, 0.f, 0.f};
#pragma unroll
            for (int ai = 0; ai < 2; ++ai)
#pragma unroll
                for (int bj = 0; bj < 2; ++bj)
#pragma unroll
                    for (int m = 0; m < 4; ++m) s += acc[ai][bj][m][0] + acc[ai][bj][m][1];
            *(f32x4*)(sink + (wr * 4 + wc) * 256 + (fq * 16 + fr) * 4) = s; }
    }
};
#endif
struct EpiSplit2 {
    static constexpr bool PERM = true, AFTER_DRAIN = false, APERM = false, F16 = false, KSCALE = false;
    bf16_t* O0; bf16_t* O1; int ldc; const unsigned* ss;
    static constexpr bool SS_PRE = true;
    __device__ __forceinline__ void ss_load(const Unit& u, int wr, int fr, unsigned (&raw)[8]) const { ss_load_rows(ss, u.pm * BM + wr * 64 + fr, raw); }
    __device__ __forceinline__ void operator()(const f32x4 (&acc)[2][2][4][2], const Unit& u, int wr, int wc, int fr, int fq, const unsigned (&raw)[8]) const {
        const int row0 = u.pm * BM + wr * 64 + fr; int colt = u.pn * BM; bf16_t* base = O0; if (colt >= ldc) { base = O1; colt -= ldc; }
        const int col0 = colt + wc * 32 + 8 * fq;
        float rs[2][4]; rs_from_raw(ss, raw, rs);
#pragma unroll
        for (int ai = 0; ai < 2; ++ai)
#pragma unroll
            for (int m = 0; m < 4; ++m) { bf16_t* rowp = base + (size_t)(row0 + ai * HALF + m * 16) * ldc + col0;
#pragma unroll
                for (int bj = 0; bj < 2; ++bj) { const f32x4 v0 = acc[ai][bj][m][0] * rs[ai][m], v1 = acc[ai][bj][m][1] * rs[ai][m];
                    u32x4 w; w.x = cvt_pk_bf16(v0[0], v0[1]); w.y = cvt_pk_bf16(v0[2], v0[3]); w.z = cvt_pk_bf16(v1[0], v1[1]); w.w = cvt_pk_bf16(v1[2], v1[3]);
                    __builtin_nontemporal_store(w, (u32x4*)(rowp + bj * HALF)); } }
    }
};
#ifndef EPI_RES_PERM
#define EPI_RES_PERM 0
#endif
#ifndef RES_BF16
#define RES_BF16 1
#endif
__device__ __forceinline__ f32x4 b4_to_f32(u32x2 w) { f32x4 r; r[0] = __builtin_bit_cast(float, w.x << 16); r[1] = __builtin_bit_cast(float, w.x & 0xffff0000u); r[2] = __builtin_bit_cast(float, w.y << 16); r[3] = __builtin_bit_cast(float, w.y & 0xffff0000u); return r; }
__device__ __forceinline__ f32x4 h4_to_f32(u32x2 w) { f32x4 r; r[0] = h2lo(w.x); r[1] = h2hi(w.x); r[2] = h2lo(w.y); r[3] = h2hi(w.y); return r; }
typedef float float2_t __attribute__((ext_vector_type(2)));
template <bool KS_> struct EpiResT {
    static constexpr bool PERM = true, AFTER_DRAIN = false, APERM = false, F16 = false, KSCALE = KS_;
    const float* base; bf16_t* xh; bf16_t* xb; unsigned* ssq; int ldc; const float* ssh; PG8_LAS unsigned char* rl; int ldx = 2048;
    static constexpr bool SS_PRE = false;
    __device__ __forceinline__ void unit_ratios(const Unit& u, int tid) const {
        const int row = tid >> 1, hp = tid & 1;
        const f32x4* p = (const f32x4*)(ssh + ((size_t)(u.pm * BM + row) * 4 + 2 * hp) * 24);
        f32x4 v[12];
#pragma unroll
        for (int i = 0; i < 12; ++i) v[i] = p[i];
        float sa = 0.f, sb = 0.f;
#pragma unroll
        for (int i = 0; i < 6; ++i) { sa += (v[i][0] + v[i][1]) + (v[i][2] + v[i][3]); sb += (v[6 + i][0] + v[6 + i][1]) + (v[6 + i][2] + v[6 + i][3]); }
        sa = __builtin_amdgcn_rsqf(sa * (1.0f / 384.0f) + 1e-6f); sb = __builtin_amdgcn_rsqf(sb * (1.0f / 384.0f) + 1e-6f);
        const float pa = __builtin_bit_cast(float, __builtin_amdgcn_update_dpp(0, __builtin_bit_cast(int, sa), 0xB1, 0xf, 0xf, true));
        const float r0 = sa * __builtin_amdgcn_rcpf(sb), r1 = hp ? sb : sb * __builtin_amdgcn_rcpf(pa);
        *(PG8_LAS float2_t*)(rl + (row * 4 + 2 * hp) * 4) = (float2_t){r0, r1};
    }
    __device__ __forceinline__ void kscale(f32x4 (&acc)[2][2][4][2], int idx, int wr, int fr) const {
#pragma unroll
        for (int ai = 0; ai < 2; ++ai)
#pragma unroll
            for (int m = 0; m < 4; ++m) { const float r = *(const PG8_LAS float*)(rl + ((ai * HALF + wr * 64 + m * 16 + fr) * 4 + idx) * 4);
#pragma unroll
                for (int bj = 0; bj < 2; ++bj) { acc[ai][bj][m][0] *= r; acc[ai][bj][m][1] *= r; } }
    }
    __device__ __forceinline__ void operator()(const f32x4 (&acc)[2][2][4][2], const Unit& u, int wr, int wc, int fr, int fq, const unsigned (&)[8]) const {
        const int row0 = u.pm * BM + wr * 64 + fr, col0 = u.pn * BM + wc * 32 + 8 * fq;
        if (base == nullptr) {
            u32x4 raw[2][4][2];
#pragma unroll
            for (int ai = 0; ai < 2; ++ai)
#pragma unroll
                for (int m = 0; m < 4; ++m) { const size_t off = (size_t)(row0 + ai * HALF + m * 16) * ldc + col0;
#pragma unroll
                    for (int bj = 0; bj < 2; ++bj) raw[ai][m][bj] = *(const u32x4*)((RES_BF16 ? xb : xh) + off + bj * HALF); }
#if EPI_RES_PERM
            PG8_STORE_PERM;
            const int srow0 = u.pm * BM + wr * 64 + pr, scol0 = u.pn * BM + wc * 32 + 8 * pq;
#else
            const int srow0 = row0, scol0 = col0;
#define bperm4(a, w) (w)
#endif
#pragma unroll
            for (int ai = 0; ai < 2; ++ai) {
#pragma unroll
                for (int m = 0; m < 4; ++m) { const size_t soff = (size_t)(srow0 + ai * HALF + m * 16) * ldc + scol0; float s = 0.f;
#pragma unroll
                    for (int bj = 0; bj < 2; ++bj) { const u32x4 r = raw[ai][m][bj];
                        const f32x4 v0 = (RES_BF16 ? b4_to_f32((u32x2){r.x, r.y}) : h4_to_f32((u32x2){r.x, r.y})) + acc[ai][bj][m][0], v1 = (RES_BF16 ? b4_to_f32((u32x2){r.z, r.w}) : h4_to_f32((u32x2){r.z, r.w})) + acc[ai][bj][m][1];
                        if (!RES_BF16) { u32x4 w; w.x = pkh2(v0[0], v0[1]); w.y = pkh2(v0[2], v0[3]); w.z = pkh2(v1[0], v1[1]); w.w = pkh2(v1[2], v1[3]); *(u32x4*)(xh + soff + bj * HALF) = bperm4(bpa, w); }
                        if (xb) { u32x4 wb; wb.x = cvt_pk_bf16(v0[0], v0[1]); wb.y = cvt_pk_bf16(v0[2], v0[3]); wb.z = cvt_pk_bf16(v1[0], v1[1]); wb.w = cvt_pk_bf16(v1[2], v1[3]); *(u32x4*)(xb + soff + bj * HALF) = bperm4(bpa, wb); }
                        s += ((v0[0] * v0[0] + v0[1] * v0[1]) + (v0[2] * v0[2] + v0[3] * v0[3])) + ((v1[0] * v1[0] + v1[1] * v1[1]) + (v1[2] * v1[2] + v1[3] * v1[3])); }
                    if (ssq) { s = sum_fq(s);
                    if (fq == 0) atomicAdd(ssq + row0 + ai * HALF + m * 16, (unsigned)(s * SS_SCALE + 0.5f)); } } }
#if !EPI_RES_PERM
#undef bperm4
#endif
            return;
        }
#pragma unroll
        for (int ai = 0; ai < 2; ++ai) {
            f32x4 b[4][2][2];
#pragma unroll
            for (int m = 0; m < 4; ++m) { const size_t off = (size_t)(row0 + ai * HALF + m * 16) * ldc + col0;
#pragma unroll
                for (int bj = 0; bj < 2; ++bj)
#pragma unroll
                    for (int n = 0; n < 2; ++n) {
                        if (base == nullptr) { if (n == 0) { const u32x4 w = *(const u32x4*)(xh + off + bj * HALF); b[m][bj][0] = h4_to_f32((u32x2){w.x, w.y}); b[m][bj][1] = h4_to_f32((u32x2){w.z, w.w}); } }
                        else b[m][bj][n] = *(const f32x4*)(base + (size_t)(row0 + ai * HALF + m * 16) * ldx + col0 + bj * HALF + n * 4); } }
#pragma unroll
            for (int m = 0; m < 4; ++m) { const size_t off = (size_t)(row0 + ai * HALF + m * 16) * ldc + col0; float s = 0.f;
#pragma unroll
                for (int bj = 0; bj < 2; ++bj) { const f32x4 v0 = b[m][bj][0] + acc[ai][bj][m][0], v1 = b[m][bj][1] + acc[ai][bj][m][1];
                    if (!RES_BF16) { u32x4 w; w.x = pkh2(v0[0], v0[1]); w.y = pkh2(v0[2], v0[3]); w.z = pkh2(v1[0], v1[1]); w.w = pkh2(v1[2], v1[3]); *(u32x4*)(xh + off + bj * HALF) = w; }
                    if (xb) { u32x4 wb; wb.x = cvt_pk_bf16(v0[0], v0[1]); wb.y = cvt_pk_bf16(v0[2], v0[3]); wb.z = cvt_pk_bf16(v1[0], v1[1]); wb.w = cvt_pk_bf16(v1[2], v1[3]); *(u32x4*)(xb + off + bj * HALF) = wb; }
                    s += ((v0[0] * v0[0] + v0[1] * v0[1]) + (v0[2] * v0[2] + v0[3] * v0[3])) + ((v1[0] * v1[0] + v1[1] * v1[1]) + (v1[2] * v1[2] + v1[3] * v1[3])); }
                if (ssq) { s = sum_fq(s);
                if (fq == 0) atomicAdd(ssq + row0 + ai * HALF + m * 16, (unsigned)(s * SS_SCALE + 0.5f)); } }
            asm volatile("" ::: "memory"); }
    }
};
typedef EpiResT<false> EpiRes; typedef EpiResT<true> EpiResK;

template <int CTRL> __device__ __forceinline__ float dpp_keep(float old, float src) {
    return __builtin_bit_cast(float, __builtin_amdgcn_update_dpp(__builtin_bit_cast(int, old), __builtin_bit_cast(int, src), CTRL, 0xf, 0xf, false)); }
template <int CTRL> __device__ __forceinline__ f32x4 dpp_keep4(f32x4 old, f32x4 src) { f32x4 r; r[0] = dpp_keep<CTRL>(old[0], src[0]); r[1] = dpp_keep<CTRL>(old[1], src[1]); r[2] = dpp_keep<CTRL>(old[2], src[2]); r[3] = dpp_keep<CTRL>(old[3], src[3]); return r; }
__device__ __forceinline__ float silu_f(float x) { return x * __builtin_amdgcn_rcpf(1.0f + __builtin_amdgcn_exp2f(-1.4426950408889634f * x)); }
struct EpiConv {
    static constexpr bool PERM = true, AFTER_DRAIN = false, APERM = true, F16 = false, KSCALE = false;
    bf16_t* G; float* halo; const float* cw; const float* cb; PG8_LAS unsigned char* xch; const unsigned* ss; int ldg;
    static __device__ __forceinline__ int xidx(int blk, int rr, int bj, int wc, int fq, int n) { return ((((blk * 2 + rr) * 2 + bj) * 4 + wc) * 4 + fq) * 2 + n; }
    static constexpr bool SS_PRE = true;
    __device__ __forceinline__ void ss_load(const Unit& u, int wr, int fr, unsigned (&raw)[8]) const {
#pragma unroll
        for (int ai = 0; ai < 2; ++ai) { const u32x4 w = *(const u32x4*)(ss + u.pm * BM + wr * 64 + 4 * fr + ai * HALF); raw[ai * 4 + 0] = w.x; raw[ai * 4 + 1] = w.y; raw[ai * 4 + 2] = w.z; raw[ai * 4 + 3] = w.w; }
    }
    __device__ __forceinline__ void operator()(const f32x4 (&acc)[2][2][4][2], const Unit& u, int wr, int wc, int fr, int fq, const unsigned (&raw)[8]) const {
        constexpr int FF = 5632, N2 = 11264;
        PG8_LAS f32x4* X = (PG8_LAS f32x4*)xch;
        const int rowb = u.pm * BM + wr * 64 + 4 * fr;
        float rs[2][4];
#pragma unroll
        for (int ai = 0; ai < 2; ++ai)
#pragma unroll
            for (int m = 0; m < 4; ++m) rs[ai][m] = __builtin_amdgcn_rsqf((float)raw[ai * 4 + m] * (1.0f / (SS_SCALE * 2048.0f)) + 1e-6f);
        if (fr == 15) {
#pragma unroll
            for (int ai = 0; ai < 2; ++ai)
#pragma unroll
                for (int rr = 0; rr < 2; ++rr)
#pragma unroll
                    for (int bj = 0; bj < 2; ++bj)
#pragma unroll
                        for (int n = 0; n < 2; ++n) X[xidx(ai * 2 + wr, rr, bj, wc, fq, n)] = acc[ai][bj][2 + rr][n] * rs[ai][2 + rr];
        }
        if (wr == 0 && fr == 0) {
#pragma unroll
            for (int rr = 0; rr < 2; ++rr)
#pragma unroll
                for (int bj = 0; bj < 2; ++bj)
#pragma unroll
                    for (int n = 0; n < 2; ++n) *(f32x4*)(halo + (size_t)(u.pm * 4 + rr) * N2 + u.pn * 256 + bj * 128 + wc * 32 + 8 * fq + 4 * n) = acc[0][bj][rr][n] * rs[0][rr];
        }
        if (wr == 1 && fr == 15) {
#pragma unroll
            for (int rr = 0; rr < 2; ++rr)
#pragma unroll
                for (int bj = 0; bj < 2; ++bj)
#pragma unroll
                    for (int n = 0; n < 2; ++n) *(f32x4*)(halo + (size_t)(u.pm * 4 + 2 + rr) * N2 + u.pn * 256 + bj * 128 + wc * 32 + 8 * fq + 4 * n) = acc[1][bj][2 + rr][n] * rs[1][2 + rr];
        }
        asm volatile("s_waitcnt lgkmcnt(0)" ::: "memory"); __builtin_amdgcn_s_barrier(); asm volatile("" ::: "memory");
        u32x2 hold[2][4];
#pragma unroll
        for (int n = 0; n < 2; ++n) {
            const int c0 = u.pn * 128 + wc * 32 + 8 * fq + 4 * n;
            const f32x4 wa0 = *(const f32x4*)(cw + c0), wa1 = *(const f32x4*)(cw + N2 + c0), wa2 = *(const f32x4*)(cw + 2 * N2 + c0), ba = *(const f32x4*)(cb + c0);
            const f32x4 wv0 = *(const f32x4*)(cw + FF + c0), wv1 = *(const f32x4*)(cw + N2 + FF + c0), wv2 = *(const f32x4*)(cw + 2 * N2 + FF + c0), bv = *(const f32x4*)(cb + FF + c0);
#pragma unroll
            for (int ai = 0; ai < 2; ++ai) {
                const int blk = ai * 2 + wr;
                f32x4 xa1 = (f32x4){0.f, 0.f, 0.f, 0.f}, xa2 = xa1, xv1 = xa1, xv2 = xa1;
                if (blk > 0) { xa2 = X[xidx(blk - 1, 0, 0, wc, fq, n)]; xa1 = X[xidx(blk - 1, 1, 0, wc, fq, n)]; xv2 = X[xidx(blk - 1, 0, 1, wc, fq, n)]; xv1 = X[xidx(blk - 1, 1, 1, wc, fq, n)]; }
                f32x4 ua[4], uv[4];
#pragma unroll
                for (int m = 0; m < 4; ++m) { ua[m] = acc[ai][0][m][n] * rs[ai][m]; uv[m] = acc[ai][1][m][n] * rs[ai][m]; }
                const f32x4 sa3 = dpp_keep4<0x111>(xa1, ua[3]), sa2 = dpp_keep4<0x111>(xa2, ua[2]);
                const f32x4 sv3 = dpp_keep4<0x111>(xv1, uv[3]), sv2 = dpp_keep4<0x111>(xv2, uv[2]);
#pragma unroll
                for (int m = 0; m < 4; ++m) {
                    const f32x4 pa1 = m == 0 ? sa3 : ua[m > 0 ? m - 1 : 0], pa2 = m == 0 ? sa2 : (m == 1 ? sa3 : ua[m > 1 ? m - 2 : 0]);
                    const f32x4 pv1 = m == 0 ? sv3 : uv[m > 0 ? m - 1 : 0], pv2 = m == 0 ? sv2 : (m == 1 ? sv3 : uv[m > 1 ? m - 2 : 0]);
                    const f32x4 ya = wa0 * pa2 + wa1 * pa1 + wa2 * ua[m] + ba;
                    const f32x4 yv = wv0 * pv2 + wv1 * pv1 + wv2 * uv[m] + bv;
                    const f32x4 tq = ya * -1.4426950408889634f; f32x4 eq; eq[0] = __builtin_amdgcn_exp2f(tq[0]); eq[1] = __builtin_amdgcn_exp2f(tq[1]); eq[2] = __builtin_amdgcn_exp2f(tq[2]); eq[3] = __builtin_amdgcn_exp2f(tq[3]);
                    const f32x4 dq = eq + 1.0f; f32x4 rq; rq[0] = __builtin_amdgcn_rcpf(dq[0]); rq[1] = __builtin_amdgcn_rcpf(dq[1]); rq[2] = __builtin_amdgcn_rcpf(dq[2]); rq[3] = __builtin_amdgcn_rcpf(dq[3]);
                    const f32x4 g = (ya * rq) * yv;
                    u32x2 w; w.x = cvt_pk_bf16(g[0], g[1]); w.y = cvt_pk_bf16(g[2], g[3]);
                    if (n == 0) hold[ai][m] = w;
                    else { u32x4 o; o.x = hold[ai][m].x; o.y = hold[ai][m].y; o.z = w.x; o.w = w.y;
                        __builtin_nontemporal_store(o, (u32x4*)(G + (size_t)(rowb + ai * HALF + m) * ldg + u.pn * 128 + wc * 32 + 8 * fq)); }
                }
            }
        }
    }
};
template <class Epi, class Sched, bool ALIGN_EPI = false, bool SP2 = false>
__device__ __forceinline__ void gemm_phase(PG8_LAS unsigned char* lds, const Gemm g, const Sched& S, const Epi& E, const int wave_in) {
    const int tid = opaque_tid(wave_in), wid = wave_in, lane = tid & 63, wr = wid >> 2, wc = wid & 3, fr = lane & 15, fq = lane >> 4;
    const int K = g.K, nt = K / BK;
    const int lda = g.lda ? g.lda : K;
    unsigned voffA[2], voffB[2];
#pragma unroll
    for (int i = 0; i < 2; ++i) { int R, C; stage_rc(tid * 16 + i * 8192, R, C); const int Rb = Epi::PERM ? ((R & ~31) + perm32(R & 31)) : R;
        const int Ra = Epi::APERM ? ((R & ~63) + 4 * (R & 15) + ((R >> 4) & 3)) : R;
        voffA[i] = (unsigned)(Ra * lda + C) * 2u; voffB[i] = (unsigned)(Rb * K + C) * 2u; }
    const size_t kstep = (size_t)(BK * 2);
    const size_t hstepA = (size_t)HALF * lda * 2, hstepB = (size_t)HALF * K * 2;
    const size_t tstepA = 2 * hstepA, tstepB = 2 * hstepB;
    const unsigned ldsw = (unsigned)wid * 1024u;
    const int aoff = lds_byte(wr * 64 + fr, fq * 8), boff = lds_byte(wc * 32 + fr, fq * 8);
#define PG8_SA(b, h) (((b) * 2 + (h)) * HTB)
#define PG8_SB(b, h) ((4 + (b) * 2 + (h)) * HTB)
#define PG8_STAGE(bufoff, gbase, voff) do { _Pragma("unroll") for (int _i = 0; _i < 2; ++_i) \
        __builtin_amdgcn_global_load_lds((const unsigned*)((const char*)(gbase) + (voff)[_i]), (PG8_LAS unsigned*)(lds + (bufoff) + ldsw + _i * 8192), 16, 0, 0); } while (0)
#define PG8_LDA(dst, b, h) do { _Pragma("unroll") for (int m = 0; m < 4; ++m) _Pragma("unroll") for (int k = 0; k < 2; ++k) dst[m][k] = *(const PG8_LAS bf16x8*)(lds + PG8_SA(b, h) + aoff + m * 2048 + k * 1024); } while (0)
#define PG8_LDB(dst, b, h) do { _Pragma("unroll") for (int n = 0; n < 2; ++n) _Pragma("unroll") for (int k = 0; k < 2; ++k) dst[n][k] = *(const PG8_LAS bf16x8*)(lds + PG8_SB(b, h) + boff + n * 2048 + k * 1024); } while (0)
#define PG8_MMA(ai, bj, At, Bt) do { __builtin_amdgcn_s_setprio(1); _Pragma("unroll") for (int m = 0; m < 4; ++m) _Pragma("unroll") for (int n = 0; n < 2; ++n) _Pragma("unroll") for (int k = 0; k < 2; ++k) \
        acc[ai][bj][m][n] = mfma16<Epi::F16>(Bt[n][k], At[m][k], acc[ai][bj][m][n]); __builtin_amdgcn_s_setprio(0); } while (0)
#define PG8_WAIT_V(n) asm volatile("s_waitcnt vmcnt(" #n ")" ::: "memory")
#define PG8_WAIT_L(n) asm volatile("s_waitcnt lgkmcnt(" #n ")" ::: "memory")
#define PG8_BAR __builtin_amdgcn_s_barrier()
#define PG8_SCHED __builtin_amdgcn_sched_barrier(0)
    Unit cur, nxt; int ui = 0;
    if (!S.next(0, cur)) return;
    f32x4 acc[2][2][4][2];
#pragma unroll
    for (int a = 0; a < 2; ++a)
#pragma unroll
        for (int b = 0; b < 2; ++b)
#pragma unroll
            for (int m = 0; m < 4; ++m)
#pragma unroll
                for (int n = 0; n < 2; ++n) acc[a][b][m][n] = (f32x4){0.f, 0.f, 0.f, 0.f};
    bf16x8 At[4][2], B0[2][2], B1[2][2];
    const char* cA = (const char*)g.A + (size_t)cur.pm * tstepA; const char* cB = (const char*)g.Bt + (size_t)cur.pn * tstepB;
    unsigned ssraw[8] = {0u, 0u, 0u, 0u, 0u, 0u, 0u, 0u};
    if constexpr (Epi::KSCALE) E.unit_ratios(cur, tid);
    if constexpr (Epi::SS_PRE) E.ss_load(cur, wr, fr, ssraw);
    S.a_ready(cur);
    if constexpr (SP2) {
        PG8_STAGE(PG8_SB(0, 0), cB, voffB); PG8_STAGE(PG8_SB(0, 1), cB + hstepB, voffB); PG8_STAGE(PG8_SA(0, 0), cA, voffA); PG8_STAGE(PG8_SA(0, 1), cA + hstepA, voffA);
        if (wr == 1) PG8_BAR;
        PG8_WAIT_V(2); PG8_BAR;
        PG8_STAGE(PG8_SB(1, 0), cB + kstep, voffB); PG8_STAGE(PG8_SA(1, 0), cA + kstep, voffA); PG8_STAGE(PG8_SB(1, 1), cB + hstepB + kstep, voffB);
        PG8_WAIT_V(6); PG8_BAR;
    } else {
        PG8_STAGE(PG8_SB(0, 0), cB, voffB); PG8_STAGE(PG8_SA(0, 0), cA, voffA); PG8_STAGE(PG8_SB(0, 1), cB + hstepB, voffB); PG8_STAGE(PG8_SA(0, 1), cA + hstepA, voffA);
        if (wr == 1) PG8_BAR;
        PG8_WAIT_V(4); PG8_BAR;
        PG8_STAGE(PG8_SB(1, 0), cB + kstep, voffB); PG8_STAGE(PG8_SA(1, 0), cA + kstep, voffA); PG8_STAGE(PG8_SB(1, 1), cB + hstepB + kstep, voffB);
        PG8_WAIT_V(6); PG8_BAR;
    }
    for (;;) {
        const bool has_next = S.next(ui + 1, nxt);
        const char* nA = has_next ? (const char*)g.A + (size_t)nxt.pm * tstepA : cA; const char* nB = has_next ? (const char*)g.Bt + (size_t)nxt.pn * tstepB : cB;
        for (int t = 0; t < nt; t += 2) {
            const bool last = (t == nt - 2);
            const char* a1 = cA + (size_t)(t + 1) * kstep;
            const char* a2 = last ? nA : cA + (size_t)(t + 2) * kstep; const char* b2 = last ? nB : cB + (size_t)(t + 2) * kstep;
            const char* a3 = a2 + kstep; const char* b3 = b2 + kstep;
            if (last && has_next) S.a_ready(nxt);
            if constexpr (Epi::KSCALE) { if (t == 6 || t == 12 || t == 18 || t == 24) E.kscale(acc, t / 6 - 1, wr, fr); }
            if constexpr (SP2) {
            PG8_LDB(B0, 0, 0); PG8_LDB(B1, 0, 1); PG8_SCHED; PG8_LDA(At, 0, 0); PG8_STAGE(PG8_SA(1, 1), a1 + hstepA, voffA);
            PG8_WAIT_V(8); PG8_WAIT_L(0); PG8_BAR; PG8_MMA(0, 0, At, B0); PG8_MMA(0, 1, At, B1); PG8_BAR; PG8_SCHED;
            PG8_LDA(At, 0, 1); PG8_STAGE(PG8_SB(0, 0), b2, voffB); PG8_STAGE(PG8_SB(0, 1), b2 + hstepB, voffB); PG8_STAGE(PG8_SA(0, 0), a2, voffA);
            PG8_WAIT_V(8); PG8_WAIT_L(0); PG8_BAR; PG8_MMA(1, 0, At, B0); PG8_MMA(1, 1, At, B1); PG8_BAR; PG8_SCHED;
            PG8_LDB(B0, 1, 0); PG8_LDB(B1, 1, 1); PG8_SCHED; PG8_LDA(At, 1, 0); PG8_STAGE(PG8_SA(0, 1), a2 + hstepA, voffA);
            PG8_WAIT_V(8); PG8_WAIT_L(0); PG8_BAR; PG8_MMA(0, 0, At, B0); PG8_MMA(0, 1, At, B1); PG8_BAR; PG8_SCHED;
            PG8_LDA(At, 1, 1); PG8_STAGE(PG8_SB(1, 0), b3, voffB); PG8_STAGE(PG8_SB(1, 1), b3 + hstepB, voffB); PG8_STAGE(PG8_SA(1, 0), a3, voffA);
            PG8_WAIT_V(8); PG8_WAIT_L(0); PG8_BAR; PG8_MMA(1, 0, At, B0); PG8_MMA(1, 1, At, B1); PG8_BAR; PG8_SCHED;
            } else {
            PG8_LDB(B0, 0, 0); PG8_SCHED; PG8_LDA(At, 0, 0); PG8_STAGE(PG8_SA(1, 1), a1 + hstepA, voffA);
            PG8_WAIT_L(8); PG8_BAR; PG8_WAIT_L(0); PG8_MMA(0, 0, At, B0); PG8_BAR; PG8_SCHED;
            PG8_LDB(B1, 0, 1); PG8_STAGE(PG8_SB(0, 0), b2, voffB);
            PG8_BAR; PG8_WAIT_L(0); PG8_MMA(0, 1, At, B1); PG8_BAR;
            PG8_LDA(At, 0, 1); PG8_STAGE(PG8_SA(0, 0), a2, voffA);
            PG8_BAR; PG8_WAIT_L(0); PG8_MMA(1, 0, At, B0); PG8_BAR; PG8_SCHED;
            PG8_STAGE(PG8_SB(0, 1), b2 + hstepB, voffB);
            PG8_WAIT_V(6); PG8_BAR; PG8_MMA(1, 1, At, B1); PG8_BAR;
            PG8_LDB(B0, 1, 0); PG8_SCHED; PG8_LDA(At, 1, 0); PG8_STAGE(PG8_SA(0, 1), a2 + hstepA, voffA);
            PG8_WAIT_L(8); PG8_BAR; PG8_WAIT_L(0); PG8_MMA(0, 0, At, B0); PG8_BAR; PG8_SCHED;
            PG8_LDB(B1, 1, 1); PG8_STAGE(PG8_SB(1, 0), b3, voffB);
            PG8_BAR; PG8_WAIT_L(0); PG8_MMA(0, 1, At, B1); PG8_BAR;
            PG8_LDA(At, 1, 1); PG8_STAGE(PG8_SA(1, 0), a3, voffA);
            PG8_BAR; PG8_WAIT_L(0); PG8_MMA(1, 0, At, B0); PG8_BAR; PG8_SCHED;
            PG8_STAGE(PG8_SB(1, 1), b3 + hstepB, voffB);
            PG8_WAIT_V(6); PG8_BAR; PG8_MMA(1, 1, At, B1); PG8_BAR;
            }
        }
        if constexpr (ALIGN_EPI) { if (wr == 0) PG8_BAR; }
        if constexpr (!Epi::AFTER_DRAIN) { E(acc, cur, wr, wc, fr, fq, ssraw); S.done(cur); if constexpr (Epi::SS_PRE) { if (has_next) E.ss_load(nxt, wr, fr, ssraw); }
            if constexpr (Epi::KSCALE) { if (has_next) E.unit_ratios(nxt, tid); } }
        if (!has_next) break;
#pragma unroll
        for (int a = 0; a < 2; ++a)
#pragma unroll
            for (int b = 0; b < 2; ++b)
#pragma unroll
                for (int m = 0; m < 4; ++m)
#pragma unroll
                    for (int n = 0; n < 2; ++n) acc[a][b][m][n] = (f32x4){0.f, 0.f, 0.f, 0.f};
        cur = nxt; cA = nA; cB = nB; ++ui;
        if constexpr (ALIGN_EPI) { if (wr == 1) PG8_BAR; }
    }
    PG8_WAIT_V(0);
    if constexpr (!ALIGN_EPI) { if (wr == 0) PG8_BAR; }
    PG8_BAR;
    if constexpr (Epi::AFTER_DRAIN) { E.fused(acc, cur, wr, wc, fr, fq, lds, wid, lane); S.done(cur); }
#undef PG8_SA
#undef PG8_SB
#undef PG8_STAGE
#undef PG8_LDA
#undef PG8_LDB
#undef PG8_MMA
#undef PG8_WAIT_V
#undef PG8_WAIT_L
#undef PG8_BAR
#undef PG8_SCHED
}
}
namespace att {
typedef unsigned short bf16;
typedef short bf16x8 __attribute__((ext_vector_type(8)));
typedef short s16x4 __attribute__((ext_vector_type(4)));
typedef float f32x16 __attribute__((ext_vector_type(16)));
typedef float f32x4 __attribute__((ext_vector_type(4)));
typedef unsigned u32x4 __attribute__((ext_vector_type(4)));
#define LASP __attribute__((address_space(3)))
constexpr int D = 128;
constexpr float SCALE = 0.08838834764831845f, INV_SCALE = 11.313708498984761f;
constexpr float THR = 8.f;
constexpr int NW = 8, QBLK = 32, KVBLK = 64, QB = NW * QBLK;
constexpr int SHM_V = KVBLK * D * 2, SHM_K = KVBLK * D * 2;
constexpr int BIAS_OFF = 2 * SHM_V + 2 * SHM_K + NW * 64 * 4;
constexpr int LDS_BYTES = BIAS_OFF + 2 * 64 * 4;
constexpr int WBIG = 1 << 30;

#define KSWZ(row, colB) ((row) * 256 + ((colB) ^ (((row) & 7) << 4)))
#define SBAR() __builtin_amdgcn_sched_barrier(0)
__device__ __forceinline__ int v_st(int k, int c) { const int kk = (k & ~0xC) | ((k & 4) << 1) | ((k & 8) >> 1); return ((kk >> 3) * 4 + (c >> 5)) * 512 + ((kk & 7) * 32 + (c & 31)) * 2; }
__device__ __forceinline__ int v_rd_base(int lane) { return ((lane & 3) << 3) | (((lane >> 2) & 3) << 6) | (((lane >> 4) & 1) << 5) | (((lane >> 5) & 1) << 8); }
constexpr int v_rd_off(int d0, int ks, int half) { return d0 * 512 + ks * 4096 + half * 2048; }
__device__ __forceinline__ int crow(int r, int hi) { return (r & 3) + 8 * (r >> 2) + 4 * hi; }
__device__ __forceinline__ unsigned cvtpk(float lo, float hi) { unsigned r; asm volatile("v_cvt_pk_bf16_f32 %0, %1, %2" : "=v"(r) : "v"(lo), "v"(hi)); return r; }
__device__ __forceinline__ bf16x8 load8(const bf16* p) { return *reinterpret_cast<const bf16x8*>(p); }
__device__ __forceinline__ void mask_tile(f32x16& p0, f32x16& p1, int dq, unsigned W) {
    const float NEG = -__builtin_inff();
#pragma unroll
    for (int r = 0; r < 16; ++r) {
        const int c = (r & 3) + 8 * (r >> 2);
        if ((unsigned)(dq - c) >= W) p0[r] = NEG;
        if ((unsigned)(dq - c - 32) >= W) p1[r] = NEG;
    }
}
__device__ __forceinline__ void partialSM(f32x16& p0, f32x16& p1, float& m_reg, float& mn, float& alpha) {
    float pmax = p0[0]; for (int r = 1; r < 16; ++r) pmax = fmaxf(pmax, p0[r]); for (int r = 0; r < 16; ++r) pmax = fmaxf(pmax, p1[r]);
    { auto rr = __builtin_amdgcn_permlane32_swap(__float_as_uint(pmax), __float_as_uint(pmax), false, false);
      pmax = fmaxf(__uint_as_float(rr[0]), __uint_as_float(rr[1])); }
    constexpr float C2 = 1.4426950408889634f * SCALE;
    if (__builtin_expect(__all((pmax - m_reg) * SCALE <= THR), 1)) { mn = m_reg; alpha = 1.f; }
    else { mn = fmaxf(m_reg, pmax); alpha = __builtin_amdgcn_exp2f((m_reg - mn) * C2); m_reg = mn; }
    const float mnL = -mn * C2;
    for (int r = 0; r < 16; ++r) p0[r] = fmaf(p0[r], C2, mnL); for (int r = 0; r < 16; ++r) p1[r] = fmaf(p1[r], C2, mnL);
    for (int r = 0; r < 16; ++r) p0[r] = __builtin_amdgcn_exp2f(p0[r]);
}
__device__ __forceinline__ void finishSM(f32x16& p0, f32x16& p1, float alpha, float& l_reg, bf16x8& pa0, bf16x8& pa1, bf16x8& pa2, bf16x8& pa3) {
    for (int r = 0; r < 16; ++r) p1[r] = __builtin_amdgcn_exp2f(p1[r]);
    float ps = 0; for (int r = 0; r < 16; ++r) ps += p0[r]; for (int r = 0; r < 16; ++r) ps += p1[r];
    { auto rr = __builtin_amdgcn_permlane32_swap(__float_as_uint(ps), __float_as_uint(ps), false, false);
      ps = __uint_as_float(rr[0]) + __uint_as_float(rr[1]); }
    l_reg = l_reg * alpha + ps;
#define PK4(P, B_, OUT) do { unsigned a0 = cvtpk(P[B_+0], P[B_+1]), a1 = cvtpk(P[B_+2], P[B_+3]);                          \
        unsigned b0 = cvtpk(P[B_+4], P[B_+5]), b1 = cvtpk(P[B_+6], P[B_+7]);                                             \
        auto r0 = __builtin_amdgcn_permlane32_swap(a0, b0, false, false); auto r1 = __builtin_amdgcn_permlane32_swap(a1, b1, false, false); \
        u32x4 w = {r0[0], r1[0], r0[1], r1[1]}; OUT = *reinterpret_cast<bf16x8*>(&w); } while (0)
    PK4(p0, 0, pa0); PK4(p0, 8, pa1); PK4(p1, 0, pa2); PK4(p1, 8, pa3);
#undef PK4
}
template <int KB>
__device__ __forceinline__ void qkt(f32x16& p0, f32x16& p1, const char* K_lds, const char* B_lds, int r32, int hi, const bf16x8* qr) {
    p0 = *reinterpret_cast<const f32x16*>(B_lds + KB * 256 + hi * 64); p1 = *reinterpret_cast<const f32x16*>(B_lds + KB * 256 + 128 + hi * 64);
    const char* kb[4];
#pragma unroll
    for (int dd = 0; dd < 4; ++dd) kb[dd] = K_lds + KB * SHM_K + KSWZ(r32, (dd * 16 + hi * 8) * 2);
#pragma unroll
    for (int d0 = 0; d0 < 8; ++d0) { const char* a = kb[d0 & 3] + (d0 >> 2) * 128;
        bf16x8 b0 = *reinterpret_cast<const bf16x8*>(a);
        bf16x8 b1 = *reinterpret_cast<const bf16x8*>(a + 32 * 256);
        p0 = __builtin_amdgcn_mfma_f32_32x32x16_bf16(b0, qr[d0], p0, 0, 0, 0);
        p1 = __builtin_amdgcn_mfma_f32_32x32x16_bf16(b1, qr[d0], p1, 0, 0, 0); }
}
template <int VB>
__device__ __forceinline__ void pv_tile(f32x16* o, int vb0, bf16x8 pa0, bf16x8 pa1, bf16x8 pa2, bf16x8 pa3) {
#define TRRD(dst, off) asm volatile("ds_read_b64_tr_b16 %0, %1 offset:%2" : "=&v"(dst) : "v"(vb0), "i"(off) : "memory")
#define PV_D0(d0) do { s16x4 l0, l1, l2, l3, h0, h1, h2, h3; constexpr int b_ = VB * SHM_V + v_rd_off(d0, 0, 0);   \
        TRRD(l0, b_); TRRD(h0, b_ + 2048); TRRD(l1, b_ + 4096); TRRD(h1, b_ + 6144); TRRD(l2, b_ + 8192); TRRD(h2, b_ + 10240); TRRD(l3, b_ + 12288); TRRD(h3, b_ + 14336); \
        asm volatile("s_waitcnt lgkmcnt(0)" ::: "memory"); SBAR();   \
        o[d0] = __builtin_amdgcn_mfma_f32_32x32x16_bf16(pa0, (bf16x8){l0[0], l0[1], l0[2], l0[3], h0[0], h0[1], h0[2], h0[3]}, o[d0], 0, 0, 0);   \
        o[d0] = __builtin_amdgcn_mfma_f32_32x32x16_bf16(pa1, (bf16x8){l1[0], l1[1], l1[2], l1[3], h1[0], h1[1], h1[2], h1[3]}, o[d0], 0, 0, 0);   \
        o[d0] = __builtin_amdgcn_mfma_f32_32x32x16_bf16(pa2, (bf16x8){l2[0], l2[1], l2[2], l2[3], h2[0], h2[1], h2[2], h2[3]}, o[d0], 0, 0, 0);   \
        o[d0] = __builtin_amdgcn_mfma_f32_32x32x16_bf16(pa3, (bf16x8){l3[0], l3[1], l3[2], l3[3], h3[0], h3[1], h3[2], h3[3]}, o[d0], 0, 0, 0); } while (0)
    PV_D0(0); PV_D0(1); PV_D0(2); PV_D0(3);
#undef PV_D0
#undef TRRD
}
struct BlockRef { const bf16* Q; const bf16* K; const bf16* V; bf16* O; const float* cb; int qs, kvs, os, P0, skv, jlo; };
struct Seam { bf16x8 qr[8]; bf16x8 st_v0, st_v1, st_k0, st_k1; };
#define ROW(p, k0, rr, st) ((p) + (int)((k0) * (st)) + (int)((rr) * (st) + sc))
#define VMW() asm volatile("s_waitcnt vmcnt(0)" ::: "memory")
#define VMWN(n) asm volatile("s_waitcnt vmcnt(%0)" :: "i"(n) : "memory")
#define SLOAD_H(B_, k0, bf) do { S.st_v0 = load8(ROW((B_).V, k0, sr, (B_).kvs)); S.st_v1 = load8(ROW((B_).V, k0, 32 + sr, (B_).kvs));              \
                         S.st_k0 = load8(ROW((B_).K, k0, sr, (B_).kvs)); S.st_k1 = load8(ROW((B_).K, k0, 32 + sr, (B_).kvs));                \
                         if (wid == 0) __builtin_amdgcn_global_load_lds((const unsigned*)((B_).cb + (k0) + bias_key(lane)), (LASP unsigned*)(B_lds + (bf) * 256), 4, 0, 0); } while (0)
#define SWRITE_HK(bf, cref_) do { *(bf16x8*)(K_lds + (bf) * SHM_K + kws) = S.st_k0; *(bf16x8*)(K_lds + (bf) * SHM_K + kws + 32 * 256) = S.st_k1; } while (0)
#define SWRITE_HV(bf) do { *(bf16x8*)(V_lds + (bf) * SHM_V + vst0) = S.st_v0; *(bf16x8*)(V_lds + (bf) * SHM_V + vst1) = S.st_v1; } while (0)
#define SWRITE_H(bf, cref_) do { SWRITE_HV(bf); SWRITE_HK(bf, cref_); } while (0)
__device__ __forceinline__ int bias_key(int L) { const int p = L >> 5, hi = (L >> 4) & 1, r = L & 15; return 32 * p + (r & 3) + 8 * (r >> 2) + 4 * hi; }
__device__ __forceinline__ void attn_prime(const BlockRef& cur, char* lds, Seam& S, const int wave_in) {
    const int tid = opaque_tid(wave_in), wid = wave_in, lane = tid & 63, r32 = lane & 31, hi = lane >> 5;
    const int sr = tid >> 4, sc = (tid & 15) * 8, kws = KSWZ(sr, sc * 2); char* K_lds = lds + 2 * SHM_V; char* B_lds = lds + BIAS_OFF;
    for (int d0 = 0; d0 < 8; ++d0) S.qr[d0] = load8(cur.Q + (int)((wid * QBLK + r32) * cur.qs + hi * 8) + d0 * 16);
    SLOAD_H(cur, cur.jlo * KVBLK, 0); VMW(); SWRITE_HK(0, 0);
    __syncthreads();
}
__device__ __forceinline__ void attn_block(const BlockRef& cur, const BlockRef& nxt, char* lds, Seam& S, const int wave_in) {
    const int tid = opaque_tid(wave_in), wid = wave_in, lane = tid & 63, r32 = lane & 31, hi = lane >> 5;
    constexpr int W = WBIG;
    int j_hi = (cur.P0 + QB - 1) / KVBLK + 1; if (j_hi > cur.skv / KVBLK) j_hi = cur.skv / KVBLK;
    const int j_lo = cur.jlo; const int NT = j_hi - j_lo;
    const int qlo = cur.P0 + wid * QBLK, qm = qlo + r32 - 4 * hi;
    char* V_lds = lds; char* K_lds = lds + 2 * SHM_V; char* B_lds = lds + BIAS_OFF;
    float* ws = (float*)(lds + 2 * SHM_V + 2 * SHM_K) + wid * 64; float* li_l = ws, * al_l = ws + 32;
    float m_reg = -1e30f, l_reg = 0; f32x16 o[4] = {};
    const int sr = tid >> 4, sc = (tid & 15) * 8, vst0 = v_st(sr, sc), vst1 = v_st(32 + sr, sc), kws = KSWZ(sr, sc * 2);
    const int vb0 = (int)(uintptr_t)V_lds + v_rd_base(lane);
#define RESC(a) do { if (__any((a) < 1.f)) { if (hi == 0) al_l[r32] = (a); asm volatile("s_waitcnt lgkmcnt(0)" ::: "memory");              \
                     for (int d_ = 0; d_ < 4; ++d_) for (int r = 0; r < 16; ++r) o[d_][r] *= al_l[crow(r, hi)]; } } while (0)
#define KBASE(t) ((j_lo + (t)) * KVBLK)
#define MASKT(P0_, P1_, t) do { const int kb_ = KBASE(t); if (kb_ + KVBLK - 1 > qlo) mask_tile(P0_, P1_, qm - kb_, (unsigned)W); } while (0)
    constexpr int NQL = 8;
#define SEAM_K0() do { VMWN(NQL); SWRITE_HK(0, 0); SBAR(); } while (0)
    f32x16 pA0, pA1, pB0, pB1; float mnA, mnB, alA, alB; bf16x8 pa0, pa1, pa2, pa3;
    SWRITE_HV(0); SBAR();
    if (NT > 1) { SLOAD_H(cur, KBASE(1), 1); }
    SBAR(); qkt<0>(pA0, pA1, K_lds, B_lds, r32, hi, S.qr);
    MASKT(pA0, pA1, 0); partialSM(pA0, pA1, m_reg, mnA, alA);
    if (NT > 1) { VMW(); SWRITE_H(1, 0); }
    __syncthreads();
#define HALF_STEP(PX0, PX1, mnX, alX, PY0, PY1, alY, t, KB, VB, SB) do {                                                      \
        SBAR(); qkt<KB>(PX0, PX1, K_lds, B_lds, r32, hi, S.qr);                                                               \
        finishSM(PY0, PY1, alY, l_reg, pa0, pa1, pa2, pa3); SBAR();                                                           \
        if ((t) + 1 < NT) { SLOAD_H(cur, KBASE((t) + 1), SB); SBAR(); }                                                           \
        pv_tile<VB>(o, vb0, pa0, pa1, pa2, pa3); MASKT(PX0, PX1, (t)); partialSM(PX0, PX1, m_reg, mnX, alX);                  \
        __syncthreads();                                                                                                      \
        if ((t) + 1 < NT) { VMW(); SWRITE_H(SB, 0); }                                                                      \
        RESC(alX); __syncthreads(); } while (0)
    for (int t = 1; t + 1 < NT; t += 2) {
        HALF_STEP(pB0, pB1, mnB, alB, pA0, pA1, alA, t, 1, 0, 0);
        HALF_STEP(pA0, pA1, mnA, alA, pB0, pB1, alB, t + 1, 0, 1, 1);
    }
    const bool even = (NT & 1) == 0;
    if (even) { SBAR(); qkt<1>(pB0, pB1, K_lds, B_lds, r32, hi, S.qr); SBAR(); }
    SLOAD_H(nxt, nxt.jlo * KVBLK, 0); SBAR();
#pragma unroll
    for (int d0 = 0; d0 < 8; ++d0) S.qr[d0] = load8(nxt.Q + (int)((wid * QBLK + r32) * nxt.qs + hi * 8) + d0 * 16);
    SBAR();
    finishSM(pA0, pA1, alA, l_reg, pa0, pa1, pa2, pa3); SBAR();
    pv_tile<0>(o, vb0, pa0, pa1, pa2, pa3);
    if (even) { MASKT(pB0, pB1, NT - 1); partialSM(pB0, pB1, m_reg, mnB, alB); __syncthreads(); RESC(alB);
        finishSM(pB0, pB1, alB, l_reg, pa0, pa1, pa2, pa3); SBAR(); pv_tile<1>(o, vb0, pa0, pa1, pa2, pa3); }
    SBAR(); SEAM_K0();
    if (hi == 0) li_l[r32] = l_reg; asm volatile("s_waitcnt lgkmcnt(0)" ::: "memory");
    bf16* Ow = cur.O + (int)(wid * QBLK * cur.os); const int ooff = 4 * hi * cur.os + r32;
#pragma unroll
    for (int r = 0; r < 16; ++r) { const int orc = (r & 3) + 8 * (r >> 2);
        const float rl = __builtin_amdgcn_rcpf(li_l[orc + 4 * hi]);
#pragma unroll
        for (int d0 = 0; d0 < 4; ++d0) { const float v = o[d0][r] * rl;
            const float vn = __builtin_bit_cast(float, __builtin_amdgcn_update_dpp(0, __builtin_bit_cast(int, v), 0xB1, 0xf, 0xf, false));
            if ((r32 & 1) == 0) *(unsigned*)(Ow + (orc * cur.os + d0 * 32) + ooff) = cvtpk(v, vn); } }
    __syncthreads();
#undef RESC
#undef KBASE
#undef MASKT
#undef SEAM_K0
#undef HALF_STEP
}
#undef ROW
#undef VMW
#undef VMWN
#undef SLOAD_H
#undef SWRITE_HK
#undef SWRITE_HV
#undef SWRITE_H
#undef KSWZ
#undef SBAR
}
constexpr int NWAVES = 8, NTHREADS = 512;
constexpr int DM = 2048, BATCH = 8, SEQ = 4096, MTOK = BATCH * SEQ, NMEM = 256, MMEM = BATCH * NMEM;
constexpr int GLA_H = 4, GLA_DK = 256, GLA_DV = 384, GLA_QK = 1024, GLA_V = 1536, GLA_IN_SRC = 5648, GLA_IN = 5632;
constexpr int FOX_H = 12, FOX_W = 1536, FOX_KV_SRC = 3084, MEM_H = 4, MEM_W = 512;
constexpr int FFH = 5632, FF2 = 11264, FFP = FFH + 64;
constexpr int ZQ = 0, ZK = 1024, ZV = 2048, ZOG = 3584, ZMQ = 5120;
constexpr float EPS = 1e-6f;
constexpr size_t al256(size_t x) { return (x + 255) & ~(size_t)255; }
constexpr size_t WS_CTL = 0, CTL_BYTES = 1u << 20;
constexpr size_t WS_SS    = WS_CTL + CTL_BYTES;
constexpr size_t WS_WMEM  = WS_SS + (size_t)10 * MTOK * 4;
constexpr size_t WS_WGIN  = WS_WMEM  + (size_t)4 * 1024 * DM * 2;
constexpr size_t WS_WGLR  = WS_WGIN  + (size_t)2 * GLA_IN * DM * 2;
constexpr size_t WS_WGOUT = WS_WGLR  + (size_t)2 * 16 * DM * 2;
constexpr size_t WS_WFKV  = WS_WGOUT + (size_t)2 * DM * DM * 2;
constexpr size_t WS_WFL   = WS_WFKV  + (size_t)3072 * DM * 2;
constexpr size_t WS_WFIN  = WS_WFL   + (size_t)16 * DM * 2;
constexpr size_t WS_WFOUT = WS_WFIN  + (size_t)2 * DM * DM * 2;
constexpr size_t WS_WUP   = WS_WFOUT + (size_t)2 * DM * DM * 2;
constexpr size_t WS_WDOWN = WS_WUP   + (size_t)4 * FF2 * DM * 2;
constexpr size_t WS_MEMN  = WS_WDOWN + (size_t)4 * DM * FFH * 2;
constexpr size_t WS_MKV   = WS_MEMN  + (size_t)MMEM * DM * 2;
constexpr size_t WS_H     = WS_MKV   + (size_t)MMEM * 4096 * 2;
#ifndef XBPAD
#define XBPAD 0
#endif
constexpr int XBP = RES_BF16 ? DM + XBPAD : DM;
constexpr size_t WS_Z     = WS_H     + (size_t)MTOK * XBP * 2;
constexpr size_t WS_MIX   = WS_Z     + (size_t)MTOK * FFP * 2;
constexpr size_t WS_U     = WS_MIX   + (size_t)MTOK * DM * 2;
constexpr size_t WS_KET   = WS_U;
constexpr size_t WS_VT    = WS_KET   + (size_t)2048 * 256 * 64 * 2;
constexpr size_t WS_UEND_A = WS_VT   + (size_t)2048 * 384 * 64 * 2;
constexpr size_t WS_KF    = WS_U;
constexpr size_t WS_VF    = WS_KF    + (size_t)MTOK * FOX_W * 2;
constexpr size_t WS_UEND_B = WS_VF   + (size_t)MTOK * FOX_W * 2;
constexpr size_t WS_UEND  = WS_UEND_A > WS_UEND_B ? WS_UEND_A : WS_UEND_B;
constexpr size_t WS_EL    = WS_UEND;
constexpr size_t WS_GLR   = WS_EL    + (size_t)2048 * 256 * 4;
constexpr size_t WS_CF    = WS_GLR   + (size_t)MTOK * 16 * 4;
constexpr size_t WS_HALO  = WS_CF    + (size_t)96 * SEQ * 4;
constexpr size_t WS_XH    = WS_HALO  + (size_t)128 * 4 * FF2 * 4;
constexpr size_t WS_END   = WS_XH    + (size_t)MTOK * DM * 2;
constexpr size_t WS_SSH   = WS_END;
constexpr size_t WS_NQ    = WS_SSH   + (size_t)MTOK * 4 * 24 * 4;
constexpr int CW_BAR = 4096;
constexpr int RING_BYTES = 131072, MISC_OFF = RING_BYTES, XTRA_OFF = RING_BYTES + 1024, LDS_BYTES = 163840;

#define GAS __attribute__((address_space(1)))
#define LAS __attribute__((address_space(3)))
typedef unsigned short bf16;
typedef unsigned v4u __attribute__((ext_vector_type(4)));
typedef unsigned v2u __attribute__((ext_vector_type(2)));
typedef float f32x4 __attribute__((ext_vector_type(4)));
typedef short bf16x8 __attribute__((ext_vector_type(8)));
#define LDS_WAIT() asm volatile("s_waitcnt lgkmcnt(0)" ::: "memory")
#define VM_WAIT() asm volatile("s_waitcnt vmcnt(0)" ::: "memory")
__device__ __forceinline__ unsigned f2bf(float f) { unsigned u = __builtin_bit_cast(unsigned, f); return (u + 0x7fffu + ((u >> 16) & 1u)) >> 16; }
__device__ __forceinline__ unsigned pk2(float lo, float hi) { return f2bf(lo) | (f2bf(hi) << 16); }
__device__ __forceinline__ float bf2f(unsigned short b) { return __builtin_bit_cast(float, (unsigned)b << 16); }
__device__ __forceinline__ float bflo(unsigned w) { return __builtin_bit_cast(float, w << 16); }
__device__ __forceinline__ float bfhi(unsigned w) { return __builtin_bit_cast(float, w & 0xffff0000u); }
__device__ __forceinline__ float dpp_shr_add(float v, const int n) {
    int r; const int iv = __builtin_bit_cast(int, v);
    if (n == 1) r = __builtin_amdgcn_update_dpp(0, iv, 0x111, 0xf, 0xf, true); else if (n == 2) r = __builtin_amdgcn_update_dpp(0, iv, 0x112, 0xf, 0xf, true);
    else if (n == 4) r = __builtin_amdgcn_update_dpp(0, iv, 0x114, 0xf, 0xf, true); else r = __builtin_amdgcn_update_dpp(0, iv, 0x118, 0xf, 0xf, true);
    return v + __builtin_bit_cast(float, r);
}
__device__ __forceinline__ float dpp_shr_max(float v, const int n) {
    int r; const int iv = __builtin_bit_cast(int, v);
    if (n == 1) r = __builtin_amdgcn_update_dpp(0, iv, 0x111, 0xf, 0xf, true); else if (n == 2) r = __builtin_amdgcn_update_dpp(0, iv, 0x112, 0xf, 0xf, true);
    else if (n == 4) r = __builtin_amdgcn_update_dpp(0, iv, 0x114, 0xf, 0xf, true); else r = __builtin_amdgcn_update_dpp(0, iv, 0x118, 0xf, 0xf, true);
    return fmaxf(v, __builtin_bit_cast(float, r));
}
__device__ __forceinline__ float wave_max(float v) {
    v = dpp_shr_max(v, 1); v = dpp_shr_max(v, 2); v = dpp_shr_max(v, 4); v = dpp_shr_max(v, 8);
    v = fmaxf(v, __builtin_bit_cast(float, __builtin_amdgcn_update_dpp(0, __builtin_bit_cast(int, v), 0x142, 0xa, 0xf, false)));
    v = fmaxf(v, __builtin_bit_cast(float, __builtin_amdgcn_update_dpp(0, __builtin_bit_cast(int, v), 0x143, 0xc, 0xf, false)));
    return __builtin_bit_cast(float, __builtin_amdgcn_readlane(__builtin_bit_cast(int, v), 63));
}
__device__ __forceinline__ float wave_sum(float v) {
    v = dpp_shr_add(v, 1); v = dpp_shr_add(v, 2); v = dpp_shr_add(v, 4); v = dpp_shr_add(v, 8);
    v += __builtin_bit_cast(float, __builtin_amdgcn_update_dpp(0, __builtin_bit_cast(int, v), 0x142, 0xa, 0xf, false));
    v += __builtin_bit_cast(float, __builtin_amdgcn_update_dpp(0, __builtin_bit_cast(int, v), 0x143, 0xc, 0xf, false));
    return __builtin_bit_cast(float, __builtin_amdgcn_readlane(__builtin_bit_cast(int, v), 63));
}
#define XB_TMO      128
#define XB_XCNT(j)  (256  + 64 * (j))
#define XB_XSUB(j)  (1280 + 64 * (j))
#define XB_XGEN(j)  (2304 + 64 * (j))
#define XB_TOP      3328
#define XB_TOPGEN   3392
#define XCD_BAR_WORDS 3456
#define XB_SPIN_CAP (1u << 18)

__device__ __forceinline__ unsigned xb_ld(unsigned* p)              { return __hip_atomic_load(p, __ATOMIC_RELAXED, __HIP_MEMORY_SCOPE_AGENT); }
__device__ __forceinline__ unsigned xb_add(unsigned* p, unsigned v) { return __hip_atomic_fetch_add(p, v, __ATOMIC_RELAXED, __HIP_MEMORY_SCOPE_AGENT); }
__device__ __forceinline__ unsigned xb_xcc_id() { return (unsigned)__builtin_amdgcn_s_getreg((3 << 11) | 20) & 0xFu; }
#define XB_SPIN(cond, bar) do { unsigned _sp = 0; while (cond) { __builtin_amdgcn_s_sleep(1); \
    if ((++_sp & 255u) == 0u) { if (xb_ld(&(bar)[XB_TMO])) break; if (_sp > XB_SPIN_CAP) { atomicAdd(&(bar)[XB_TMO], 1u); break; } } } } while (0)

struct XcdBarrier {
    unsigned* bar; unsigned x;
    volatile LAS unsigned* st;
};

__device__ __forceinline__ XcdBarrier xcd_barrier_post(unsigned* bar, volatile LAS unsigned* st, const int wave_in) {
    XcdBarrier b; b.bar = bar; b.x = xb_xcc_id(); b.st = st;
    if (opaque_tid(wave_in) == 0) (void)xb_add(&bar[XB_XCNT(b.x)], 1u);
    return b;
}
__device__ __forceinline__ void xcd_barrier_complete(unsigned* bar, unsigned x, unsigned& nloc, unsigned& nx) {
    const unsigned G = gridDim.x * gridDim.y * gridDim.z;
    unsigned sum, cnt, mine, sp = 0u;
    for (;;) {
        sum = 0u; cnt = 0u; mine = 0u;
#pragma unroll
        for (unsigned j = 0; j < 16; ++j) { const unsigned c = xb_ld(&bar[XB_XCNT(j)]); sum += c; cnt += (c > 0u) ? 1u : 0u; mine = (j == x) ? c : mine; }
        if (sum == G) break;
        __builtin_amdgcn_s_sleep(1);
        if ((++sp & 255u) == 0u) { if (xb_ld(&bar[XB_TMO])) break; if (sp > XB_SPIN_CAP) { atomicAdd(&bar[XB_TMO], 1u); break; } }
    }
    nloc = mine > 0u ? mine : 1u; nx = cnt > 0u ? cnt : 1u;
}

__device__ __forceinline__ void xcd_barrier(const XcdBarrier& b, const int wave_in) {
    asm volatile("s_waitcnt vmcnt(0)" ::: "memory");
    __syncthreads();
    if (opaque_tid(wave_in) == 0) {
        unsigned* bar = b.bar;
        __builtin_amdgcn_s_waitcnt(0);
        unsigned nloc = b.st[0], nx = b.st[1];
        if (nloc == 0u) { xcd_barrier_complete(bar, b.x, nloc, nx); b.st[0] = nloc; b.st[1] = nx; }
        const unsigned old = xb_add(&bar[XB_XSUB(b.x)], 1u);
        const unsigned gen = old / nloc;
        if (old + 1u == (gen + 1u) * nloc) {
            __builtin_amdgcn_fence(__ATOMIC_RELEASE, "agent");
            asm volatile("s_waitcnt vmcnt(0)" ::: "memory");
            const unsigned og = xb_add(&bar[XB_TOP], 1u);
            const unsigned tg = og / nx;
            if (og + 1u == (tg + 1u) * nx) xb_add(&bar[XB_TOPGEN], 1u);
            else XB_SPIN(xb_ld(&bar[XB_TOPGEN]) == tg, bar);
            __builtin_amdgcn_fence(__ATOMIC_ACQUIRE, "agent");
            xb_add(&bar[XB_XGEN(b.x)], 1u);
            asm volatile("s_waitcnt vmcnt(0)" ::: "memory");
        } else {
            XB_SPIN(xb_ld(&bar[XB_XGEN(b.x)]) == gen, bar);
            __builtin_amdgcn_fence(__ATOMIC_ACQUIRE, "agent");
            asm volatile("s_waitcnt vmcnt(0)" ::: "memory");
        }
    }
    __syncthreads();
}
struct Ctx {
    LAS unsigned char* lds;
    int tid, lane, wave, vcu, bx, G;
    const float* in[21]; float* out; unsigned char* ws;
};
template <class T> __device__ __forceinline__ T* wsp(const Ctx& C, size_t off) { return (T*)(C.ws + off); }

struct XpItem { const float* src; const float* gain; bf16* dst; int Nsrc, K; };
__device__ __forceinline__ void xp_load(const XpItem& X, f32x4 (&v)[8], float (&gk)[8]) {
#pragma unroll
    for (int i = 0; i < 8; ++i) { v[i] = *(const GAS f32x4*)(X.src + (size_t)(8 * i) * X.Nsrc); gk[i] = X.gain ? X.gain[8 * i] : 1.0f; }
}
__device__ __forceinline__ void xp_finish(const XpItem& X, const f32x4 (&v)[8], const float (&gk)[8], LAS float* scr, int lane) {
#pragma unroll
    for (int i = 0; i < 8; ++i) { const int kk = 8 * i + (lane >> 3); LAS float* d = scr + kk * 33 + (lane & 7) * 4; const f32x4 y = v[i] * gk[i]; d[0] = y.x; d[1] = y.y; d[2] = y.z; d[3] = y.w; }
    LDS_WAIT(); asm volatile("" ::: "memory");
    const int c = lane & 7;
#pragma unroll
    for (int j = 0; j < 4; ++j) { const int n = (lane >> 3) + 8 * j; const LAS float* s = scr + (8 * c) * 33 + n;
        v4u o; o.x = pk2(s[0 * 33], s[1 * 33]); o.y = pk2(s[2 * 33], s[3 * 33]); o.z = pk2(s[4 * 33], s[5 * 33]); o.w = pk2(s[6 * 33], s[7 * 33]);
        *(GAS v4u*)(X.dst + (size_t)(8 * j) * X.K) = o; }
    LDS_WAIT(); asm volatile("" ::: "memory");
}
__device__ __forceinline__ int colmap(int type, int g) {
    if (type == 1) return g < 112 ? 32 * g : 32 * g + 16;
    if (type == 2) { const int pn = g >> 3, gg = g & 7; return gg < 4 ? 128 * pn + 32 * gg : FFH + 128 * pn + 32 * (gg - 4); }
    return 32 * g;
}
__device__ __forceinline__ bool xpose_family(int& r, XpItem& X, int lane, const float* W, int K, int Nsrc, int Ndst, int l0, int nl, int type, bf16* WT, const float* gain = nullptr, int gstride = 0, int gmax = 1 << 30) {
    const int per = (K / 64) * (Ndst / 32), tot = per * nl;
    if (r >= tot) { r -= tot; return false; }
    const int l = l0 + r / per, q = r - (l - l0) * per, g = q / (K / 64), kb = q - g * (K / 64), k0 = 64 * kb;
    X.src = W + (size_t)l * K * Nsrc + (size_t)(k0 + (lane >> 3)) * Nsrc + colmap(type, g) + (lane & 7) * 4; X.Nsrc = Nsrc; X.K = K;
    X.gain = (gain && k0 < gmax) ? gain + (size_t)l * gstride + k0 + (lane >> 3) : nullptr;
    X.dst = WT + (size_t)l * Ndst * K + (size_t)(32 * g + (lane >> 3)) * K + k0 + 8 * (lane & 7);
    return true;
}
__device__ __forceinline__ void xp_resolve(const Ctx& C, int list, int it, XpItem& X) {
    int r = it; const int lane = C.lane;
    if (list == 0) {
        if (xpose_family(r, X, lane, C.in[7], DM, GLA_IN_SRC, GLA_IN, 0, 2, 1, wsp<bf16>(C, WS_WGIN), C.in[2], DM)) return;
        if (xpose_family(r, X, lane, C.in[6], DM, 1024, 1024, 0, 4, 0, wsp<bf16>(C, WS_WMEM))) return;
        if (xpose_family(r, X, lane, C.in[11], DM, DM, DM, 0, 2, 0, wsp<bf16>(C, WS_WGOUT), C.in[10], GLA_V, GLA_V)) return;
        if (xpose_family(r, X, lane, C.in[17], DM, FF2, FF2, 0, 2, 2, wsp<bf16>(C, WS_WUP), C.in[3], DM)) return;
        xpose_family(r, X, lane, C.in[20], FFH, DM, DM, 0, 2, 0, wsp<bf16>(C, WS_WDOWN));
    } else {
        if (xpose_family(r, X, lane, C.in[13], DM, FOX_KV_SRC, 3072, 0, 1, 0, wsp<bf16>(C, WS_WFKV), C.in[12], 0)) return;
        if (xpose_family(r, X, lane, C.in[15], DM, DM, DM, 0, 2, 0, wsp<bf16>(C, WS_WFIN), C.in[2] + 2 * DM, DM)) return;
        if (xpose_family(r, X, lane, C.in[16], DM, DM, DM, 0, 2, 0, wsp<bf16>(C, WS_WFOUT))) return;
        if (xpose_family(r, X, lane, C.in[17], DM, FF2, FF2, 2, 2, 2, wsp<bf16>(C, WS_WUP), C.in[3], DM)) return;
        xpose_family(r, X, lane, C.in[20], FFH, DM, DM, 2, 2, 0, wsp<bf16>(C, WS_WDOWN));
    }
}
constexpr int NX_EARLY = 4 * 32 * 32 + 2 * 32 * 176 + 2 * 32 * 64 + 2 * 32 * 352 + 2 * 88 * 64;
constexpr int NX_LATE = 32 * 96 + 2 * 32 * 64 + 2 * 32 * 64 + 2 * 32 * 352 + 2 * 88 * 64;
__device__ __forceinline__ void xp_run(const Ctx& C, int list, int first, int end, int stride) {
    LAS float* scr = (LAS float*)(C.lds + C.wave * 16384);
    XpItem Xa, Xb; f32x4 va[8], vb[8]; float ga[8], gb[8];
    int it = first; if (it < end) { xp_resolve(C, list, it, Xa); xp_load(Xa, va, ga); }
    while (it < end) {
        const int it1 = it + stride, it2 = it1 + stride;
        if (it1 < end) { xp_resolve(C, list, it1, Xb); xp_load(Xb, vb, gb); }
        xp_finish(Xa, va, ga, scr, C.lane);
        if (it2 < end) { xp_resolve(C, list, it2, Xa); xp_load(Xa, va, ga); }
        if (it1 < end) xp_finish(Xb, vb, gb, scr, C.lane);
        it = it2;
    }
}
__device__ __forceinline__ void rms_row(const Ctx& C, const float* xrow, const float* g1, bf16* o1, const float* g2, bf16* o2, float* of32) {
    const GAS f32x4* xr = (const GAS f32x4*)xrow + C.lane;
    f32x4 v[8]; float s = 0.f;
#pragma unroll
    for (int j = 0; j < 8; ++j) { v[j] = xr[64 * j]; s += (v[j].x * v[j].x + v[j].y * v[j].y) + (v[j].z * v[j].z + v[j].w * v[j].w); }
    const float rstd = 1.0f / sqrtf(wave_sum(s) * (1.f / DM) + EPS);
#pragma unroll
    for (int j = 0; j < 8; ++j) { const f32x4 g = ((const GAS f32x4*)g1)[C.lane + 64 * j]; const f32x4 y = v[j] * rstd * g;
        if (of32) ((GAS f32x4*)of32)[C.lane + 64 * j] = y;
        else ((GAS v2u*)o1)[C.lane + 64 * j] = (v2u){pk2(y.x, y.y), pk2(y.z, y.w)}; }
    if (o2) {
#pragma unroll
        for (int j = 0; j < 8; ++j) { const f32x4 g = ((const GAS f32x4*)g2)[C.lane + 64 * j]; const f32x4 y = v[j] * rstd * g;
            ((GAS v2u*)o2)[C.lane + 64 * j] = (v2u){pk2(y.x, y.y), pk2(y.z, y.w)}; }
    }
}
__device__ __forceinline__ void rms_phase(const Ctx& C, const float* x, int rows, const float* g1, bf16* o1, const float* g2, bf16* o2, float* of32) {
    const int gw = C.vcu * NWAVES + C.wave, NGW = C.G * NWAVES;
    for (int m = gw; m < rows; m += NGW) rms_row(C, x + (size_t)m * DM, g1, o1 ? o1 + (size_t)m * DM : nullptr, g2, o2 ? o2 + (size_t)m * DM : nullptr, of32 ? of32 + (size_t)m * DM : nullptr);
}
__device__ __forceinline__ void convert_late(const Ctx& C, int half, int widx, int nw) { xp_run(C, 1, half * (NX_LATE / 2) + widx, (half + 1) * (NX_LATE / 2), nw); }
__device__ __forceinline__ void rms_bf16_phase(const Ctx& C, const bf16* xb, const float* g, float* out) {
    const int gw = C.vcu * NWAVES + C.wave, NGW = C.G * NWAVES;
    f32x4 gg[8];
#pragma unroll
    for (int j = 0; j < 8; ++j) gg[j] = ((const GAS f32x4*)g)[C.lane + 64 * j];
    v2u wn[8];
    if (gw < MTOK) {
#pragma unroll
        for (int j = 0; j < 8; ++j) wn[j] = ((const GAS v2u*)(xb + (size_t)gw * XBP))[C.lane + 64 * j]; }
    for (int m = gw; m < MTOK; m += NGW) { f32x4 v[8]; float s = 0.f; v2u w[8];
#pragma unroll
        for (int j = 0; j < 8; ++j) w[j] = wn[j];
        if (m + NGW < MTOK) {
#pragma unroll
            for (int j = 0; j < 8; ++j) wn[j] = ((const GAS v2u*)(xb + (size_t)(m + NGW) * XBP))[C.lane + 64 * j]; }
#pragma unroll
        for (int j = 0; j < 8; ++j) { v[j] = RES_BF16 ? (f32x4){bflo(w[j].x), bfhi(w[j].x), bflo(w[j].y), bfhi(w[j].y)} : (f32x4){pg8::h2lo(w[j].x), pg8::h2hi(w[j].x), pg8::h2lo(w[j].y), pg8::h2hi(w[j].y)}; s += (v[j].x * v[j].x + v[j].y * v[j].y) + (v[j].z * v[j].z + v[j].w * v[j].w); }
        const float rstd = 1.0f / sqrtf(wave_sum(s) * (1.f / DM) + EPS);
#pragma unroll
        for (int j = 0; j < 8; ++j) ((GAS f32x4*)(out + (size_t)m * DM))[C.lane + 64 * j] = v[j] * rstd * gg[j]; }
}
__device__ __forceinline__ void p0_prologue(const Ctx& C) {
    const int gw = C.vcu * NWAVES + C.wave, NGW = C.G * NWAVES;
    xp_run(C, 0, gw, NX_EARLY, NGW);
    { const int gt = C.vcu * NTHREADS + C.tid, NT = C.G * NTHREADS;
      for (int i = gt; i < 3 * 16 * DM; i += NT) { const int l = i / (16 * DM), n = (i / DM) & 15, k = i % DM;
          if (l < 2) wsp<bf16>(C, WS_WGLR)[i] = (bf16)f2bf(C.in[7][((size_t)l * DM + k) * GLA_IN_SRC + 3584 + n] * C.in[2][l * DM + k]);
          else wsp<bf16>(C, WS_WFL)[i - 2 * 16 * DM] = (bf16)(n < 12 ? f2bf(C.in[13][(size_t)k * FOX_KV_SRC + 3072 + n] * C.in[12][k]) : 0u); } }
    rms_phase(C, C.in[1], MMEM, C.in[4], wsp<bf16>(C, WS_MEMN), nullptr, nullptr, nullptr);
    { unsigned* SS = wsp<unsigned>(C, WS_SS); bf16* XB = wsp<bf16>(C, WS_H);
      f32x4 vn[8];
      if (gw < MTOK) { const GAS f32x4* xr = (const GAS f32x4*)(C.in[0] + (size_t)gw * DM) + C.lane;
#pragma unroll
          for (int j = 0; j < 8; ++j) vn[j] = xr[64 * j]; }
      for (int m = gw; m < MTOK; m += NGW) { f32x4 v[8]; float s = 0.f;
#pragma unroll
          for (int j = 0; j < 8; ++j) v[j] = vn[j];
          if (m + NGW < MTOK) { const GAS f32x4* xr = (const GAS f32x4*)(C.in[0] + (size_t)(m + NGW) * DM) + C.lane;
#pragma unroll
              for (int j = 0; j < 8; ++j) vn[j] = xr[64 * j]; }
#pragma unroll
          for (int j = 0; j < 8; ++j) s += (v[j].x * v[j].x + v[j].y * v[j].y) + (v[j].z * v[j].z + v[j].w * v[j].w);
          const float rstd = 1.0f / sqrtf(wave_sum(s) * (1.f / DM) + EPS);
#pragma unroll
          for (int j = 0; j < 8; ++j) { const f32x4 y = v[j] * rstd; ((GAS v2u*)(XB + (size_t)m * XBP))[C.lane + 64 * j] = (v2u){pk2(y.x, y.y), pk2(y.z, y.w)}; }
          if (C.lane == 0) SS[m] = (unsigned)(2048.0f * (1.0f - 1e-6f) * pg8::SS_SCALE); }
    }
}
__device__ __forceinline__ void skinny16_phase(const Ctx& C, const bf16* A, const bf16* Wt, float* out, const unsigned* ss, int gw = -1, int NGW = 0) {
    if (gw < 0) { gw = C.vcu * NWAVES + C.wave; NGW = C.G * NWAVES; }
    const int fr = C.lane & 15, fq = C.lane >> 4;
    for (int t = gw; t < MTOK / 16; t += NGW) {
        const bf16* ap = A + (size_t)(t * 16 + fr) * XBP + fq * 8; const bf16* bp = Wt + (size_t)fr * DM + fq * 8;
        f32x4 acc[4] = {};
#pragma unroll 4
        for (int ks = 0; ks < 64; ks += 4) {
#pragma unroll
            for (int u = 0; u < 4; ++u) { const bf16x8 a = *(const bf16x8*)(ap + (ks + u) * 32), b = *(const bf16x8*)(bp + (ks + u) * 32);
                acc[u] = pg8::mfma16<false>(a, b, acc[u]); }
        }
        const f32x4 r = (acc[0] + acc[1]) + (acc[2] + acc[3]);
#pragma unroll
        for (int j = 0; j < 4; ++j) out[(size_t)(t * 16 + 4 * fq + j) * 16 + fr] = r[j] * __builtin_amdgcn_rsqf((float)ss[t * 16 + 4 * fq + j] * (1.0f / (pg8::SS_SCALE * DM)) + EPS);
    }
}

__device__ __forceinline__ void gla_prep_phase(const Ctx& C, int layer) {
    bf16* Z = wsp<bf16>(C, WS_Z); const float* GLR = wsp<float>(C, WS_GLR);
    const float* Wg = C.in[8] + (size_t)layer * 16 * GLA_QK; const float* bg = C.in[9] + (size_t)layer * GLA_QK;
    LAS float* GL = (LAS float*)C.lds; LAS float* WG = (LAS float*)(C.lds + 4096); LAS float* TOT = (LAS float*)(C.lds + 20480);
    const int tid = C.tid, cg = tid & 31, rg = tid >> 5;
    int hprev = -1; f32x4 glnext = (f32x4){0.f, 0.f, 0.f, 0.f};
    if (C.vcu < 2048 && tid < 256) { const int ch0 = (C.vcu >> 2) & 63, b0_ = C.vcu >> 8; glnext = ((const GAS f32x4*)(GLR + ((size_t)b0_ * SEQ + ch0 * 64) * 16))[tid]; }
    f32x4 b0 = (f32x4){0.f, 0.f, 0.f, 0.f}, b1 = b0;
    for (int it0 = C.vcu; it0 < 2048; it0 += C.G) {
        const int h = it0 & 3, ch = (it0 >> 2) & 63, b = it0 >> 8, bh = b * 4 + h, item = bh * 64 + ch; const size_t r0 = (size_t)b * SEQ + ch * 64;
        if (tid < 256) ((LAS f32x4*)GL)[tid] = glnext;
        if (h != hprev) {
#pragma unroll
            for (int i = 0; i < 2; ++i) { const int q = tid + NTHREADS * i, j = q >> 6, c4 = q & 63; ((LAS f32x4*)WG)[q] = *(const GAS f32x4*)(Wg + j * GLA_QK + h * GLA_DK + c4 * 4); }
            b0 = *(const GAS f32x4*)(bg + h * GLA_DK + 8 * cg); b1 = *(const GAS f32x4*)(bg + h * GLA_DK + 8 * cg + 4); hprev = h; }
        { const int itn = it0 + C.G; if (itn < 2048 && tid < 256) { const int chn = (itn >> 2) & 63, bn = itn >> 8; glnext = ((const GAS f32x4*)(GLR + ((size_t)bn * SEQ + chn * 64) * 16))[tid]; } }
        v4u qv[4], kv[4];
        bf16* qp = Z + (r0 + 4 * rg) * GLA_IN + ZQ + h * GLA_DK + 8 * cg; bf16* kp = qp + ZK;
#pragma unroll
        for (int r = 0; r < 4; ++r) { qv[r] = *(const GAS v4u*)(qp + (size_t)r * GLA_IN); kv[r] = *(const GAS v4u*)(kp + (size_t)r * GLA_IN); }
        __syncthreads();
        float x[4][8];
#pragma unroll
        for (int r = 0; r < 4; ++r) { x[r][0] = b0[0]; x[r][1] = b0[1]; x[r][2] = b0[2]; x[r][3] = b0[3]; x[r][4] = b1[0]; x[r][5] = b1[1]; x[r][6] = b1[2]; x[r][7] = b1[3]; }
#pragma unroll
        for (int j4 = 0; j4 < 4; ++j4) {
            f32x4 g[4];
#pragma unroll
            for (int r = 0; r < 4; ++r) g[r] = ((const LAS f32x4*)(GL + (4 * rg + r) * 16))[j4];
#pragma unroll
            for (int jj = 0; jj < 4; ++jj) { const int j = 4 * j4 + jj; const f32x4 w0 = ((const LAS f32x4*)(WG + j * 256 + 8 * cg))[0], w1 = ((const LAS f32x4*)(WG + j * 256 + 8 * cg))[1];
#pragma unroll
                for (int r = 0; r < 4; ++r) { const float gv = g[r][jj];
                    x[r][0] += gv * w0[0]; x[r][1] += gv * w0[1]; x[r][2] += gv * w0[2]; x[r][3] += gv * w0[3]; x[r][4] += gv * w1[0]; x[r][5] += gv * w1[1]; x[r][6] += gv * w1[2]; x[r][7] += gv * w1[3]; } }
        }
#pragma unroll
        for (int c = 0; c < 8; ++c) { float cum = 0.f;
#pragma unroll
            for (int r = 0; r < 4; ++r) { const float v = x[r][c]; const float ls = fminf(v, 0.f) - 0.6931471805599453f * __builtin_amdgcn_logf(1.0f + __builtin_amdgcn_exp2f(-1.4426950408889634f * fabsf(v)));
                cum += ls * 0.0625f; x[r][c] = cum; } }
        ((LAS f32x4*)(TOT + rg * 256 + 8 * cg))[0] = (f32x4){x[3][0], x[3][1], x[3][2], x[3][3]}; ((LAS f32x4*)(TOT + rg * 256 + 8 * cg))[1] = (f32x4){x[3][4], x[3][5], x[3][6], x[3][7]};
        __syncthreads();
        { f32x4 o0 = (f32x4){0.f, 0.f, 0.f, 0.f}, o1 = o0;
#pragma unroll
          for (int q = 0; q < 15; ++q) { const float msk = q < rg ? 1.0f : 0.0f; o0 += ((const LAS f32x4*)(TOT + q * 256 + 8 * cg))[0] * msk; o1 += ((const LAS f32x4*)(TOT + q * 256 + 8 * cg))[1] * msk; }
#pragma unroll
          for (int r = 0; r < 4; ++r) { x[r][0] += o0[0]; x[r][1] += o0[1]; x[r][2] += o0[2]; x[r][3] += o0[3]; x[r][4] += o1[0]; x[r][5] += o1[1]; x[r][6] += o1[2]; x[r][7] += o1[3]; } }
        if (rg == 15) { float* el = wsp<float>(C, WS_EL) + (size_t)item * 256 + 8 * cg;
            f32x4 e0, e1;
#pragma unroll
            for (int c = 0; c < 4; ++c) { e0[c] = __builtin_amdgcn_exp2f(1.4426950408889634f * x[3][c]); e1[c] = __builtin_amdgcn_exp2f(1.4426950408889634f * x[3][4 + c]); }
            *(GAS f32x4*)el = e0; *(GAS f32x4*)(el + 4) = e1; }
        const int pb = ((8 * cg) & ~31) + 16 * (cg & 1) + 4 * ((cg >> 1) & 1);
        unsigned ket[8][2];
#pragma unroll
        for (int r = 0; r < 4; ++r) { unsigned qo[4], ko[4];
#pragma unroll
            for (int c2 = 0; c2 < 4; ++c2) {
                const float e0 = __builtin_amdgcn_exp2f(1.4426950408889634f * x[r][2 * c2]), e1 = __builtin_amdgcn_exp2f(1.4426950408889634f * x[r][2 * c2 + 1]);
                const float q0 = bflo(qv[r][c2]) * 0.0625f * e0, q1 = bfhi(qv[r][c2]) * 0.0625f * e1;
                const unsigned k0 = f2bf(bflo(kv[r][c2]) * __builtin_amdgcn_rcpf(e0)), k1 = f2bf(bfhi(kv[r][c2]) * __builtin_amdgcn_rcpf(e1));
                qo[c2] = pk2(q0, q1); ko[c2] = k0 | (k1 << 16);
                if (r & 1) { ket[2 * c2][r >> 1] |= k0 << 16; ket[2 * c2 + 1][r >> 1] |= k1 << 16; } else { ket[2 * c2][r >> 1] = k0; ket[2 * c2 + 1][r >> 1] = k1; } }
            bf16* qr = Z + (r0 + 4 * rg + r) * GLA_IN + ZQ + h * GLA_DK; bf16* kr = qr + ZK;
            *(GAS v2u*)(qr + pb) = (v2u){qo[0], qo[1]}; *(GAS v2u*)(qr + pb + 8) = (v2u){qo[2], qo[3]};
            *(GAS v2u*)(kr + pb) = (v2u){ko[0], ko[1]}; *(GAS v2u*)(kr + pb + 8) = (v2u){ko[2], ko[3]}; }
        { bf16* ketp = wsp<bf16>(C, WS_KET) + (size_t)item * 256 * 64 + (size_t)(8 * cg) * 64 + 4 * rg;
#pragma unroll
          for (int c = 0; c < 8; ++c) *(GAS v2u*)(ketp + c * 64) = (v2u){ket[c][0], ket[c][1]}; }
        __syncthreads();
    }
}

__device__ __forceinline__ int sw512(int row, int ch) { return row * 512 + ((ch ^ (row & 15)) << 4); }
__device__ __forceinline__ int sw128(int row, int ch) { return row * 128 + ((ch ^ ((row >> 1) & 7)) << 4); }
__device__ __forceinline__ void gla_scan_phase(const Ctx& C) {
    constexpr int SQE = 0, SKE = 32768, SKET = 65536, SVT = 98304, SATT = 106496, SEL = 114688, SPART = XTRA_OFF;
    const bf16* Z = wsp<bf16>(C, WS_Z); const bf16* KETg = wsp<bf16>(C, WS_KET); const float* ELg = wsp<float>(C, WS_EL);
    bf16* Og = wsp<bf16>(C, WS_MIX);
    LAS unsigned char* L = C.lds;
    const int tid = C.tid, lane = C.lane, w = C.wave, dh = w >> 2, nt = w & 3, fr = lane & 15, fq = lane >> 4;
    if (C.vcu < 192) { const int it = C.vcu;
        const int bh = it / 6, slice = it - bh * 6, b = bh >> 2, h = bh & 3;
        v4u rq[4], rk[4], rt[4], rv, re;
#define SCAN_LOAD_A(c_) do { const size_t r0_ = (size_t)b * SEQ + (size_t)(c_) * 64;                                                                           \
        _Pragma("unroll") for (int j_ = 0; j_ < 4; ++j_) { const int i_ = tid + NTHREADS * j_;                                                                \
            rq[j_] = *(const GAS v4u*)(Z + (r0_ + (i_ >> 5)) * GLA_IN + ZQ + h * GLA_DK + (i_ & 31) * 8);                                                     \
            rk[j_] = *(const GAS v4u*)(Z + (r0_ + (i_ >> 5)) * GLA_IN + ZK + h * GLA_DK + (i_ & 31) * 8); } } while (0)
#define SCAN_LOAD_B(c_) do { const size_t ci_ = (size_t)bh * 64 + (c_);                                                                                       \
        _Pragma("unroll") for (int j_ = 0; j_ < 4; ++j_) { const int i_ = tid + NTHREADS * j_; rt[j_] = *(const GAS v4u*)(KETg + ci_ * 16384 + (size_t)i_ * 8); } \
        rv = *(const GAS v4u*)(Z + ((size_t)b * SEQ + (size_t)(c_) * 64 + (tid >> 3)) * GLA_IN + ZV + h * GLA_DV + slice * 64 + (tid & 7) * 8);     \
        if (tid < 64) re = *(const GAS v4u*)(ELg + ci_ * 256 + tid * 4); } while (0)
#define SCAN_WRITE() do {                                                                                                                                      \
        _Pragma("unroll") for (int j_ = 0; j_ < 4; ++j_) { const int i_ = tid + NTHREADS * j_;                                                                \
            *(LAS v4u*)(L + SQE + sw512(i_ >> 5, i_ & 31)) = rq[j_]; *(LAS v4u*)(L + SKE + sw512(i_ >> 5, i_ & 31)) = rk[j_];                                 \
            *(LAS v4u*)(L + SKET + sw128(i_ >> 3, i_ & 7)) = rt[j_]; }                                                                                         \
        _Pragma("unroll") for (int e_ = 0; e_ < 8; ++e_) {                \
            *(LAS unsigned short*)(L + SVT + sw128(8 * (tid & 7) + e_, tid >> 6) + ((tid >> 3) & 7) * 2) = (unsigned short)(rv[e_ >> 1] >> (16 * (e_ & 1))); }                    \
        if (tid < 64) *(LAS v4u*)(L + SEL + tid * 16) = re; } while (0)
        SCAN_LOAD_A(0); SCAN_LOAD_B(0);
        for (int i = tid; i < 512; i += NTHREADS) *(LAS v4u*)(L + SATT + i * 16) = (v4u){0u, 0u, 0u, 0u};
        VM_WAIT(); SCAN_WRITE();
        f32x4 S[8];
#pragma unroll
        for (int i = 0; i < 8; ++i) S[i] = (f32x4){0.f, 0.f, 0.f, 0.f};
        __syncthreads();
        float* SSHg = wsp<float>(C, WS_SSH);
        for (int c = 0; c < 64; ++c) {
            if (c + 1 < 64) { SCAN_LOAD_A(c + 1); SCAN_LOAD_B(c + 1); }
            unsigned short ogv[8];
            { const bf16* ogp = Z + ((size_t)b * SEQ + (size_t)c * 64 + 32 * dh + 4 * fq) * GLA_IN + ZOG + h * GLA_DV + slice * 64 + 16 * nt + fr;
#pragma unroll
              for (int i = 0; i < 2; ++i)
#pragma unroll
                  for (int j = 0; j < 4; ++j) ogv[i * 4 + j] = ogp[(size_t)(16 * i + j) * GLA_IN]; }
#pragma unroll
            for (int rep = 0; rep < 2; ++rep) {
                const int id = w + 8 * rep;
                if (id < 10) {
                    int mt = 0; if (id >= 1) mt = 1; if (id >= 3) mt = 2; if (id >= 6) mt = 3; const int nn = id - (mt * (mt + 1)) / 2;
                    f32x4 a = (f32x4){0.f, 0.f, 0.f, 0.f};
#pragma unroll
                    for (int ks = 0; ks < 8; ++ks) {
                        const bf16x8 af = *(const LAS bf16x8*)(L + SQE + sw512(16 * mt + fr, 4 * ks + fq)), bfm = *(const LAS bf16x8*)(L + SKE + sw512(16 * nn + fr, 4 * ks + fq));
                        a = __builtin_amdgcn_mfma_f32_16x16x32_bf16(af, bfm, a, 0, 0, 0); }
#pragma unroll
                    for (int j = 0; j < 4; ++j) { const int t = 16 * mt + 4 * fq + j, s = 16 * nn + fr; const float v = (s <= t) ? a[j] : 0.f;
                        *(LAS unsigned short*)(L + SATT + sw128(t, s >> 3) + (s & 7) * 2) = (unsigned short)f2bf(v); }
                }
            }
            f32x4 ao[4];
            { bf16x8 sf[4];
#pragma unroll
              for (int k2 = 0; k2 < 4; ++k2) { v4u p; p.x = pg8::cvt_pk_bf16(S[2 * k2][0], S[2 * k2][1]); p.y = pg8::cvt_pk_bf16(S[2 * k2][2], S[2 * k2][3]);
                  p.z = pg8::cvt_pk_bf16(S[2 * k2 + 1][0], S[2 * k2 + 1][1]); p.w = pg8::cvt_pk_bf16(S[2 * k2 + 1][2], S[2 * k2 + 1][3]); sf[k2] = __builtin_bit_cast(bf16x8, p); }
#pragma unroll
              for (int mt = 0; mt < 4; ++mt) { f32x4 a = (f32x4){0.f, 0.f, 0.f, 0.f};
#pragma unroll
                  for (int k2 = 0; k2 < 4; ++k2) { const bf16x8 af = *(const LAS bf16x8*)(L + SQE + sw512(16 * mt + fr, 4 * (4 * dh + k2) + fq));
                      a = __builtin_amdgcn_mfma_f32_16x16x32_bf16(af, sf[k2], a, 0, 0, 0); }
                  ao[mt] = a; } }
            { const f32x4 e0 = dh ? ao[0] : ao[2], e1 = dh ? ao[1] : ao[3];
              *(LAS f32x4*)(L + SPART + ((w * 2 + 0) * 64 + lane) * 16) = e0; *(LAS f32x4*)(L + SPART + ((w * 2 + 1) * 64 + lane) * 16) = e1; }
            { const bf16x8 v0 = *(const LAS bf16x8*)(L + SVT + sw128(16 * nt + fr, fq)), v1 = *(const LAS bf16x8*)(L + SVT + sw128(16 * nt + fr, 4 + fq));
#pragma unroll
              for (int i = 0; i < 8; ++i) { const int row = 128 * dh + 16 * i + fr;
                  const bf16x8 a0 = *(const LAS bf16x8*)(L + SKET + sw128(row, fq)), a1 = *(const LAS bf16x8*)(L + SKET + sw128(row, 4 + fq));
                  S[i] = __builtin_amdgcn_mfma_f32_16x16x32_bf16(a0, v0, S[i], 0, 0, 0); S[i] = __builtin_amdgcn_mfma_f32_16x16x32_bf16(a1, v1, S[i], 0, 0, 0);
                  const f32x4 el = *(const LAS f32x4*)(L + SEL + (128 * dh + 16 * i + 4 * fq) * 4); S[i] = S[i] * el; } }
            LDS_WAIT(); __syncthreads();
            { const int wo = (1 - dh) * 4 + nt;
              const bf16x8 v0 = *(const LAS bf16x8*)(L + SVT + sw128(16 * nt + fr, fq)), v1 = *(const LAS bf16x8*)(L + SVT + sw128(16 * nt + fr, 4 + fq));
#pragma unroll
              for (int i = 0; i < 2; ++i) { const int mt = 2 * dh + i;
                  f32x4 a = (i == 0 ? (dh ? ao[2] : ao[0]) : (dh ? ao[3] : ao[1])) + *(const LAS f32x4*)(L + SPART + ((wo * 2 + i) * 64 + lane) * 16);
                  const bf16x8 t0 = *(const LAS bf16x8*)(L + SATT + sw128(16 * mt + fr, fq)); a = __builtin_amdgcn_mfma_f32_16x16x32_bf16(t0, v0, a, 0, 0, 0);
                  if (dh) { const bf16x8 t1 = *(const LAS bf16x8*)(L + SATT + sw128(16 * mt + fr, 4 + fq)); a = __builtin_amdgcn_mfma_f32_16x16x32_bf16(t1, v1, a, 0, 0, 0); }
                  const size_t grow = (size_t)b * SEQ + (size_t)c * 64 + 16 * mt + 4 * fq;
                  bf16* op = Og + grow * DM + h * GLA_DV + slice * 64 + 16 * nt + fr;
#pragma unroll
                  for (int j = 0; j < 4; ++j) { float s2 = a[j] * a[j]; s2 = dpp_shr_add(s2, 1); s2 = dpp_shr_add(s2, 2); s2 = dpp_shr_add(s2, 4); s2 = dpp_shr_add(s2, 8);
                      if (fr == 15) SSHg[((grow + j) * 4 + h) * 24 + slice * 4 + nt] = s2;
                      op[(size_t)j * DM] = (bf16)f2bf(a[j] * pg8::silu_f(bf2f(ogv[i * 4 + j]))); } } }
            __syncthreads();
            if (c + 1 < 64) { VM_WAIT(); SCAN_WRITE(); }
            LDS_WAIT(); __syncthreads();
        }
#undef SCAN_LOAD_A
#undef SCAN_LOAD_B
#undef SCAN_WRITE
    }
}

__device__ __forceinline__ void gla_onorm_phase(const Ctx& C, int layer) {
    const bf16* Z = wsp<bf16>(C, WS_Z); bf16* MIX = wsp<bf16>(C, WS_MIX); const float* gain = C.in[10] + (size_t)layer * GLA_V;
    const int gw = C.vcu * NWAVES + C.wave, NGW = C.G * NWAVES, lane = C.lane;
    for (int m = gw; m < MTOK; m += NGW) {
#pragma unroll
        for (int h = 0; h < 4; ++h) {
            float o[8], g[8]; float ss = 0.f;
            if (lane < 48) { const v4u ov = *(const GAS v4u*)(MIX + (size_t)m * DM + h * GLA_DV + lane * 8), gv = *(const GAS v4u*)(Z + (size_t)m * GLA_IN + ZOG + h * GLA_DV + lane * 8);
#pragma unroll
                for (int j = 0; j < 4; ++j) { o[2 * j] = bflo(ov[j]); o[2 * j + 1] = bfhi(ov[j]); g[2 * j] = bflo(gv[j]); g[2 * j + 1] = bfhi(gv[j]); }
#pragma unroll
                for (int j = 0; j < 8; ++j) ss += o[j] * o[j]; }
            const float rstd = 1.0f / sqrtf(wave_sum(ss) * (1.f / GLA_DV) + EPS);
            if (lane < 48) { const f32x4 ga = *(const GAS f32x4*)(gain + h * GLA_DV + lane * 8), gb = *(const GAS f32x4*)(gain + h * GLA_DV + lane * 8 + 4);
                float y[8];
#pragma unroll
                for (int j = 0; j < 8; ++j) { const float gn = j < 4 ? ga[j] : gb[j - 4]; y[j] = o[j] * rstd * gn * pg8::silu_f(g[j]); }
                *(GAS v4u*)(MIX + (size_t)m * DM + h * GLA_DV + lane * 8) = (v4u){pk2(y[0], y[1]), pk2(y[2], y[3]), pk2(y[4], y[5]), pk2(y[6], y[7])}; }
        }
    }
}

__device__ __forceinline__ void fox_cumsum_phase(const Ctx& C) {
    const float* FL = wsp<float>(C, WS_GLR); float* CF = wsp<float>(C, WS_CF); const float* bfp = C.in[14];
    const int NGW = C.G * NWAVES, lane = C.lane; int gw = C.vcu * NWAVES + C.wave;
    if (NGW >= 1536 + BATCH * FOX_H) gw -= 1536;
    if (gw < 0) return;
    for (int q = gw; q < BATCH * FOX_H; q += NGW) { const int b = q / FOX_H, h = q - b * FOX_H; const float bias = bfp[h];
        float v[64]; float run = 0.f;
#pragma unroll
        for (int i = 0; i < 64; ++i) { const float x = FL[((size_t)b * SEQ + lane * 64 + i) * 16 + h] + bias; run += fminf(x, 0.f) - 0.6931471805599453f * __builtin_amdgcn_logf(1.0f + __builtin_amdgcn_exp2f(-1.4426950408889634f * fabsf(x))); v[i] = run; }
        LAS float* tot = (LAS float*)(C.lds + C.wave * 256);
        tot[lane] = run; LDS_WAIT(); asm volatile("" ::: "memory");
        float excl = 0.f;
        for (int j = 0; j < 64; ++j) { const float t = tot[j]; excl += (j < lane) ? t : 0.f; }
        LDS_WAIT(); asm volatile("" ::: "memory");
#pragma unroll
        for (int i = 0; i < 64; i += 4) *(GAS f32x4*)(CF + (size_t)q * SEQ + lane * 64 + i) = (f32x4){v[i] + excl, v[i + 1] + excl, v[i + 2] + excl, v[i + 3] + excl} * (-att::INV_SCALE);
    }
}

__device__ __forceinline__ void conv_fix_phase(const Ctx& C, int layer) {
    const float* HALO = wsp<float>(C, WS_HALO); bf16* G = wsp<bf16>(C, WS_Z); const float* cw = C.in[18] + (size_t)layer * 3 * FF2; const float* cb = C.in[19] + (size_t)layer * FF2;
    const int gt = C.vcu * NTHREADS + C.tid, NT = C.G * NTHREADS;
    for (int i = gt; i < 128 * (FFH / 4); i += NT) { const int pm = i / (FFH / 4), c = 4 * (i - pm * (FFH / 4)), pn = c >> 7, cc = c & 127;
        const int ca = pn * 256 + cc, cv = ca + 128;
        const float* h0 = HALO + (size_t)pm * 4 * FF2; const bool first = (pm & 15) == 0; const float* hp = HALO + (size_t)(first ? pm : pm - 1) * 4 * FF2;
        const f32x4 z4 = (f32x4){0.f, 0.f, 0.f, 0.f};
        const f32x4 a0 = *(const GAS f32x4*)(h0 + ca), a1 = *(const GAS f32x4*)(h0 + FF2 + ca), v0 = *(const GAS f32x4*)(h0 + cv), v1 = *(const GAS f32x4*)(h0 + FF2 + cv);
        f32x4 am2 = *(const GAS f32x4*)(hp + 2 * FF2 + ca), am1 = *(const GAS f32x4*)(hp + 3 * FF2 + ca), vm2 = *(const GAS f32x4*)(hp + 2 * FF2 + cv), vm1 = *(const GAS f32x4*)(hp + 3 * FF2 + cv);
        if (first) { am2 = z4; am1 = z4; vm2 = z4; vm1 = z4; }
        const f32x4 wa0 = *(const GAS f32x4*)(cw + c), wa1 = *(const GAS f32x4*)(cw + FF2 + c), wa2 = *(const GAS f32x4*)(cw + 2 * FF2 + c), ba = *(const GAS f32x4*)(cb + c);
        const f32x4 wv0 = *(const GAS f32x4*)(cw + FFH + c), wv1 = *(const GAS f32x4*)(cw + FF2 + FFH + c), wv2 = *(const GAS f32x4*)(cw + 2 * FF2 + FFH + c), bv = *(const GAS f32x4*)(cb + FFH + c);
        const f32x4 ya0 = wa0 * am2 + wa1 * am1 + wa2 * a0 + ba, yv0 = wv0 * vm2 + wv1 * vm1 + wv2 * v0 + bv;
        const f32x4 ya1 = wa0 * am1 + wa1 * a0 + wa2 * a1 + ba, yv1 = wv0 * vm1 + wv1 * v0 + wv2 * v1 + bv;
        float g0[4], g1[4];
#pragma unroll
        for (int j = 0; j < 4; ++j) { g0[j] = pg8::silu_f(ya0[j]) * yv0[j]; g1[j] = pg8::silu_f(ya1[j]) * yv1[j]; }
        *(GAS v2u*)(G + (size_t)(pm * 256) * FFP + c) = (v2u){pk2(g0[0], g0[1]), pk2(g0[2], g0[3])}; *(GAS v2u*)(G + (size_t)(pm * 256 + 1) * FFP + c) = (v2u){pk2(g1[0], g1[1]), pk2(g1[2], g1[3])};
    }
}

struct AttnPlan { int fox; const bf16* Q; int qs; int mqcol; const bf16* MKV; int idx, stride; };
__device__ __forceinline__ att::BlockRef attn_decode(const Ctx& C, const AttnPlan& P, int i, int nfox) {
    att::BlockRef r;
    bf16* MIX = wsp<bf16>(C, WS_MIX);
    if (i < nfox) {
        const int L = P.idx + P.stride * (i >> 1), pass = i & 1;
        const int xcd = L & 7, k = L >> 3, bh = xcd * 12 + (k >> 3), x = k & 7, qb = pass ? 15 - x : x, b = bh / FOX_H, h = bh - b * FOX_H;
        const size_t row0 = (size_t)b * SEQ + (size_t)qb * 256;
        r.Q = P.Q + row0 * P.qs + h * 128; r.qs = P.qs;
        r.K = wsp<bf16>(C, WS_KF) + (size_t)b * SEQ * FOX_W + h * 128; r.V = wsp<bf16>(C, WS_VF) + (size_t)b * SEQ * FOX_W + h * 128; r.kvs = FOX_W;
        r.O = MIX + row0 * DM + h * 128; r.os = DM; r.cb = wsp<float>(C, WS_CF) + (size_t)bh * SEQ; r.P0 = qb * 256; r.skv = SEQ; r.jlo = 0;
    } else {
        const int L = P.idx + P.stride * (i - nfox);
        const int bmh = L >> 4, qb = L & 15, b = bmh >> 2, mh = bmh & 3; const size_t row0 = (size_t)b * SEQ + (size_t)qb * 256;
        r.Q = P.Q + row0 * P.qs + P.mqcol + mh * 128; r.qs = P.qs;
        r.K = P.MKV + (size_t)b * NMEM * 4096 + mh * 128; r.V = r.K + 512; r.kvs = 4096;
        r.O = MIX + row0 * DM + FOX_W + mh * 128; r.os = DM; r.cb = wsp<float>(C, WS_CTL); r.P0 = NMEM; r.skv = NMEM; r.jlo = 0;
    }
    return r;
}
__device__ __forceinline__ void attn_phase(const Ctx& C, const AttnPlan& P) {
    int nfox = 0; if (P.fox) { for (int L = P.idx; L < 768; L += P.stride) nfox += 2; }
    int nmem = 0; for (int L = P.idx; L < 512; L += P.stride) nmem += 1;
    const int n = nfox + nmem; if (n == 0) return;
    att::Seam S; att::BlockRef cur = attn_decode(C, P, 0, nfox);
    att::attn_prime(cur, (char*)C.lds, S, C.wave);
    for (int i = 0; i < n; ++i) {
        const att::BlockRef nxt = (i + 1 < n) ? attn_decode(C, P, i + 1, nfox) : cur;
        att::attn_block(cur, nxt, (char*)C.lds, S, C.wave);
        cur = nxt;
    }
}

#ifndef FOX_BLOCK_QMAX
#define FOX_BLOCK_QMAX 0
#endif
constexpr int CW_NQB = 32768;
constexpr int CW_NK2 = 16384, CW_NQ2 = 16640  , CW_QHEAD = 17408  ;
__device__ __forceinline__ void head_norms_phase(const Ctx& C, const bf16* src, int stride, unsigned* out2, const bool per_block = false) {
    const int gw = C.vcu * NWAVES + C.wave, NGW = C.G * NWAVES, lane = C.lane;
    for (int task = gw; task < BATCH * FOX_H * 16; task += NGW) { const int bh = task >> 4, rb = task & 15, b = bh / FOX_H, h = bh - b * FOX_H;
        const bf16* p = src + ((size_t)b * SEQ + (size_t)rb * 256 + (lane >> 4)) * stride + h * 128 + (lane & 15) * 8; float mx = 0.f;
#pragma unroll 16
        for (int i = 0; i < 64; ++i) { const v4u w = *(const GAS v4u*)(p + (size_t)(4 * i) * stride); float s = 0.f;
#pragma unroll
            for (int j = 0; j < 4; ++j) { const float lo = bflo(w[j]), hi = bfhi(w[j]); s += lo * lo + hi * hi; }
            s = dpp_shr_add(s, 1); s = dpp_shr_add(s, 2); s = dpp_shr_add(s, 4); s = dpp_shr_add(s, 8);
            mx = fmaxf(mx, s); }
        float m0 = __builtin_bit_cast(float, __builtin_amdgcn_readlane(__builtin_bit_cast(int, mx), 15)), m1 = __builtin_bit_cast(float, __builtin_amdgcn_readlane(__builtin_bit_cast(int, mx), 31));
        float m2 = __builtin_bit_cast(float, __builtin_amdgcn_readlane(__builtin_bit_cast(int, mx), 47)), m3 = __builtin_bit_cast(float, __builtin_amdgcn_readlane(__builtin_bit_cast(int, mx), 63));
        const float m = fmaxf(fmaxf(m0, m1), fmaxf(m2, m3));
        if (lane == 0) { if (per_block) out2[task] = __builtin_bit_cast(unsigned, m); else atomicMax(out2 + bh, __builtin_bit_cast(unsigned, m)); } }
}
__device__ __forceinline__ int fox_jlo(const float* cb, int P0, float thr, int lane) {
    const int last = 64 * lane + 63; const bool cand = last < P0;
    const float d = cand ? cb[last] - cb[P0] : 0.f;
    const unsigned long long m = __ballot(cand && d < thr);
    return __builtin_amdgcn_readfirstlane((int)__builtin_ctzll(~m));
}
__device__ __forceinline__ att::BlockRef fox_decode(const Ctx& C, int layer, int code, int lane) {
    att::BlockRef r; bf16* MIX = wsp<bf16>(C, WS_MIX); const bf16* Qz = wsp<bf16>(C, WS_Z);
    const int x = code >> 8, v = code & 255;
    if (v < 192) { const int hl = v % 12, qb = 15 - v / 12, bh = x * 12 + hl, b = bh / FOX_H, h = bh - b * FOX_H; const size_t row0 = (size_t)b * SEQ + (size_t)qb * 256;
        r.Q = Qz + row0 * DM + h * 128; r.qs = DM;
        r.K = wsp<bf16>(C, WS_KF) + (size_t)b * SEQ * FOX_W + h * 128; r.V = wsp<bf16>(C, WS_VF) + (size_t)b * SEQ * FOX_W + h * 128; r.kvs = FOX_W;
        r.O = MIX + row0 * DM + h * 128; r.os = DM; r.cb = wsp<float>(C, WS_CF) + (size_t)bh * SEQ; r.P0 = qb * 256; r.skv = SEQ;
        const unsigned* ctl = (const unsigned*)(C.ws + WS_CTL);
#if FOX_BLOCK_QMAX
        float qn2;
        { float s = 0.f; if (C.tid < 256) s = (float)wsp<unsigned>(C, WS_NQ)[(size_t)(layer - 2) * MTOK * 12 + (row0 + C.tid) * 12 + h];
          const float m = wave_max(s);
          volatile LAS float* mx = (volatile LAS float*)(C.lds + MISC_OFF + 256);
          if (lane == 0) mx[C.wave] = m;
          __syncthreads();
          qn2 = fmaxf(fmaxf(fmaxf(mx[0], mx[1]), fmaxf(mx[2], mx[3])), fmaxf(fmaxf(mx[4], mx[5]), fmaxf(mx[6], mx[7]))) * (1.0f / 256.0f);
          __syncthreads(); }
        const float kn2 = __builtin_bit_cast(float, ctl[CW_NK2 + bh]);
#else
        const float qn2 = __builtin_bit_cast(float, ctl[CW_NQB + 2048 * (layer - 2) + bh * 16 + qb]), kn2 = __builtin_bit_cast(float, ctl[CW_NK2 + bh]);
#endif
        r.jlo = fox_jlo(r.cb, r.P0, -(45.0f * att::INV_SCALE + 2.0f * sqrtf(qn2 * kn2) * 1.01f), lane);
    } else { const int id = x * 64 + (v - 192), bmh = id >> 4, qb = id & 15, b = bmh >> 2, mh = bmh & 3; const size_t row0 = (size_t)b * SEQ + (size_t)qb * 256;
        r.Q = Qz + row0 * DM + FOX_W + mh * 128; r.qs = DM;
        r.K = wsp<bf16>(C, WS_MKV) + 1024 * layer + (size_t)b * NMEM * 4096 + mh * 128; r.V = r.K + 512; r.kvs = 4096;
        r.O = MIX + row0 * DM + FOX_W + mh * 128; r.os = DM; r.cb = wsp<float>(C, WS_CTL); r.P0 = NMEM; r.skv = NMEM; r.jlo = 0; }
    return r;
}
__device__ __forceinline__ int fox_grab(const Ctx& C, int layer) {
    volatile LAS int* box = (volatile LAS int*)(C.lds + MISC_OFF + 128);
    if (C.tid == 0) { unsigned* heads = (unsigned*)(C.ws + WS_CTL) + CW_QHEAD + 64 * 8 * (layer - 2); int code = -1;
        for (int i = 0; i < 8 && code < 0; ++i) { const int q = (C.bx + i) & 7; const unsigned v = __hip_atomic_fetch_add(heads + 64 * q, 1u, __ATOMIC_RELAXED, __HIP_MEMORY_SCOPE_AGENT); if (v < 256u) code = q * 256 + (int)v; }
        box[0] = code; }
    __syncthreads();
    const int code = box[0];
    __syncthreads();
    return code;
}
__device__ __forceinline__ void fox_attn_phase(const Ctx& C, int layer) {
    int code = fox_grab(C, layer); if (code < 0) return;
    att::Seam S; att::BlockRef cur = fox_decode(C, layer, code, C.lane);
    att::attn_prime(cur, (char*)C.lds, S, C.wave);
    for (;;) {
        const int nc = fox_grab(C, layer);
        const att::BlockRef nxt = nc >= 0 ? fox_decode(C, layer, nc, C.lane) : cur;
        att::attn_block(cur, nxt, (char*)C.lds, S, C.wave);
        if (nc < 0) break;
        cur = nxt;
    }
}
enum Kind { K_PROLOGUE = 0, K_MEMKV, K_IN, K_MIX1, K_PREP, K_SCAN, K_ONORM, K_OUT, K_RMSF, K_UP, K_FIX, K_DOWN, K_NORMN, K_KV, K_CUM, K_QN, K_DRYUP, K_DRYDOWN, K_COUNT };
#ifndef KEEP_ONORM
#define KEEP_ONORM 0
#endif
#ifndef QN_IN_EPI
#define QN_IN_EPI 0
#endif
#ifndef IN_WGM
#define IN_WGM 8
#endif
#ifndef MEMKV_FILL
#define MEMKV_FILL 1
#endif
#ifndef QK_TEMPORAL_TILES
#define QK_TEMPORAL_TILES 0
#endif
#ifndef DOWN_WGM
#define DOWN_WGM 4
#endif
#ifndef SKINNY_STAGGER
#define SKINNY_STAGGER 0
#endif
#ifndef PROBE_DUP_IN
#define PROBE_DUP_IN 0
#endif
#ifndef PROBE_DUP_UP
#define PROBE_DUP_UP 0
#endif
#ifndef PROBE_DRY_UP
#define PROBE_DRY_UP 0
#endif
#ifndef PROBE_DRY_DOWN
#define PROBE_DRY_DOWN 0
#endif
__device__ __forceinline__ unsigned* ss_arr(const Ctx& C, int id) { return wsp<unsigned>(C, WS_SS) + (size_t)id * MTOK; }
struct Args { const float* in[21]; float* out; unsigned char* ws; int layer, fused, ph_lo, ph_hi; };
__device__ __forceinline__ void make_ctx(Ctx& C, const Args& args, unsigned char* lds_raw, int wave) {
    int bx = blockIdx.x; asm volatile("" : "+s"(bx));
    int G = gridDim.x; asm volatile("" : "+s"(G));
    unsigned long long z = 0; asm volatile("" : "+s"(z));
    const Args* ap = (const Args*)((const char*)&args + z);
    C.lds = (LAS unsigned char*)lds_raw;
    C.wave = wave; C.tid = opaque_tid(wave); C.lane = C.tid & 63;
    C.G = G; C.bx = bx; C.vcu = (C.G % 8 == 0) ? (C.bx % 8) * (C.G / 8) + C.bx / 8 : C.bx;
#pragma unroll
    for (int i = 0; i < 21; ++i) C.in[i] = ap->in[i];
    C.out = ap->out; C.ws = ap->ws;
}
__device__ __forceinline__ int wave_index() { int w = __builtin_amdgcn_readfirstlane((int)threadIdx.x >> 6); asm volatile("" : "+s"(w)); return w; }
template <int KIND> __device__ __forceinline__ void run_phase(const Ctx& C, int layer) {
    LAS unsigned char* ring = C.lds;
    const bool gla = layer < 2; const int lj = gla ? layer : layer - 2;
    if constexpr (KIND == K_PROLOGUE) { p0_prologue(C); }
    if constexpr (KIND == K_MEMKV) {
        pg8::Gemm g{wsp<bf16>(C, WS_MEMN), wsp<bf16>(C, WS_WMEM), MMEM, 4096, DM}; pg8::StaticOrder S; S.init(MMEM, 4096, C.G, C.bx);
        pg8::EpiBf16 E{wsp<bf16>(C, WS_MKV), 4096, nullptr, nullptr, C.lds + XTRA_OFF};
        pg8::gemm_phase<pg8::EpiBf16, pg8::StaticOrder, true, true>(ring, g, S, E, C.wave);
        if (MEMKV_FILL && C.G > 128 && C.bx >= 128)
            skinny16_phase(C, wsp<bf16>(C, WS_H), wsp<bf16>(C, WS_WGLR), wsp<float>(C, WS_GLR), ss_arr(C, 0), (C.bx - 128) * NWAVES + C.wave, (C.G - 128) * NWAVES);
    }
    if constexpr (KIND == K_IN) {
        const int N = gla ? GLA_IN : DM;
        const bf16* Bt = gla ? wsp<bf16>(C, WS_WGIN) + (size_t)lj * GLA_IN * DM : wsp<bf16>(C, WS_WFIN) + (size_t)lj * DM * DM;
        const bf16* Aop = wsp<bf16>(C, WS_H); const unsigned* ssp = ss_arr(C, 2 * layer);
        pg8::Gemm g{Aop, Bt, MTOK, N, DM, XBP}; pg8::StaticOrder S; S.init(MTOK, N, C.G, C.bx, IN_WGM);
        pg8::EpiBf16H E{wsp<bf16>(C, WS_Z), N, ssp, (QN_IN_EPI && !gla) ? (unsigned*)(C.ws + WS_CTL) + CW_NQB + 2048 * lj : nullptr, C.lds + XTRA_OFF, gla ? QK_TEMPORAL_TILES : 0};
        const bool early = SKINNY_STAGGER && ((C.bx >> 3) & 1) != 0;
        if (gla && early) skinny16_phase(C, Aop, wsp<bf16>(C, WS_WGLR) + (size_t)lj * 16 * DM, wsp<float>(C, WS_GLR), ssp);
        pg8::gemm_phase<pg8::EpiBf16H, pg8::StaticOrder, true, true>(ring, g, S, E, C.wave);
        if (gla && !early && !(MEMKV_FILL && layer == 0 && C.G > 128)) skinny16_phase(C, Aop, wsp<bf16>(C, WS_WGLR) + (size_t)lj * 16 * DM, wsp<float>(C, WS_GLR), ssp);
    }
    if constexpr (KIND == K_MIX1) { fox_attn_phase(C, layer); }
    if constexpr (KIND == K_QN) { head_norms_phase(C, wsp<bf16>(C, WS_Z), DM, (unsigned*)(C.ws + WS_CTL) + CW_NQB + 2048 * (layer - 2), true); }
    if constexpr (KIND == K_PREP) { gla_prep_phase(C, lj); }
    if constexpr (KIND == K_SCAN) {
        if (C.vcu < 192) gla_scan_phase(C);
        else { AttnPlan P; P.fox = 0; P.Q = wsp<bf16>(C, WS_Z); P.qs = GLA_IN; P.mqcol = ZMQ; P.MKV = wsp<bf16>(C, WS_MKV) + 1024 * layer; P.idx = C.vcu - 192; P.stride = C.G - 192;
            attn_phase(C, P); __syncthreads(); convert_late(C, layer, (C.vcu - 192) * NWAVES + C.wave, (C.G - 192) * NWAVES); }
    }
    if constexpr (KIND == K_ONORM) { gla_onorm_phase(C, lj); }
    if constexpr (KIND == K_OUT) {
        const float* xin = (layer == 0) ? C.in[0] : nullptr;
        const bf16* Bt = gla ? wsp<bf16>(C, WS_WGOUT) + (size_t)lj * DM * DM : wsp<bf16>(C, WS_WFOUT) + (size_t)lj * DM * DM;
        pg8::Gemm g{wsp<bf16>(C, WS_MIX), Bt, MTOK, DM, DM}; pg8::StaticOrder S; S.init(MTOK, DM, C.G, C.bx, DOWN_WGM);
        if (gla) { pg8::EpiResK E{xin, wsp<bf16>(C, WS_XH), wsp<bf16>(C, WS_H), ss_arr(C, 1 + 2 * layer), XBP, wsp<float>(C, WS_SSH), C.lds + XTRA_OFF};
            pg8::gemm_phase<pg8::EpiResK, pg8::StaticOrder, true, true>(ring, g, S, E, C.wave); }
        else { pg8::EpiRes E{xin, wsp<bf16>(C, WS_XH), wsp<bf16>(C, WS_H), ss_arr(C, 1 + 2 * layer), XBP, nullptr, C.lds + XTRA_OFF};
            pg8::gemm_phase<pg8::EpiRes, pg8::StaticOrder, true, true>(ring, g, S, E, C.wave); }
    }
    if constexpr (KIND == K_UP) {
        const bf16* Aop = wsp<bf16>(C, WS_H); const unsigned* ssp = ss_arr(C, 1 + 2 * layer);
        pg8::Gemm g{Aop, wsp<bf16>(C, WS_WUP) + (size_t)layer * FF2 * DM, MTOK, FF2, DM, XBP}; pg8::StaticOrder S; S.init(MTOK, FF2, C.G, C.bx);
        pg8::EpiConv E{wsp<bf16>(C, WS_Z), wsp<float>(C, WS_HALO), C.in[18] + (size_t)layer * 3 * FF2, C.in[19] + (size_t)layer * FF2, C.lds + XTRA_OFF, ssp, FFP};
        pg8::gemm_phase<pg8::EpiConv, pg8::StaticOrder, true, true>(ring, g, S, E, C.wave);
    }
#if defined(PROBE_DRY)
    if constexpr (KIND == K_DRYUP) {
        pg8::Gemm g{wsp<bf16>(C, WS_H), wsp<bf16>(C, WS_WUP) + (size_t)layer * FF2 * DM, MTOK, FF2, DM, XBP}; pg8::StaticOrder S; S.init(MTOK, FF2, C.G, C.bx);
        pg8::EpiDry E{wsp<float>(C, WS_HALO)};
        pg8::gemm_phase<pg8::EpiDry, pg8::StaticOrder, true, true>(ring, g, S, E, C.wave);
    }
    if constexpr (KIND == K_DRYDOWN) {
        pg8::Gemm g{wsp<bf16>(C, WS_Z), wsp<bf16>(C, WS_WDOWN) + (size_t)layer * DM * FFH, MTOK, DM, FFH}; pg8::StaticOrder S; S.init(MTOK, DM, C.G, C.bx);
        pg8::EpiDry E{wsp<float>(C, WS_HALO)};
        pg8::gemm_phase<pg8::EpiDry, pg8::StaticOrder, true, true>(ring, g, S, E, C.wave);
    }
#endif
    if constexpr (KIND == K_FIX) { conv_fix_phase(C, layer); }
    if constexpr (KIND == K_DOWN) {
        pg8::Gemm g{wsp<bf16>(C, WS_Z), wsp<bf16>(C, WS_WDOWN) + (size_t)layer * DM * FFH, MTOK, DM, FFH, FFP}; pg8::StaticOrder S; S.init(MTOK, DM, C.G, C.bx, DOWN_WGM);
        pg8::EpiRes E{nullptr, wsp<bf16>(C, WS_XH), (RES_BF16 || layer < 3) ? wsp<bf16>(C, WS_H) : nullptr, layer < 3 ? ss_arr(C, 2 + 2 * layer) : nullptr, XBP, nullptr, C.lds + XTRA_OFF};
        pg8::gemm_phase<pg8::EpiRes, pg8::StaticOrder, true, true>(ring, g, S, E, C.wave);
    }
    if constexpr (KIND == K_NORMN) { rms_bf16_phase(C, wsp<bf16>(C, RES_BF16 ? WS_H : WS_XH), C.in[5], C.out); }
    if constexpr (KIND == K_KV) {
        const bf16* Aop = wsp<bf16>(C, WS_H); const unsigned* ssp = ss_arr(C, 4);
        pg8::Gemm g{Aop, wsp<bf16>(C, WS_WFKV), MTOK, 3072, DM, XBP}; pg8::StaticOrder S; S.init(MTOK, 3072, C.G, C.bx);
        pg8::EpiSplit2 E{wsp<bf16>(C, WS_KF), wsp<bf16>(C, WS_VF), FOX_W, ssp};
        const bool early = SKINNY_STAGGER && ((C.bx >> 3) & 1) != 0;
        if (early) skinny16_phase(C, Aop, wsp<bf16>(C, WS_WFL), wsp<float>(C, WS_GLR), ssp);
        pg8::gemm_phase<pg8::EpiSplit2, pg8::StaticOrder, true, true>(ring, g, S, E, C.wave);
        if (!early) skinny16_phase(C, Aop, wsp<bf16>(C, WS_WFL), wsp<float>(C, WS_GLR), ssp);
    }
    if constexpr (KIND == K_CUM) { fox_cumsum_phase(C); head_norms_phase(C, wsp<bf16>(C, WS_KF), FOX_W, (unsigned*)(C.ws + WS_CTL) + CW_NK2); }
}
template <int KIND> __global__ void __launch_bounds__(NTHREADS, 2) phase_kernel(Args args) {
    extern __shared__ __attribute__((aligned(16))) unsigned char lds_raw[];
    Ctx C; make_ctx(C, args, lds_raw, wave_index());
    run_phase<KIND>(C, args.layer);
}
__global__ void __launch_bounds__(NTHREADS, 2) hybrid_fwd(Args args) {
    extern __shared__ __attribute__((aligned(16))) unsigned char lds_raw[];
    const int wave = wave_index();
    volatile LAS unsigned* MISC = (volatile LAS unsigned*)((LAS unsigned char*)lds_raw + MISC_OFF);
    { const int t = opaque_tid(wave); if (t < 64) MISC[t] = 0u; }
    __syncthreads();
    XcdBarrier bar = xcd_barrier_post((unsigned*)(args.ws + WS_CTL) + CW_BAR, MISC + 8, wave);
#define PHASE(KIND, L) do { Ctx C; make_ctx(C, args, lds_raw, wave); run_phase<KIND>(C, (L)); } while (0)
#define SEAM() do { XcdBarrier b_ = bar; asm volatile("" : "+s"(b_.bar)); xcd_barrier(b_, wave); } while (0)
    PHASE(K_PROLOGUE, 0); SEAM();
    PHASE(K_MEMKV, 0);
#define LAYER(layer) do {                                                                                   \
        if (PROBE_DUP_IN && (layer) == 0) { PHASE(K_IN, layer); SEAM(); }                                   \
        PHASE(K_IN, layer); SEAM();                                                                         \
        if ((layer) == 2) { PHASE(K_CUM, layer); if (FOX_BLOCK_QMAX || QN_IN_EPI) SEAM(); }     \
        if (!FOX_BLOCK_QMAX && !QN_IN_EPI && (layer) >= 2) { PHASE(K_QN, layer); SEAM(); }                                \
        if ((layer) < 2) { PHASE(K_PREP, layer); } else { PHASE(K_MIX1, layer); } SEAM();                   \
        if ((layer) < 2) { PHASE(K_SCAN, layer); SEAM(); if (KEEP_ONORM) { PHASE(K_ONORM, layer); SEAM(); } }  \
        PHASE(K_OUT, layer); SEAM();                                                \
        if (PROBE_DRY_UP && (layer) == 2) { PHASE(K_DRYUP, layer); SEAM(); }                                \
        if (PROBE_DUP_UP && (layer) == 2) { PHASE(K_UP, layer); SEAM(); }                                   \
        PHASE(K_UP, layer); SEAM();                                                               \
        PHASE(K_FIX, layer); SEAM();                                                                        \
        if (PROBE_DRY_DOWN && (layer) == 2) { PHASE(K_DRYDOWN, layer); SEAM(); }                            \
        PHASE(K_DOWN, layer); SEAM();                                               \
        if ((layer) == 3) { PHASE(K_NORMN, layer); }                                                        \
        if ((layer) == 1) { PHASE(K_KV, layer); } } while (0)
    LAYER(0); LAYER(1); LAYER(2); LAYER(3);
#undef LAYER
#undef PHASE
#undef SEAM
}
template <int KIND> static void launch_phase(Args& a, int layer, int grid, hipStream_t stream) {
    static bool attr = false;
    if (!attr) { (void)hipFuncSetAttribute((const void*)phase_kernel<KIND>, hipFuncAttributeMaxDynamicSharedMemorySize, LDS_BYTES); attr = true; }
    a.layer = layer;
    hipLaunchKernelGGL(phase_kernel<KIND>, dim3(grid), dim3(NTHREADS), LDS_BYTES, stream, a);
}

constexpr size_t WS_NEED = WS_NQ + (size_t)2 * MTOK * 12 * 4;
extern "C" void kernel_launch(void* const* d_in, const int* in_sizes, int n_in, void* d_out, int out_size, void* d_ws, size_t ws_size, hipStream_t stream) {
    static int grid = 0;
    if (grid == 0) {
        if (n_in != 21 || in_sizes[0] != MTOK * DM || out_size != MTOK * DM || ws_size < WS_NEED) {
            fprintf(stderr, "kernel_launch: unexpected shapes / workspace (n_in %d, in0 %d, out %d, ws %zu < %zu); nothing launched\n", n_in, n_in > 0 ? in_sizes[0] : -1, out_size, ws_size, (size_t)WS_END); grid = -1; return; }
        int dev = 0, cus = 0;
        if (hipGetDevice(&dev) != hipSuccess || hipDeviceGetAttribute(&cus, hipDeviceAttributeMultiprocessorCount, dev) != hipSuccess) { grid = -1; return; }
        if (cus < 192) { fprintf(stderr, "kernel_launch: needs >= 192 CUs\n"); grid = -1; return; }
        grid = cus;
    }
    if (grid < 0) return;
    if (hipMemsetAsync((char*)d_ws + WS_CTL, 0, CTL_BYTES + (size_t)9 * MTOK * 4, stream) != hipSuccess) return;
    Args a{};
    for (int i = 0; i < 21; ++i) a.in[i] = (const float*)d_in[i];
    a.out = (float*)d_out; a.ws = (unsigned char*)d_ws;
#if MK_FUSED
    static bool attr = false;
    if (!attr) { if (hipFuncSetAttribute((const void*)hybrid_fwd, hipFuncAttributeMaxDynamicSharedMemorySize, LDS_BYTES) != hipSuccess) { fprintf(stderr, "kernel_launch: hipFuncSetAttribute failed\n"); return; } attr = true; }
    a.fused = 1;
    hipLaunchKernelGGL(hybrid_fwd, dim3(grid), dim3(NTHREADS), LDS_BYTES, stream, a);
#else
    launch_phase<K_PROLOGUE>(a, 0, grid, stream);
    launch_phase<K_MEMKV>(a, 0, grid, stream);
    for (int layer = 0; layer < 4; ++layer) {
        launch_phase<K_IN>(a, layer, grid, stream);
        if (layer < 2) launch_phase<K_PREP>(a, layer, grid, stream); else { launch_phase<K_QN>(a, layer, grid, stream); launch_phase<K_MIX1>(a, layer, grid, stream); }
        if (layer < 2) { launch_phase<K_SCAN>(a, layer, grid, stream); launch_phase<K_ONORM>(a, layer, grid, stream); }
        launch_phase<K_OUT>(a, layer, grid, stream);
        launch_phase<K_UP>(a, layer, grid, stream);
        launch_phase<K_FIX>(a, layer, grid, stream);
        launch_phase<K_DOWN>(a, layer, grid, stream);
        if (layer == 3) launch_phase<K_NORMN>(a, layer, grid, stream);
        if (layer == 1) { launch_phase<K_KV>(a, layer, grid, stream); launch_phase<K_CUM>(a, layer, grid, stream); }
    }
#endif
}
```
